# Optimizing an MI355X kernel written in HIP

```python
import jax
import jax.numpy as jnp
from jax import lax
import numpy as np

D_MODEL = 1024
BATCH = 4
SEQ = 8192
DEPTH = 2

GRID_W = 64
CTX_LEN = 256
N_GROUPS = 4
GROUP_W = D_MODEL // N_GROUPS
MIX_W = N_GROUPS * GROUP_W

GLA_HEADS = 4
GLA_DK = GROUP_W // (2 * GLA_HEADS)
GLA_DV = GROUP_W // GLA_HEADS
GLA_RANK = 16
GLA_GATE_NORMALIZER = 16.0
GLA_LOG_DECAY_MIN = -1.0
GLA_CHUNK = 64

POOL_WINDOWS = (2, 4, 8, 16)
POOL_CH = GROUP_W // len(POOL_WINDOWS)

SGU_CHUNK = 128
SGU_HEADS = 4
SGU_HD = GROUP_W // SGU_HEADS

CONV_WIDTH = 31
FFN_HIDDEN = 2816
FFN_CONV = 3

GLA_QK = GLA_HEADS * GLA_DK
COLS_A = 2 * GLA_QK + 2 * GROUP_W + 2 * GLA_RANK
COLS_B = GROUP_W
COLS_C = 2 * GROUP_W
COLS_D = 2 * GROUP_W
IN_COLS = COLS_A + COLS_B + COLS_C + COLS_D
MIX_SPLITS = (COLS_A, COLS_A + COLS_B, COLS_A + COLS_B + COLS_C)
GLA_SPLITS = (GLA_QK, 2 * GLA_QK, 2 * GLA_QK + GROUP_W, 2 * GLA_QK + 2 * GROUP_W,
              2 * GLA_QK + 2 * GROUP_W + GLA_RANK)

ALPHA = (2 * DEPTH) ** 0.25
BETA = (8 * DEPTH) ** -0.25
EPS = 1e-6

kernel_name = 'hybrid_parallel_mixer_dit_block'


def _norm(x):
    x32 = x.astype(jnp.float32)
    mu = jnp.mean(x32, axis=-1, keepdims=True)
    var = jnp.mean(jnp.square(x32 - mu), axis=-1, keepdims=True)
    return ((x32 - mu) * lax.rsqrt(var + EPS)).astype(x.dtype)


def layer_norm(x, w, b):
    return _norm(x) * w + b


def modulate(x, shift, scale):
    return _norm(x) * (1 + scale) + shift


def split_heads(t, h):
    b, l, _ = t.shape
    return t.reshape(b, l, h, -1).transpose(0, 2, 1, 3)


def merge_heads(t):
    b, h, l, d = t.shape
    return t.transpose(0, 2, 1, 3).reshape(b, l, h * d)


def _to_chunks(t):
    b, h, l, d = t.shape
    return t.reshape(b, h, l // GLA_CHUNK, GLA_CHUNK, d)


def gla_chunk_summaries(k, v, g):
    cum = jnp.cumsum(g, axis=3)
    cum_last = cum[:, :, :, -1, :]
    k_dec = k * jnp.exp(cum_last[:, :, :, None, :] - cum)
    kv = jnp.einsum('bhncd,bhnce->bhnde', k_dec, v)
    return cum, kv, jnp.exp(cum_last)


def gla_chunk_states(kv, decay, s0):
    def step(s, inp):
        kv_n, dec_n = inp
        return dec_n[..., None] * s + kv_n, s
    s_fin, s_start = lax.scan(step, s0, (jnp.moveaxis(kv, 2, 0), jnp.moveaxis(decay, 2, 0)))
    return jnp.moveaxis(s_start, 0, 2), s_fin


def gla_scan(q, k, v, g, s0):
    b, h, l, dv = v.shape
    q, k, v, g = (_to_chunks(t) for t in (q, k, v, g))
    cum, kv, decay = gla_chunk_summaries(k, v, g)
    s_start, s_fin = gla_chunk_states(kv, decay, s0)
    q_in = q * jnp.exp(cum)
    k_in = k * jnp.exp(-cum)
    tri = jnp.tril(jnp.ones((GLA_CHUNK, GLA_CHUNK), dtype=bool))
    a = jnp.where(tri, jnp.einsum('bhncd,bhnsd->bhncs', q_in, k_in), 0.0)
    o = jnp.einsum('bhncs,bhnse->bhnce', a, v) + jnp.einsum('bhncd,bhnde->bhnce', q_in, s_start)
    return o.reshape(b, h, l, dv), s_fin


def gla_final_state(k, v, g, s0):
    _, kv, decay = gla_chunk_summaries(_to_chunks(k), _to_chunks(v), _to_chunks(g))
    _, s_fin = gla_chunk_states(kv, decay, s0)
    return s_fin


def gla_log_decay(z_low, w_up, b_up):
    logit = z_low @ w_up + b_up
    return jnp.maximum(jax.nn.log_sigmoid(logit) / GLA_GATE_NORMALIZER, GLA_LOG_DECAY_MIN)


def gla_mixer(za_lat, za_ctx, w_gate, b_gate, norm_w, with_ctx_out):
    def prep(za):
        q, k, v, r, low_f, low_b = jnp.split(za.astype(jnp.float32), GLA_SPLITS, axis=-1)
        q = split_heads(q, GLA_HEADS) * GLA_DK ** -0.5
        k = split_heads(k, GLA_HEADS)
        v = split_heads(v, GLA_HEADS)
        g_f = split_heads(gla_log_decay(low_f, w_gate[0], b_gate[0]), GLA_HEADS)
        g_b = split_heads(gla_log_decay(low_b, w_gate[1], b_gate[1]), GLA_HEADS)
        return q, k, v, r, g_f, g_b

    def readout(o, r, dtype):
        o = o * lax.rsqrt(jnp.mean(jnp.square(o), axis=-1, keepdims=True) + EPS)
        return (merge_heads(o) * norm_w * jax.nn.silu(r)).astype(dtype)

    flip = lambda t: jnp.flip(t, axis=2)
    s0 = jnp.zeros((za_ctx.shape[0], GLA_HEADS, GLA_DK, GLA_DV), jnp.float32)
    qc, kc, vc, rc, gfc, gbc = prep(za_ctx)
    if with_ctx_out:
        oc_f, s_f = gla_scan(qc, kc, vc, gfc, s0)
        oc_b, s_b = gla_scan(flip(qc), flip(kc), flip(vc), flip(gbc), s0)
        y_ctx = readout(oc_f + flip(oc_b), rc, za_ctx.dtype)
    else:
        s_f = gla_final_state(kc, vc, gfc, s0)
        s_b = gla_final_state(flip(kc), flip(vc), flip(gbc), s0)
        y_ctx = None
    q, k, v, r, g_f, g_b = prep(za_lat)
    o_f, _ = gla_scan(q, k, v, g_f, s_f)
    o_b, _ = gla_scan(flip(q), flip(k), flip(v), flip(g_b), s_b)
    return readout(o_f + flip(o_b), r, za_lat.dtype), y_ctx


def pool_mixer(zb, pool_w, pool_scale):
    b, l, _ = zb.shape
    x32 = zb.astype(jnp.float32)
    cs = jnp.concatenate([jnp.zeros((b, 1, GROUP_W), jnp.float32), jnp.cumsum(x32, axis=1)], axis=1)
    t = jnp.arange(l)
    outs = []
    for gi, w in enumerate(POOL_WINDOWS):
        lo = jnp.clip(t - w // 2, 0, l)
        hi = jnp.clip(t + w - w // 2, 0, l)
        sl = slice(gi * POOL_CH, (gi + 1) * POOL_CH)
        mean = (cs[:, hi, sl] - cs[:, lo, sl]) / (hi - lo).astype(jnp.float32)[None, :, None]
        outs.append(mean - x32[:, :, sl])
    y = jnp.stack(outs, axis=2).astype(zb.dtype)
    y = jnp.einsum('blgc,gcd->blgd', y, pool_w).reshape(b, l, GROUP_W)
    return y * pool_scale


def sgu_mixer(zc, sgu_w, sgu_b, ln_w, ln_b):
    z = jax.nn.gelu(zc)
    u, v = jnp.split(z, 2, axis=-1)
    v = layer_norm(v, ln_w, ln_b)
    b, l, _ = v.shape
    vh = v.reshape(b, l // SGU_CHUNK, SGU_CHUNK, SGU_HEADS, SGU_HD)
    s = jnp.einsum('hts,bnshd->bnthd', sgu_w, vh) + sgu_b.T[:, :, None]
    return u * s.reshape(b, l, GROUP_W)


def conv_module(zd, conv_w, conv_b, ln_w, ln_b):
    a, g = jnp.split(zd, 2, axis=-1)
    y = a * jax.nn.sigmoid(g)
    y = lax.conv_general_dilated(y, conv_w[:, None, :], window_strides=(1,),
                                 padding=[(CONV_WIDTH // 2, CONV_WIDTH // 2)],
                                 dimension_numbers=('NWC', 'WIO', 'NWC'),
                                 feature_group_count=GROUP_W) + conv_b
    return jax.nn.silu(layer_norm(y, ln_w, ln_b))


def conv_ffn(h, w_up, conv_w, w_down, rows, width):
    b, l, _ = h.shape
    u = (h @ w_up).reshape(b, rows, width, 2 * FFN_HIDDEN)
    u = lax.conv_general_dilated(u, conv_w[:, :, None, :], window_strides=(1, 1), padding='SAME',
                                 dimension_numbers=('NHWC', 'HWIO', 'NHWC'),
                                 feature_group_count=2 * FFN_HIDDEN)
    a, g = jnp.split(u.reshape(b, l, 2 * FFN_HIDDEN), 2, axis=-1)
    return (jax.nn.silu(g) * a) @ w_down


def token_mixer(h_lat, h_ctx, w_in, gla_w_gate, gla_b_gate, gla_norm_w, pool_w, pool_scale,
                sgu_w, sgu_b, sgu_ln_w, sgu_ln_b, cm_conv_w, cm_conv_b, cm_ln_w, cm_ln_b, w_out,
                with_ctx_out):
    def other_groups(z):
        _, zb, zc, zd = jnp.split(z, MIX_SPLITS, axis=-1)
        return [pool_mixer(zb, pool_w, pool_scale),
                sgu_mixer(zc, sgu_w, sgu_b, sgu_ln_w, sgu_ln_b),
                conv_module(zd, cm_conv_w, cm_conv_b, cm_ln_w, cm_ln_b)]
    z_lat = h_lat @ w_in
    z_ctx = h_ctx @ (w_in if with_ctx_out else w_in[:, :COLS_A])
    ya_lat, ya_ctx = gla_mixer(z_lat[..., :COLS_A], z_ctx[..., :COLS_A],
                               gla_w_gate, gla_b_gate, gla_norm_w, with_ctx_out)
    y_lat = jnp.concatenate([ya_lat] + other_groups(z_lat), axis=-1) @ w_out
    y_ctx = (jnp.concatenate([ya_ctx] + other_groups(z_ctx), axis=-1) @ w_out) if with_ctx_out else None
    return y_lat, y_ctx


def setup_inputs(seed: int = 0) -> dict:
    key = jax.random.key(seed)
    ks = jax.random.split(key, 26)

    def nrm(k, shape, scale):
        return jax.random.normal(k, shape, jnp.float32) * scale

    return {
        'x': nrm(ks[0], (BATCH, SEQ, D_MODEL), 1.0),
        'c': nrm(ks[1], (BATCH, D_MODEL), 1.0),
        'ctx': nrm(ks[2], (BATCH, CTX_LEN, D_MODEL), 1.0),
        'c_ctx': nrm(ks[3], (D_MODEL,), 1.0),
        'w_mod': nrm(ks[4], (DEPTH, D_MODEL, 6 * D_MODEL), 0.5 * D_MODEL ** -0.5),
        'b_mod': nrm(ks[5], (DEPTH, 6 * D_MODEL), 0.02),
        'w_in': nrm(ks[6], (DEPTH, D_MODEL, IN_COLS), D_MODEL ** -0.5),
        'gla_w_gate': nrm(ks[7], (DEPTH, 2, GLA_RANK, GLA_QK), GLA_RANK ** -0.5),
        'gla_b_gate': nrm(ks[8], (DEPTH, 2, GLA_QK), 0.02),
        'gla_norm_w': 1.0 + nrm(ks[9], (DEPTH, GROUP_W), 0.02),
        'pool_w': nrm(ks[10], (DEPTH, len(POOL_WINDOWS), POOL_CH, POOL_CH), POOL_CH ** -0.5),
        'pool_scale': 1.0 + nrm(ks[11], (DEPTH, GROUP_W), 0.02),
        'sgu_w': nrm(ks[12], (DEPTH, SGU_HEADS, SGU_CHUNK, SGU_CHUNK), SGU_CHUNK ** -0.5),
        'sgu_b': 1.0 + nrm(ks[13], (DEPTH, SGU_HEADS, SGU_CHUNK), 0.02),
        'sgu_ln_w': 1.0 + nrm(ks[14], (DEPTH, GROUP_W), 0.02),
        'sgu_ln_b': nrm(ks[15], (DEPTH, GROUP_W), 0.02),
        'cm_conv_w': nrm(ks[16], (DEPTH, CONV_WIDTH, GROUP_W), CONV_WIDTH ** -0.5),
        'cm_conv_b': nrm(ks[17], (DEPTH, GROUP_W), 0.02),
        'cm_ln_w': 1.0 + nrm(ks[18], (DEPTH, GROUP_W), 0.02),
        'cm_ln_b': nrm(ks[19], (DEPTH, GROUP_W), 0.02),
        'w_out': nrm(ks[20], (DEPTH, MIX_W, D_MODEL), BETA * MIX_W ** -0.5),
        'ffn_w_up': nrm(ks[21], (DEPTH, D_MODEL, 2 * FFN_HIDDEN), D_MODEL ** -0.5),
        'ffn_conv_w': nrm(ks[22], (DEPTH, FFN_CONV, FFN_CONV, 2 * FFN_HIDDEN), 1.0 / FFN_CONV),
        'ffn_w_down': nrm(ks[23], (DEPTH, FFN_HIDDEN, D_MODEL), BETA * FFN_HIDDEN ** -0.5),
        'post_ln_w': 1.0 + nrm(ks[24], (DEPTH, 2, D_MODEL), 0.02),
        'post_ln_b': nrm(ks[25], (DEPTH, 2, D_MODEL), 0.02),
    }


def reference(x, c, ctx, c_ctx, w_mod, b_mod, w_in, gla_w_gate, gla_b_gate, gla_norm_w,
              pool_w, pool_scale, sgu_w, sgu_b, sgu_ln_w, sgu_ln_b, cm_conv_w, cm_conv_b,
              cm_ln_w, cm_ln_b, w_out, ffn_w_up, ffn_conv_w, ffn_w_down, post_ln_w, post_ln_b):
    rows = x.shape[1] // GRID_W
    ctx_len = ctx.shape[1]
    sc = jax.nn.silu(c)
    sc_ctx = jax.nn.silu(c_ctx)
    for l in range(DEPTH):
        with_ctx_out = l < DEPTH - 1
        m_lat = jnp.split((sc @ w_mod[l] + b_mod[l])[:, None, :], 6, axis=-1)
        m_ctx = jnp.split(sc_ctx @ w_mod[l] + b_mod[l], 6, axis=-1)
        h_lat = modulate(x, m_lat[0], m_lat[1])
        h_ctx = modulate(ctx, m_ctx[0], m_ctx[1])
        y_lat, y_ctx = token_mixer(h_lat, h_ctx, w_in[l], gla_w_gate[l], gla_b_gate[l], gla_norm_w[l],
                                   pool_w[l], pool_scale[l], sgu_w[l], sgu_b[l], sgu_ln_w[l], sgu_ln_b[l],
                                   cm_conv_w[l], cm_conv_b[l], cm_ln_w[l], cm_ln_b[l], w_out[l],
                                   with_ctx_out)
        x = layer_norm(ALPHA * x + m_lat[2] * y_lat, post_ln_w[l, 0], post_ln_b[l, 0])
        h_lat = modulate(x, m_lat[3], m_lat[4])
        f_lat = conv_ffn(h_lat, ffn_w_up[l], ffn_conv_w[l], ffn_w_down[l], rows, GRID_W)
        x = layer_norm(ALPHA * x + m_lat[5] * f_lat, post_ln_w[l, 1], post_ln_b[l, 1])
        if with_ctx_out:
            ctx = layer_norm(ALPHA * ctx + m_ctx[2] * y_ctx, post_ln_w[l, 0], post_ln_b[l, 0])
            h_ctx = modulate(ctx, m_ctx[3], m_ctx[4])
            f_ctx = conv_ffn(h_ctx, ffn_w_up[l], ffn_conv_w[l], ffn_w_down[l], 1, ctx_len)
            ctx = layer_norm(ALPHA * ctx + m_ctx[5] * f_ctx, post_ln_w[l, 1], post_ln_b[l, 1])
    return x
```

```cpp
#include <hip/hip_runtime.h>
#include <hip/hip_cooperative_groups.h>
#include <cstdio>
#include <cstdint>
namespace cg = cooperative_groups;

#ifndef MK_COOP
#define MK_COOP 1
#endif

#define DEVI __device__ __forceinline__
#define LAS __attribute__((address_space(3)))
typedef unsigned short bf16_t;
typedef short bf16x8 __attribute__((ext_vector_type(8)));
typedef float f32x4 __attribute__((ext_vector_type(4)));
typedef float f32x2 __attribute__((ext_vector_type(2)));
typedef unsigned u32x4 __attribute__((ext_vector_type(4)));
typedef unsigned u32x2 __attribute__((ext_vector_type(2)));

constexpr int DM = 1024, SEQ = 8192, CTXL = 256, NLAT = 32768, NCTX = 1024, ROWS = 33792;
constexpr int ZP = 2304;
constexpr int ZQ = 0, ZK = 128, ZV = 256, ZR = 512, ZLF = 768, ZB = 800, ZCU = 1056, ZCV = 1312, ZDA = 1568, ZDG = 1824;
constexpr int FH = 2816, UPITCH = 2048;
constexpr float ALPHA = 1.41421356237f, EPS = 1e-6f;
constexpr int LDS_BYTES = 160 * 1024;
constexpr int NCHUNK64 = 528;

constexpr size_t OFF_CTL = 0;
constexpr size_t OFF_MODS = 4096;
constexpr size_t OFF_SGUW = OFF_MODS + 2ull * 5 * 6144 * 4;
constexpr size_t OFF_POOLW = OFF_SGUW + 2ull * 4 * 128 * 128 * 2;
constexpr size_t OFF_WIN = OFF_POOLW + 2ull * 4 * 64 * 64 * 2;
constexpr size_t OFF_WOUT = OFF_WIN + 2ull * 2304 * 1024 * 2;
constexpr size_t OFF_WUP = OFF_WOUT + 2ull * 1024 * 1024 * 2;
constexpr size_t OFF_WDN = OFF_WUP + 2ull * 5632 * 1024 * 2;
constexpr size_t OFF_X = OFF_WDN + 2ull * 1024 * 2816 * 2;
constexpr size_t OFF_H = OFF_X + (size_t)ROWS * 1024 * 4;
constexpr size_t OFF_R1 = OFF_H + (size_t)ROWS * 1024 * 2;
constexpr size_t OFF_Z = OFF_R1;
constexpr size_t OFF_ST = OFF_Z + (size_t)ROWS * ZP * 2;
constexpr size_t OFF_DEC = OFF_ST + (size_t)NCHUNK64 * 8 * 2048 * 4;
constexpr size_t OFF_U = OFF_R1;
constexpr size_t OFF_ACT = OFF_U + (size_t)ROWS * UPITCH * 2;
constexpr size_t WS_END = OFF_ACT + (size_t)ROWS * 1024 * 2;

struct Params {
    const float *x, *c, *ctx, *c_ctx, *w_mod, *b_mod, *w_in, *gla_w_gate, *gla_b_gate, *gla_norm_w, *pool_w, *pool_scale, *sgu_w, *sgu_b,
        *sgu_ln_w, *sgu_ln_b, *cm_conv_w, *cm_conv_b, *cm_ln_w, *cm_ln_b, *w_out, *ffn_w_up, *ffn_conv_w, *ffn_w_down, *post_ln_w, *post_ln_b;
    float* out; unsigned char* ws;
    int wave, pad_;
};

DEVI float bf2f(unsigned v) { return __uint_as_float(v << 16); }
DEVI float bflo(unsigned v) { return __uint_as_float(v << 16); }
DEVI float bfhi(unsigned v) { return __uint_as_float(v & 0xffff0000u); }
DEVI unsigned cvt_pk_bf16(float lo, float hi) { unsigned r; asm volatile("v_cvt_pk_bf16_f32 %0, %1, %2" : "=v"(r) : "v"(lo), "v"(hi)); return r; }
DEVI bf16_t f2bf(float f) { return (bf16_t)(cvt_pk_bf16(f, 0.f) & 0xffffu); }
DEVI int my_lane() { int t; asm volatile("v_mbcnt_lo_u32_b32 %0, -1, 0\n\tv_mbcnt_hi_u32_b32 %0, -1, %0" : "=v"(t)); return t; }
DEVI int my_tid_w(int wave) { return (wave << 6) | my_lane(); }
DEVI float shx(float v, int o, int lane) { return __int_as_float(__builtin_amdgcn_ds_bpermute((lane ^ o) << 2, __float_as_int(v))); }
DEVI float wsum(float v, int lane) {
#pragma unroll
    for (int o = 32; o; o >>= 1) v += shx(v, o, lane);
    return v; }
DEVI float sigmoidf_(float x) { return 1.0f / (1.0f + __expf(-x)); }
DEVI float siluf_(float x) { return x / (1.0f + __expf(-x)); }
DEVI float geluf_(float x) { const float u = 0.7978845608f * (x + 0.044715f * x * x * x); return x / (1.0f + __expf(-2.0f * u)); }
DEVI float logsigf_(float x) { return fminf(x, 0.f) - log1pf(__expf(-fabsf(x))); }
#define MFMA16(a, b, c) __builtin_amdgcn_mfma_f32_16x16x32_bf16((a), (b), (c), 0, 0, 0)

namespace pg8 {
constexpr int BM = 256, BK = 64, HALF = 128, HTB = HALF * BK * 2, STAGE_BYTES = 8 * HTB, NXCD = 8, WGM = 8;
DEVI int lds_byte(int r, int c) { const int st = (r >> 4) * 2 + (c >> 5), rr = r & 15, cc = c & 31, ob = rr * 64 + cc * 2; return st * 1024 + (ob ^ (((ob >> 9) & 1) << 5)); }
DEVI void stage_rc(int b, int& R, int& C) { const int st = b / 1024, sb = b % 1024, swz = sb ^ (((sb >> 9) & 1) << 5); R = (st >> 1) * 16 + swz / 64; C = (st & 1) * 32 + (swz % 64) / 2; }
DEVI int perm32(int rho) { const int n = rho >> 4, i = rho & 15; return 8 * (i >> 2) + 4 * n + (i & 3); }
struct Unit { int pm, pn; };
struct Gemm { const bf16_t* A; const bf16_t* Bt; int M, N, K; };
struct StaticOrder {
    int nM, nN, nwg, G, c;
    DEVI void init(int M, int N, int G_, int c_) { nM = M / BM; nN = N / BM; nwg = nM * nN; G = G_; c = c_; }
    DEVI bool next(int i, Unit& u) const {
        const long L = (long)i * G + c; if (L >= nwg) return false;
        int wgid = (int)L; { const int q = nwg / NXCD, r = nwg % NXCD, xcd = wgid % NXCD, off = wgid / NXCD; wgid = (xcd < r ? xcd * (q + 1) : r * (q + 1) + (xcd - r) * q) + off; }
        const int nig = WGM * nN, gid = wgid / nig, fm = gid * WGM, gsz = (nM - fm) < WGM ? (nM - fm) : WGM;
        u.pm = fm + ((wgid % nig) % gsz); u.pn = (wgid % nig) / gsz; return true;
    }
    DEVI void a_ready(const Unit&) const {}
    DEVI void done(const Unit&) const {}
};

struct EpiBf16 {
    static constexpr bool PERM = true;
    bf16_t* O; int ldc;
    DEVI void operator()(const f32x4 (&acc)[2][2][4][2], const Unit& u, int wr, int wc, int, int) const {
        const int ln = my_lane(), fr = ln & 15, fq = ln >> 4;
        const int row0 = u.pm * BM + wr * 64 + fr; const int col0 = u.pn * BM + wc * 32 + 8 * fq;
#pragma unroll
        for (int ai = 0; ai < 2; ++ai)
#pragma unroll
            for (int m = 0; m < 4; ++m) { bf16_t* rowp = O + (size_t)(row0 + ai * HALF + m * 16) * ldc + col0;
#pragma unroll
                for (int bj = 0; bj < 2; ++bj) { const f32x4 v0 = acc[ai][bj][m][0], v1 = acc[ai][bj][m][1];
                    u32x4 w; w.x = cvt_pk_bf16(v0[0], v0[1]); w.y = cvt_pk_bf16(v0[2], v0[3]); w.z = cvt_pk_bf16(v1[0], v1[1]); w.w = cvt_pk_bf16(v1[2], v1[3]);
                    *(u32x4*)(rowp + bj * HALF) = w; } }
    }
};
struct EpiRes {
    static constexpr bool PERM = false;
    float* X; const float* srcL; const float* srcC; const float* mods; int goff; int mode;
    DEVI void operator()(const f32x4 (&acc)[2][2][4][2], const Unit& u, int wr, int wc, int, int) const {
        const int ln = my_lane(), fr = ln & 15, fq = ln >> 4;
        const int rowt = u.pm * BM; const int b = rowt < NLAT ? (rowt >> 13) : 4;
        float* dst = X + (size_t)rowt * DM;
        const float* src = (mode == 0) ? (rowt < NLAT ? srcL + (size_t)rowt * DM : srcC + (size_t)(rowt - NLAT) * DM) : dst;
        const float al = (mode == 0) ? ALPHA : 1.0f;
        const int rl = wr * 64 + fr;
        const int col0 = u.pn * BM + wc * 32 + 4 * fq;
        const float* gp = mods + b * 6144 + goff + col0;
        f32x4 gv[2][2];
#pragma unroll
        for (int bj = 0; bj < 2; ++bj)
#pragma unroll
            for (int n = 0; n < 2; ++n) gv[bj][n] = *(const f32x4*)(gp + bj * HALF + n * 16);
#pragma unroll
        for (int ai = 0; ai < 2; ++ai)
#pragma unroll
            for (int m = 0; m < 4; ++m) { const size_t ro = (size_t)(rl + ai * HALF + m * 16) * DM + col0;
#pragma unroll
                for (int bj = 0; bj < 2; ++bj)
#pragma unroll
                    for (int n = 0; n < 2; ++n) { const f32x4 xv = *(const f32x4*)(src + ro + bj * HALF + n * 16);
                        *(f32x4*)(dst + ro + bj * HALF + n * 16) = al * xv + gv[bj][n] * acc[ai][bj][m][n]; } }
    }
};

template <class Epi, class Sched>
DEVI void gemm_phase(LAS unsigned char* lds, const Gemm g, const Sched& S, const Epi& E, int wave) {
    const int tid = my_tid_w(wave), wid = __builtin_amdgcn_readfirstlane(tid >> 6), lane = tid & 63, wr = wid >> 2, wc = wid & 3, fr = lane & 15, fq = lane >> 4;
    const int K = g.K, nt = K / BK;
    unsigned voffA[2], voffB[2];
#pragma unroll
    for (int i = 0; i < 2; ++i) { int R, C; stage_rc(tid * 16 + i * 8192, R, C); const int Rb = Epi::PERM ? ((R & ~31) + perm32(R & 31)) : R;
        voffA[i] = (unsigned)(R * K + C) * 2u; voffB[i] = (unsigned)(Rb * K + C) * 2u; }
    const size_t kstep = (size_t)(BK * 2);
    const size_t hstep = (size_t)HALF * K * 2;
    const size_t tstep = 2 * hstep;
    const unsigned ldsw = (unsigned)wid * 1024u;
    const int aoff = lds_byte(wr * 64 + fr, fq * 8), boff = lds_byte(wc * 32 + fr, fq * 8);
#define PG8_SA(b, h) (((b) * 2 + (h)) * HTB)
#define PG8_SB(b, h) ((4 + (b) * 2 + (h)) * HTB)
#define PG8_STAGE(bufoff, gbase, voff) do { _Pragma("unroll") for (int _i = 0; _i < 2; ++_i) \
        __builtin_amdgcn_global_load_lds((const unsigned*)((const char*)(gbase) + (voff)[_i]), (LAS unsigned*)(lds + (bufoff) + ldsw + _i * 8192), 16, 0, 0); } while (0)
#define PG8_LDA(dst, b, h) do { _Pragma("unroll") for (int m = 0; m < 4; ++m) _Pragma("unroll") for (int k = 0; k < 2; ++k) dst[m][k] = *(const LAS bf16x8*)(lds + PG8_SA(b, h) + aoff + m * 2048 + k * 1024); } while (0)
#define PG8_LDB(dst, b, h) do { _Pragma("unroll") for (int n = 0; n < 2; ++n) _Pragma("unroll") for (int k = 0; k < 2; ++k) dst[n][k] = *(const LAS bf16x8*)(lds + PG8_SB(b, h) + boff + n * 2048 + k * 1024); } while (0)
#define PG8_MMA(ai, bj, At, Bt) do { __builtin_amdgcn_s_setprio(1); _Pragma("unroll") for (int m = 0; m < 4; ++m) _Pragma("unroll") for (int n = 0; n < 2; ++n) _Pragma("unroll") for (int k = 0; k < 2; ++k) \
        acc[ai][bj][m][n] = __builtin_amdgcn_mfma_f32_16x16x32_bf16(Bt[n][k], At[m][k], acc[ai][bj][m][n], 0, 0, 0); __builtin_amdgcn_s_setprio(0); } while (0)
#define PG8_WAIT_V(n) asm volatile("s_waitcnt vmcnt(" #n ")" ::: "memory")
#define PG8_WAIT_L(n) asm volatile("s_waitcnt lgkmcnt(" #n ")" ::: "memory")
#define PG8_BAR __builtin_amdgcn_s_barrier()
#define PG8_SCHED __builtin_amdgcn_sched_barrier(0)
    Unit cur, nxt; int ui = 0;
    if (!S.next(0, cur)) return;
    f32x4 acc[2][2][4][2];
#pragma unroll
    for (int a = 0; a < 2; ++a)
#pragma unroll
        for (int b = 0; b < 2; ++b)
#pragma unroll
            for (int m = 0; m < 4; ++m)
#pragma unroll
                for (int n = 0; n < 2; ++n) acc[a][b][m][n] = (f32x4){0.f, 0.f, 0.f, 0.f};
    bf16x8 At[4][2], B0[2][2], B1[2][2];
    const char* cA = (const char*)g.A + (size_t)cur.pm * tstep; const char* cB = (const char*)g.Bt + (size_t)cur.pn * tstep;
    S.a_ready(cur);
    PG8_STAGE(PG8_SB(0, 0), cB, voffB); PG8_STAGE(PG8_SA(0, 0), cA, voffA); PG8_STAGE(PG8_SB(0, 1), cB + hstep, voffB); PG8_STAGE(PG8_SA(0, 1), cA + hstep, voffA);
    if (wr == 1) PG8_BAR;
    PG8_WAIT_V(4); PG8_BAR;
    PG8_STAGE(PG8_SB(1, 0), cB + kstep, voffB); PG8_STAGE(PG8_SA(1, 0), cA + kstep, voffA); PG8_STAGE(PG8_SB(1, 1), cB + hstep + kstep, voffB);
    PG8_WAIT_V(6); PG8_BAR;
    for (;;) {
        const bool has_next = S.next(ui + 1, nxt);
        const char* nA = has_next ? (const char*)g.A + (size_t)nxt.pm * tstep : cA; const char* nB = has_next ? (const char*)g.Bt + (size_t)nxt.pn * tstep : cB;
        for (int t = 0; t < nt; t += 2) {
            const bool last = (t == nt - 2);
            const char* a1 = cA + (size_t)(t + 1) * kstep;
            const char* a2 = last ? nA : cA + (size_t)(t + 2) * kstep; const char* b2 = last ? nB : cB + (size_t)(t + 2) * kstep;
            const char* a3 = a2 + kstep; const char* b3 = b2 + kstep;
            if (last && has_next) S.a_ready(nxt);
            PG8_LDB(B0, 0, 0); PG8_SCHED; PG8_LDA(At, 0, 0); PG8_STAGE(PG8_SA(1, 1), a1 + hstep, voffA);
            PG8_WAIT_L(8); PG8_BAR; PG8_WAIT_L(0); PG8_MMA(0, 0, At, B0); PG8_BAR; PG8_SCHED;
            PG8_LDB(B1, 0, 1); PG8_STAGE(PG8_SB(0, 0), b2, voffB);
            PG8_BAR; PG8_WAIT_L(0); PG8_MMA(0, 1, At, B1); PG8_BAR;
            PG8_LDA(At, 0, 1); PG8_STAGE(PG8_SA(0, 0), a2, voffA);
            PG8_BAR; PG8_WAIT_L(0); PG8_MMA(1, 0, At, B0); PG8_BAR; PG8_SCHED;
            PG8_STAGE(PG8_SB(0, 1), b2 + hstep, voffB);
            PG8_WAIT_V(6); PG8_BAR; PG8_MMA(1, 1, At, B1); PG8_BAR;
            PG8_LDB(B0, 1, 0); PG8_SCHED; PG8_LDA(At, 1, 0); PG8_STAGE(PG8_SA(0, 1), a2 + hstep, voffA);
            PG8_WAIT_L(8); PG8_BAR; PG8_WAIT_L(0); PG8_MMA(0, 0, At, B0); PG8_BAR; PG8_SCHED;
            PG8_LDB(B1, 1, 1); PG8_STAGE(PG8_SB(1, 0), b3, voffB);
            PG8_BAR; PG8_WAIT_L(0); PG8_MMA(0, 1, At, B1); PG8_BAR;
            PG8_LDA(At, 1, 1); PG8_STAGE(PG8_SA(1, 0), a3, voffA);
            PG8_BAR; PG8_WAIT_L(0); PG8_MMA(1, 0, At, B0); PG8_BAR; PG8_SCHED;
            PG8_STAGE(PG8_SB(1, 1), b3 + hstep, voffB);
            PG8_WAIT_V(6); PG8_BAR; PG8_MMA(1, 1, At, B1); PG8_BAR;
        }
        E(acc, cur, wr, wc, fr, fq); S.done(cur);
        if (!has_next) break;
#pragma unroll
        for (int a = 0; a < 2; ++a)
#pragma unroll
            for (int b = 0; b < 2; ++b)
#pragma unroll
                for (int m = 0; m < 4; ++m)
#pragma unroll
                    for (int n = 0; n < 2; ++n) acc[a][b][m][n] = (f32x4){0.f, 0.f, 0.f, 0.f};
        cur = nxt; cA = nA; cB = nB; ++ui;
    }
    PG8_WAIT_V(0);
    if (wr == 0) PG8_BAR;
    PG8_BAR;
#undef PG8_SA
#undef PG8_SB
#undef PG8_STAGE
#undef PG8_LDA
#undef PG8_LDB
#undef PG8_MMA
#undef PG8_WAIT_V
#undef PG8_WAIT_L
#undef PG8_BAR
#undef PG8_SCHED
}
}

DEVI void transpose_tile(int wave, float* tile, const float* src, int ld_src, int k0, int n0s, int nvalid, bf16_t* dst, int ld_dst, int n0d, int k0d) {
    const int tid = my_tid_w(wave);
#pragma unroll
    for (int i = 0; i < 8; ++i) { const int kk = i * 8 + (tid >> 6), nn = tid & 63; const int col = n0s + nn;
        tile[kk * 65 + nn] = (col < nvalid) ? src[(size_t)(k0 + kk) * ld_src + col] : 0.f; }
    __syncthreads();
#pragma unroll
    for (int i = 0; i < 8; ++i) { const int nn = i * 8 + (tid >> 6), kk = tid & 63; dst[(size_t)(n0d + nn) * ld_dst + k0d + kk] = f2bf(tile[kk * 65 + nn]); }
    __syncthreads();
}

DEVI void mods_item(float* lf, const Params& p, int item) {
    const int tid = my_tid_w(p.wave); const int l = item / 96, cgp = item % 96;
    float* s = lf;
    float* red = lf + 5120;
    for (int i = tid; i < 5120; i += 512) { const int r = i >> 10, k = i & 1023; const float v = (r < 4) ? p.c[r * 1024 + k] : p.c_ctx[k]; s[i] = siluf_(v); }
    __syncthreads();
    const int cc = tid & 63, kg = tid >> 6; const int col = cgp * 64 + cc;
    const float* W = p.w_mod + (size_t)l * 1024 * 6144 + col;
    float a0 = 0.f, a1 = 0.f, a2 = 0.f, a3 = 0.f, a4 = 0.f;
#pragma unroll 8
    for (int k = kg * 128; k < kg * 128 + 128; ++k) { const float w = W[(size_t)k * 6144];
        a0 += s[k] * w; a1 += s[1024 + k] * w; a2 += s[2048 + k] * w; a3 += s[3072 + k] * w; a4 += s[4096 + k] * w; }
    red[(kg * 5 + 0) * 64 + cc] = a0; red[(kg * 5 + 1) * 64 + cc] = a1; red[(kg * 5 + 2) * 64 + cc] = a2; red[(kg * 5 + 3) * 64 + cc] = a3; red[(kg * 5 + 4) * 64 + cc] = a4;
    __syncthreads();
    if (tid < 320) { const int r = tid >> 6, c2 = tid & 63; float sum = p.b_mod[l * 6144 + cgp * 64 + c2];
#pragma unroll
        for (int q = 0; q < 8; ++q) sum += red[(q * 5 + r) * 64 + c2];
        ((float*)(p.ws + OFF_MODS))[(l * 5 + r) * 6144 + cgp * 64 + c2] = sum; }
    __syncthreads();
}

__constant__ int c_cu0[3] = {0, 8, 15};
__constant__ int c_cnu[3] = {8, 7, 7};

DEVI void prep_phase(unsigned char* lds, const Params& p) {
    float* lf = (float*)lds;
    const int T_IN = 16 * 36, T_OUT = 256, T_UP = 16 * 88, T_DN = 44 * 16, T_L = T_IN + T_OUT + T_UP + T_DN;
    const int N_MODS = 192, N_TR = 2 * T_L, N_SGU = 32, N_POOL = 8;
    const int total = N_MODS + N_TR + N_SGU + N_POOL;
    for (int item = blockIdx.x; item < total; item += gridDim.x) {
        if (item < N_MODS) { mods_item(lf, p, item); continue; }
        int it = item - N_MODS;
        if (it < N_TR) {
            const int l = it / T_L; int r = it % T_L;
            if (r < T_IN) { const int kt = r / 36, ntl = r % 36;
                transpose_tile(p.wave, lf, p.w_in + (size_t)l * 1024 * 2080, 2080, kt * 64, ntl * 64, 2080, (bf16_t*)(p.ws + OFF_WIN) + (size_t)l * 2304 * 1024, 1024, ntl * 64, kt * 64); continue; }
            r -= T_IN;
            if (r < T_OUT) { const int kt = r / 16, ntl = r % 16;
                transpose_tile(p.wave, lf, p.w_out + (size_t)l * 1024 * 1024, 1024, kt * 64, ntl * 64, 1024, (bf16_t*)(p.ws + OFF_WOUT) + (size_t)l * 1024 * 1024, 1024, ntl * 64, kt * 64); continue; }
            r -= T_OUT;
            if (r < T_UP) { const int kt = r / 88, ntl = r % 88; const int n0d = ntl * 64; const int unit = n0d >> 8, sgn = (n0d >> 7) & 1, j0 = n0d & 127;
                transpose_tile(p.wave, lf, p.ffn_w_up + (size_t)l * 1024 * 5632, 5632, kt * 64, sgn * FH + unit * 128 + j0, 5632, (bf16_t*)(p.ws + OFF_WUP) + (size_t)l * 5632 * 1024, 1024, n0d, kt * 64); continue; }
            r -= T_UP;
            { const int kt = r / 16, ntl = r % 16; const int k0 = kt * 64; const int unit = k0 >> 7; const int ch = unit < 8 ? 0 : (unit < 15 ? 1 : 2); const int u0 = c_cu0[ch], kc = c_cnu[ch] * 128;
                transpose_tile(p.wave, lf, p.ffn_w_down + (size_t)l * FH * 1024, 1024, k0, ntl * 64, 1024, (bf16_t*)(p.ws + OFF_WDN) + (size_t)l * 1024 * FH + (size_t)u0 * 128 * 1024, kc, ntl * 64, k0 - u0 * 128); continue; }
        }
        it -= N_TR;
        if (it < N_SGU) { bf16_t* d = (bf16_t*)(p.ws + OFF_SGUW); const int base = it * 4096;
#pragma unroll
            for (int i = 0; i < 8; ++i) { const int idx = base + i * 512 + my_tid_w(p.wave); d[idx] = f2bf(p.sgu_w[idx]); }
            continue; }
        it -= N_SGU;
        { transpose_tile(p.wave, lf, p.pool_w + (size_t)it * 4096, 64, 0, 0, 64, (bf16_t*)(p.ws + OFF_POOLW) + (size_t)it * 4096, 64, 0, 0); }
    }
}

DEVI void ln_phase(int wave, const float* srcL, const float* srcC, int nrows, const float* lnw, const float* lnb, float* dstX, float* dstOut, const float* mods, int soff, bf16_t* H) {
    const int lane = my_lane(), wid = wave;
    for (int r = blockIdx.x * 8 + wid; r < nrows; r += gridDim.x * 8) {
        const float* src = r < NLAT ? srcL + (size_t)r * DM : srcC + (size_t)(r - NLAT) * DM;
        f32x4 v[4];
#pragma unroll
        for (int i = 0; i < 4; ++i) v[i] = *(const f32x4*)(src + i * 256 + lane * 4);
        float s = 0.f;
#pragma unroll
        for (int i = 0; i < 4; ++i) s += v[i][0] + v[i][1] + v[i][2] + v[i][3];
        float mean = wsum(s, lane) * (1.0f / 1024.0f);
        float q = 0.f;
#pragma unroll
        for (int i = 0; i < 4; ++i) { v[i] -= mean; q += v[i][0] * v[i][0] + v[i][1] * v[i][1] + v[i][2] * v[i][2] + v[i][3] * v[i][3]; }
        float rstd = rsqrtf(wsum(q, lane) * (1.0f / 1024.0f) + EPS);
        if (lnw) {
#pragma unroll
            for (int i = 0; i < 4; ++i) { const f32x4 w = *(const f32x4*)(lnw + i * 256 + lane * 4), b = *(const f32x4*)(lnb + i * 256 + lane * 4); v[i] = v[i] * rstd * w + b; }
            if (dstX) {
#pragma unroll
                for (int i = 0; i < 4; ++i) *(f32x4*)(dstX + (size_t)r * DM + i * 256 + lane * 4) = v[i]; }
            if (dstOut && r < NLAT) {
#pragma unroll
                for (int i = 0; i < 4; ++i) *(f32x4*)(dstOut + (size_t)r * DM + i * 256 + lane * 4) = v[i]; }
            if (mods) {
                s = 0.f;
#pragma unroll
                for (int i = 0; i < 4; ++i) s += v[i][0] + v[i][1] + v[i][2] + v[i][3];
                mean = wsum(s, lane) * (1.0f / 1024.0f); q = 0.f;
#pragma unroll
                for (int i = 0; i < 4; ++i) { v[i] -= mean; q += v[i][0] * v[i][0] + v[i][1] * v[i][1] + v[i][2] * v[i][2] + v[i][3] * v[i][3]; }
                rstd = rsqrtf(wsum(q, lane) * (1.0f / 1024.0f) + EPS);
            }
        }
        if (mods) {
            const int b = r < NLAT ? (r >> 13) : 4; const float* mp = mods + b * 6144 + soff;
#pragma unroll
            for (int i = 0; i < 4; ++i) { const f32x4 sh = *(const f32x4*)(mp + i * 256 + lane * 4), sc = *(const f32x4*)(mp + 1024 + i * 256 + lane * 4);
                const f32x4 h = v[i] * rstd * (1.0f + sc) + sh;
                u32x2 w; w.x = cvt_pk_bf16(h[0], h[1]); w.y = cvt_pk_bf16(h[2], h[3]);
                *(u32x2*)(H + (size_t)r * DM + i * 256 + lane * 4) = w; }
        }
    }
}

struct Tile { int row0, T0, L; };
DEVI Tile tile_of(int t, int tl) {
    const int nlat = NLAT / tl; Tile r;
    if (t < nlat) { r.row0 = t * tl; r.T0 = r.row0 & (SEQ - 1); r.L = SEQ; }
    else { const int q = (t - nlat) * tl; r.row0 = NLAT + q; r.T0 = q & (CTXL - 1); r.L = CTXL; }
    return r;
}

DEVI void pool_item(unsigned char* lds, const Params& p, int l, const Tile tl) {
    const int tid = my_tid_w(p.wave), wid = tid >> 6, lane = tid & 63, fr = lane & 15, fq = lane >> 4;
    bf16_t* zs = (bf16_t*)lds;
    bf16_t* ys = (bf16_t*)(lds + 80 * 256 * 2);
    const bf16_t* z = (const bf16_t*)(p.ws + OFF_Z);
    bf16_t* ycat = (bf16_t*)(p.ws + OFF_H);
    for (int i = tid; i < 80 * 32; i += 512) { const int r = i >> 5, c8 = i & 31; const int T = tl.T0 - 8 + r; u32x4 v = (u32x4){0u, 0u, 0u, 0u};
        if (T >= 0 && T < tl.L) v = *(const u32x4*)(z + (size_t)(tl.row0 - 8 + r) * ZP + ZB + c8 * 8);
        *(u32x4*)(zs + r * 256 + c8 * 8) = v; }
    __syncthreads();
    { const int c2 = tid & 127, tq = tid >> 7; const int ch = c2 * 2; const int g = ch >> 6; const int hw = 1 << g;
#pragma unroll 1
        for (int tt = 0; tt < 16; ++tt) { const int t = tq * 16 + tt; const int T = tl.T0 + t; const int lo = max(T - hw, 0), hi = min(T + hw, tl.L);
            float s0 = 0.f, s1 = 0.f;
            for (int q = lo; q < hi; ++q) { const unsigned v = *(const unsigned*)(zs + (q - tl.T0 + 8) * 256 + ch); s0 += bflo(v); s1 += bfhi(v); }
            const float inv = 1.0f / (float)(hi - lo); const unsigned xv = *(const unsigned*)(zs + (t + 8) * 256 + ch);
            *(unsigned*)(ys + t * 264 + ch) = cvt_pk_bf16(s0 * inv - bflo(xv), s1 * inv - bfhi(xv)); } }
    __syncthreads();
    { const int g = wid >> 1; const bf16_t* Wt = (const bf16_t*)(p.ws + OFF_POOLW) + (size_t)(l * 4 + g) * 4096;
#pragma unroll
        for (int mi = 0; mi < 2; ++mi) { const int mt = (wid & 1) * 2 + mi; const int t = mt * 16 + fr;
            const bf16x8 a0 = *(const bf16x8*)(ys + t * 264 + g * 64 + fq * 8), a1 = *(const bf16x8*)(ys + t * 264 + g * 64 + 32 + fq * 8);
#pragma unroll
            for (int nt = 0; nt < 4; ++nt) { const bf16x8 b0 = *(const bf16x8*)(Wt + (nt * 16 + fr) * 64 + fq * 8), b1 = *(const bf16x8*)(Wt + (nt * 16 + fr) * 64 + 32 + fq * 8);
                f32x4 acc = (f32x4){0.f, 0.f, 0.f, 0.f}; acc = MFMA16(b0, a0, acc); acc = MFMA16(b1, a1, acc);
                const int col = g * 64 + nt * 16 + 4 * fq; const f32x4 sc = *(const f32x4*)(p.pool_scale + l * 256 + col); acc *= sc;
                u32x2 w; w.x = cvt_pk_bf16(acc[0], acc[1]); w.y = cvt_pk_bf16(acc[2], acc[3]);
                *(u32x2*)(ycat + (size_t)(tl.row0 + t) * DM + 256 + col) = w; } } }
    __syncthreads();
}

DEVI void sgu_item(unsigned char* lds, const Params& p, int l, const Tile tl) {
    const int tid = my_tid_w(p.wave), wid = tid >> 6, lane = tid & 63, fr = lane & 15, fq = lane >> 4;
    bf16_t* vT = (bf16_t*)lds;
    const bf16_t* z = (const bf16_t*)(p.ws + OFF_Z);
    bf16_t* ycat = (bf16_t*)(p.ws + OFF_H);
    { const f32x4 lw = *(const f32x4*)(p.sgu_ln_w + l * 256 + lane * 4), lb = *(const f32x4*)(p.sgu_ln_b + l * 256 + lane * 4);
#pragma unroll 2
        for (int i = 0; i < 16; ++i) { const int s = wid * 16 + i; const u32x2 raw = *(const u32x2*)(z + (size_t)(tl.row0 + s) * ZP + ZCV + lane * 4);
            f32x4 v; v[0] = geluf_(bflo(raw.x)); v[1] = geluf_(bfhi(raw.x)); v[2] = geluf_(bflo(raw.y)); v[3] = geluf_(bfhi(raw.y));
            const float mean = wsum(v[0] + v[1] + v[2] + v[3], lane) * (1.0f / 256.0f); v -= mean;
            const float rstd = rsqrtf(wsum(v[0] * v[0] + v[1] * v[1] + v[2] * v[2] + v[3] * v[3], lane) * (1.0f / 256.0f) + EPS);
            v = v * rstd * lw + lb;
#pragma unroll
            for (int j = 0; j < 4; ++j) vT[(lane * 4 + j) * 136 + s] = f2bf(v[j]); } }
    __syncthreads();
    { const int h = wid >> 1; const bf16_t* W = (const bf16_t*)(p.ws + OFF_SGUW) + (size_t)(l * 4 + h) * 16384;
#pragma unroll 1
        for (int mi = 0; mi < 4; ++mi) { const int mt = (wid & 1) * 4 + mi; const int t = mt * 16 + fr;
            bf16x8 a[4];
#pragma unroll
            for (int ks = 0; ks < 4; ++ks) a[ks] = *(const bf16x8*)(W + t * 128 + ks * 32 + fq * 8);
            const float bias = p.sgu_b[(l * 4 + h) * 128 + t];
#pragma unroll
            for (int nt = 0; nt < 4; ++nt) { f32x4 acc = (f32x4){0.f, 0.f, 0.f, 0.f};
#pragma unroll
                for (int ks = 0; ks < 4; ++ks) { const bf16x8 b = *(const bf16x8*)(vT + (h * 64 + nt * 16 + fr) * 136 + ks * 32 + fq * 8); acc = MFMA16(b, a[ks], acc); }
                const int col = h * 64 + nt * 16 + 4 * fq; const u32x2 raw = *(const u32x2*)(z + (size_t)(tl.row0 + t) * ZP + ZCU + col);
                const float o0 = geluf_(bflo(raw.x)) * (acc[0] + bias), o1 = geluf_(bfhi(raw.x)) * (acc[1] + bias), o2 = geluf_(bflo(raw.y)) * (acc[2] + bias), o3 = geluf_(bfhi(raw.y)) * (acc[3] + bias);
                u32x2 w; w.x = cvt_pk_bf16(o0, o1); w.y = cvt_pk_bf16(o2, o3);
                *(u32x2*)(ycat + (size_t)(tl.row0 + t) * DM + 512 + col) = w; } } }
    __syncthreads();
}

DEVI void cm_item(unsigned char* lds, const Params& p, int l, const Tile tl) {
    const int tid = my_tid_w(p.wave), wid = tid >> 6, lane = tid & 63;
    float* yg = (float*)lds;
    const bf16_t* z = (const bf16_t*)(p.ws + OFF_Z);
    bf16_t* ycat = (bf16_t*)(p.ws + OFF_H);
#pragma unroll 2
    for (int i = tid; i < 94 * 64; i += 512) { const int r = i >> 6, c4 = (i & 63) * 4; const int T = tl.T0 - 15 + r; f32x4 o = (f32x4){0.f, 0.f, 0.f, 0.f};
        if (T >= 0 && T < tl.L) { const bf16_t* zp = z + (size_t)(tl.row0 - 15 + r) * ZP; const u32x2 a = *(const u32x2*)(zp + ZDA + c4), g = *(const u32x2*)(zp + ZDG + c4);
            o[0] = bflo(a.x) * sigmoidf_(bflo(g.x)); o[1] = bfhi(a.x) * sigmoidf_(bfhi(g.x)); o[2] = bflo(a.y) * sigmoidf_(bflo(g.y)); o[3] = bfhi(a.y) * sigmoidf_(bfhi(g.y)); }
        *(f32x4*)(yg + r * 256 + c4) = o; }
    __syncthreads();
    const int c = tid & 255, th = tid >> 8;
    float* yo = (float*)(lds + 94 * 256 * 4);
    { float w[31];
#pragma unroll
        for (int j = 0; j < 31; ++j) w[j] = p.cm_conv_w[(l * 31 + j) * 256 + c];
        const float cb = p.cm_conv_b[l * 256 + c];
#pragma unroll 1
        for (int bt = 0; bt < 8; ++bt) { float in[34];
#pragma unroll
            for (int i = 0; i < 34; ++i) in[i] = yg[(th * 32 + bt * 4 + i) * 256 + c];
            float s0 = cb, s1 = cb, s2 = cb, s3 = cb;
#pragma unroll
            for (int j = 0; j < 31; ++j) { s0 += in[j] * w[j]; s1 += in[j + 1] * w[j]; s2 += in[j + 2] * w[j]; s3 += in[j + 3] * w[j]; }
            float* op = yo + (th * 32 + bt * 4) * 256 + c; op[0] = s0; op[256] = s1; op[512] = s2; op[768] = s3; } }
    __syncthreads();
    { const f32x4 lw = *(const f32x4*)(p.cm_ln_w + l * 256 + lane * 4), lb = *(const f32x4*)(p.cm_ln_b + l * 256 + lane * 4);
#pragma unroll 2
        for (int i = 0; i < 8; ++i) { const int t = wid * 8 + i; f32x4 v = *(const f32x4*)(yo + t * 256 + lane * 4);
            const float mean = wsum(v[0] + v[1] + v[2] + v[3], lane) * (1.0f / 256.0f); v -= mean;
            const float rstd = rsqrtf(wsum(v[0] * v[0] + v[1] * v[1] + v[2] * v[2] + v[3] * v[3], lane) * (1.0f / 256.0f) + EPS);
            v = v * rstd * lw + lb;
            u32x2 w; w.x = cvt_pk_bf16(siluf_(v[0]), siluf_(v[1])); w.y = cvt_pk_bf16(siluf_(v[2]), siluf_(v[3]));
            *(u32x2*)(ycat + (size_t)(tl.row0 + t) * DM + 768 + lane * 4) = w; } }
    __syncthreads();
}

constexpr int GL_G = 0, GL_WG = 32768, GL_BG = 40960, GL_LOW = 41472, GL_VT = 49664, GL_QIN = 86528, GL_KIN = 103936, GL_STT = 121344, GL_KD = 86528;

DEVI void gla_load_common(int wave, unsigned char* lds, const bf16_t* z, const Tile tl) {
    const int tid = my_tid_w(wave);
    float* low = (float*)(lds + GL_LOW); bf16_t* vT = (bf16_t*)(lds + GL_VT);
    if (tid < 256) { const int t = tid >> 2, part = tid & 3; const u32x4 v = *(const u32x4*)(z + (size_t)(tl.row0 + t) * ZP + ZLF + part * 8);
        float* d = low + t * 32 + part * 8; d[0] = bflo(v.x); d[1] = bfhi(v.x); d[2] = bflo(v.y); d[3] = bfhi(v.y); d[4] = bflo(v.z); d[5] = bfhi(v.z); d[6] = bflo(v.w); d[7] = bfhi(v.w); }
#pragma unroll 1
    for (int i = tid; i < 64 * 32; i += 512) { const int t = i >> 5, c8 = (i & 31) * 8; const u32x4 v = *(const u32x4*)(z + (size_t)(tl.row0 + t) * ZP + ZV + c8);
        vT[(c8 + 0) * 72 + t] = (bf16_t)(v.x & 0xffffu); vT[(c8 + 1) * 72 + t] = (bf16_t)(v.x >> 16); vT[(c8 + 2) * 72 + t] = (bf16_t)(v.y & 0xffffu); vT[(c8 + 3) * 72 + t] = (bf16_t)(v.y >> 16);
        vT[(c8 + 4) * 72 + t] = (bf16_t)(v.z & 0xffffu); vT[(c8 + 5) * 72 + t] = (bf16_t)(v.z >> 16); vT[(c8 + 6) * 72 + t] = (bf16_t)(v.w & 0xffffu); vT[(c8 + 7) * 72 + t] = (bf16_t)(v.w >> 16); }
}
DEVI void gla_gates(unsigned char* lds, const Params& p, int l, int dir) {
    const int tid = my_tid_w(p.wave);
    float* G = (float*)(lds + GL_G); float* WG = (float*)(lds + GL_WG); float* BG = (float*)(lds + GL_BG); const float* low = (const float*)(lds + GL_LOW);
    *(f32x4*)(WG + tid * 4) = *(const f32x4*)(p.gla_w_gate + (size_t)(l * 2 + dir) * 2048 + tid * 4);
    if (tid < 128) BG[tid] = p.gla_b_gate[(l * 2 + dir) * 128 + tid];
    __syncthreads();
    { const int t = tid >> 3, cgp = tid & 7; float lv[16];
#pragma unroll
        for (int r = 0; r < 16; ++r) lv[r] = low[t * 32 + dir * 16 + r];
#pragma unroll
        for (int j = 0; j < 16; ++j) { const int col = cgp * 16 + j; float a = BG[col];
#pragma unroll
            for (int r = 0; r < 16; ++r) a += lv[r] * WG[r * 128 + col];
            G[t * 128 + col] = fmaxf(logsigf_(a) * (1.0f / 16.0f), -1.0f); } }
    __syncthreads();
    if (tid < 128) { float run = 0.f;
        if (dir == 0) {
#pragma unroll 4
            for (int t = 0; t < 64; ++t) { run += G[t * 128 + tid]; G[t * 128 + tid] = run; } }
        else {
#pragma unroll 4
            for (int t = 63; t >= 0; --t) { run += G[t * 128 + tid]; G[t * 128 + tid] = run; } } }
    __syncthreads();
}

DEVI void gla_sum_item(unsigned char* lds, const Params& p, int l, const Tile tl) {
    const int tid = my_tid_w(p.wave), wid = tid >> 6, lane = tid & 63, fr = lane & 15, fq = lane >> 4;
    const bf16_t* z = (const bf16_t*)(p.ws + OFF_Z);
    float* ST = (float*)(p.ws + OFF_ST); float* DEC = (float*)(p.ws + OFF_DEC);
    const float* G = (const float*)(lds + GL_G); bf16_t* KD = (bf16_t*)(lds + GL_KD); const bf16_t* vT = (const bf16_t*)(lds + GL_VT);
    const int cid = tl.row0 >> 6;
    gla_load_common(p.wave, lds, z, tl);
    for (int dir = 0; dir < 2; ++dir) {
        gla_gates(lds, p, l, dir);
        { const int col = tid & 127, tq = tid >> 7; const float cl = G[(dir ? 0 : 63) * 128 + col];
#pragma unroll 4
            for (int tt = 0; tt < 16; ++tt) { const int t = tq * 16 + tt; const float k = bf2f(z[(size_t)(tl.row0 + t) * ZP + ZK + col]);
                KD[col * 72 + t] = f2bf(k * __expf(cl - G[t * 128 + col])); }
            if (tid < 128) DEC[((size_t)(cid * 4 + (col >> 5)) * 2 + dir) * 32 + (col & 31)] = __expf(cl); }
        __syncthreads();
        { const int h = wid >> 1, mt = wid & 1;
            const bf16x8 a0 = *(const bf16x8*)(KD + (h * 32 + mt * 16 + fr) * 72 + fq * 8), a1 = *(const bf16x8*)(KD + (h * 32 + mt * 16 + fr) * 72 + 32 + fq * 8);
#pragma unroll
            for (int nt = 0; nt < 4; ++nt) { const bf16x8 b0 = *(const bf16x8*)(vT + (h * 64 + nt * 16 + fr) * 72 + fq * 8), b1 = *(const bf16x8*)(vT + (h * 64 + nt * 16 + fr) * 72 + 32 + fq * 8);
                f32x4 acc = (f32x4){0.f, 0.f, 0.f, 0.f}; acc = MFMA16(b0, a0, acc); acc = MFMA16(b1, a1, acc);
                *(f32x4*)(ST + ((size_t)(cid * 4 + h) * 2 + dir) * 2048 + (mt * 16 + fr) * 64 + nt * 16 + 4 * fq) = acc; } }
        __syncthreads();
    }
}

DEVI void gla_scan_phase(const Params& p) {
    float* ST = (float*)(p.ws + OFF_ST); const float* DEC = (const float*)(p.ws + OFF_DEC);
    for (int gt = blockIdx.x * 512 + my_tid_w(p.wave); gt < 65536; gt += gridDim.x * 512) {
        const int chain = gt >> 11, e = gt & 2047; const int dir = chain & 1, h = (chain >> 1) & 3, b = chain >> 3; const int d = e >> 6;
        float S = 0.f;
        for (int s0 = 0; s0 < 132; s0 += 12) {
            float kv[12], dc[12];
#pragma unroll
            for (int j = 0; j < 12; ++j) { const int s = s0 + j; const int cid = (s < 4) ? (512 + b * 4 + (dir ? 3 - s : s)) : (b * 128 + (dir ? 131 - s : s - 4));
                const size_t slot = (size_t)(cid * 4 + h) * 2 + dir; kv[j] = ST[slot * 2048 + e]; dc[j] = DEC[slot * 32 + d]; }
#pragma unroll
            for (int j = 0; j < 12; ++j) { const int s = s0 + j; const int cid = (s < 4) ? (512 + b * 4 + (dir ? 3 - s : s)) : (b * 128 + (dir ? 131 - s : s - 4));
                const size_t slot = (size_t)(cid * 4 + h) * 2 + dir; ST[slot * 2048 + e] = S; S = dc[j] * S + kv[j]; }
        }
    }
}

DEVI void gla_out_item(unsigned char* lds, const Params& p, int l, const Tile tl) {
    const int tid = my_tid_w(p.wave), wid = tid >> 6, lane = tid & 63, fr = lane & 15, fq = lane >> 4;
    const bf16_t* z = (const bf16_t*)(p.ws + OFF_Z);
    bf16_t* ycat = (bf16_t*)(p.ws + OFF_H);
    const float* ST = (const float*)(p.ws + OFF_ST);
    const float* G = (const float*)(lds + GL_G); bf16_t* QIN = (bf16_t*)(lds + GL_QIN); bf16_t* KIN = (bf16_t*)(lds + GL_KIN); bf16_t* STT = (bf16_t*)(lds + GL_STT);
    const bf16_t* vT = (const bf16_t*)(lds + GL_VT); bf16_t* AB = (bf16_t*)(lds + GL_G) + wid * 2304;
    const int cid = tl.row0 >> 6; const int h = wid >> 1, half = wid & 1;
    gla_load_common(p.wave, lds, z, tl);
    f32x4 o[2][4];
#pragma unroll
    for (int mi = 0; mi < 2; ++mi)
#pragma unroll
        for (int nt = 0; nt < 4; ++nt) o[mi][nt] = (f32x4){0.f, 0.f, 0.f, 0.f};
    for (int dir = 0; dir < 2; ++dir) {
        gla_gates(lds, p, l, dir);
        { const int col = tid & 127, tq = tid >> 7;
#pragma unroll 2
            for (int tt = 0; tt < 16; ++tt) { const int t = tq * 16 + tt; const float cum = G[t * 128 + col];
                const float q = bf2f(z[(size_t)(tl.row0 + t) * ZP + ZQ + col]) * 0.17677669529663687f * __expf(cum);
                const float k = bf2f(z[(size_t)(tl.row0 + t) * ZP + ZK + col]) * __expf(-cum);
                QIN[t * 136 + col] = f2bf(q); KIN[t * 136 + col] = f2bf(k); }
#pragma unroll 1
            for (int i = tid; i < 2048; i += 512) { const int hh = i >> 9, rem = i & 511; const int dd = rem >> 4, e4 = (rem & 15) * 4;
                const f32x4 v = *(const f32x4*)(ST + ((size_t)(cid * 4 + hh) * 2 + dir) * 2048 + dd * 64 + e4);
#pragma unroll
                for (int j = 0; j < 4; ++j) STT[(hh * 64 + e4 + j) * 40 + dd] = f2bf(v[j]); } }
        __syncthreads();
#pragma unroll
        for (int mi = 0; mi < 2; ++mi) { const int t = (half * 2 + mi) * 16 + fr; const bf16x8 qa = *(const bf16x8*)(QIN + t * 136 + h * 32 + fq * 8);
#pragma unroll
            for (int st = 0; st < 4; ++st) { const bf16x8 kb = *(const bf16x8*)(KIN + (st * 16 + fr) * 136 + h * 32 + fq * 8);
                f32x4 acc = (f32x4){0.f, 0.f, 0.f, 0.f}; acc = MFMA16(kb, qa, acc);
                const int s0 = st * 16 + 4 * fq;
#pragma unroll
                for (int j = 0; j < 4; ++j) { const int s = s0 + j; const bool keep = dir ? (s >= t) : (s <= t); acc[j] = keep ? acc[j] : 0.f; }
                u32x2 w; w.x = cvt_pk_bf16(acc[0], acc[1]); w.y = cvt_pk_bf16(acc[2], acc[3]);
                *(u32x2*)(AB + (mi * 16 + fr) * 72 + s0) = w; } }
        __syncthreads();
#pragma unroll
        for (int mi = 0; mi < 2; ++mi) { const int t = (half * 2 + mi) * 16 + fr;
            const bf16x8 aa0 = *(const bf16x8*)(AB + (mi * 16 + fr) * 72 + fq * 8), aa1 = *(const bf16x8*)(AB + (mi * 16 + fr) * 72 + 32 + fq * 8);
            const bf16x8 qa = *(const bf16x8*)(QIN + t * 136 + h * 32 + fq * 8);
#pragma unroll
            for (int nt = 0; nt < 4; ++nt) { const int er = h * 64 + nt * 16 + fr;
                const bf16x8 vb0 = *(const bf16x8*)(vT + er * 72 + fq * 8), vb1 = *(const bf16x8*)(vT + er * 72 + 32 + fq * 8), sb = *(const bf16x8*)(STT + er * 40 + fq * 8);
                o[mi][nt] = MFMA16(vb0, aa0, o[mi][nt]); o[mi][nt] = MFMA16(vb1, aa1, o[mi][nt]); o[mi][nt] = MFMA16(sb, qa, o[mi][nt]); } }
        __syncthreads();
    }
#pragma unroll
    for (int mi = 0; mi < 2; ++mi) { const int t = (half * 2 + mi) * 16 + fr; float ss = 0.f;
#pragma unroll
        for (int nt = 0; nt < 4; ++nt) ss += o[mi][nt][0] * o[mi][nt][0] + o[mi][nt][1] * o[mi][nt][1] + o[mi][nt][2] * o[mi][nt][2] + o[mi][nt][3] * o[mi][nt][3];
        ss += shx(ss, 16, lane); ss += shx(ss, 32, lane);
        const float rs = rsqrtf(ss * (1.0f / 64.0f) + EPS);
#pragma unroll
        for (int nt = 0; nt < 4; ++nt) { const int col = h * 64 + nt * 16 + 4 * fq; const f32x4 nw = *(const f32x4*)(p.gla_norm_w + l * 256 + col);
            const u32x2 raw = *(const u32x2*)(z + (size_t)(tl.row0 + t) * ZP + ZR + col);
            const float v0 = o[mi][nt][0] * rs * nw[0] * siluf_(bflo(raw.x)), v1 = o[mi][nt][1] * rs * nw[1] * siluf_(bfhi(raw.x)), v2 = o[mi][nt][2] * rs * nw[2] * siluf_(bflo(raw.y)), v3 = o[mi][nt][3] * rs * nw[3] * siluf_(bfhi(raw.y));
            u32x2 w; w.x = cvt_pk_bf16(v0, v1); w.y = cvt_pk_bf16(v2, v3);
            *(u32x2*)(ycat + (size_t)(tl.row0 + t) * DM + col) = w; } }
    __syncthreads();
}

DEVI void mix_phase(unsigned char* lds, const Params& p, int l) {
    const int n64 = (l == 0) ? 528 : 512, n128 = (l == 0) ? 264 : 256;
    const int nD = n64, nS = 528, nB = n64, nC = n128;
    const int total = nD + nS + nB + nC;
    for (int item = blockIdx.x; item < total; item += gridDim.x) {
        int it = item;
        if (it < nD) { cm_item(lds, p, l, tile_of(it, 64)); continue; }
        it -= nD;
        if (it < nS) { gla_sum_item(lds, p, l, tile_of(it, 64)); continue; }
        it -= nS;
        if (it < nB) { pool_item(lds, p, l, tile_of(it, 64)); continue; }
        it -= nB;
        sgu_item(lds, p, l, tile_of(it, 128));
    }
}
DEVI void gla_out_phase(unsigned char* lds, const Params& p, int l) {
    const int n64 = (l == 0) ? 528 : 512;
    for (int item = blockIdx.x; item < n64; item += gridDim.x) gla_out_item(lds, p, l, tile_of(item, 64));
}

DEVI void ffnconv_phase(unsigned char* lds, const Params& p, int l, int chunk) {
    const int tid = my_tid_w(p.wave); const int nu = c_cnu[chunk], u0 = c_cu0[chunk]; const int kc = nu * 128;
    const int ntile = (l == 0) ? 528 : 512;
    float* wl = (float*)lds;
    const bf16_t* U = (const bf16_t*)(p.ws + OFF_U); bf16_t* ACT = (bf16_t*)(p.ws + OFF_ACT);
    for (int item = blockIdx.x; item < nu * ntile; item += gridDim.x) {
        const int uu = item / ntile, rt = item % ntile; const Tile tl = tile_of(rt, 64);
        for (int i = tid; i < 9 * 256; i += 512) { const int tap = i >> 8, cc = i & 255; const int sgn = cc >> 7, jj = cc & 127;
            wl[i] = p.ffn_conv_w[((size_t)l * 9 + tap) * 5632 + sgn * FH + (u0 + uu) * 128 + jj]; }
        __syncthreads();
        const int tok = tid >> 3, cg8 = tid & 7; const bool lat = tl.L == SEQ; const int gr = tl.T0 >> 6;
        float aA[16], aG[16];
#pragma unroll
        for (int j = 0; j < 16; ++j) { aA[j] = 0.f; aG[j] = 0.f; }
#pragma unroll
        for (int dr = 0; dr < 3; ++dr)
#pragma unroll
            for (int dc = 0; dc < 3; ++dc) {
                bool valid; int nrow;
                if (lat) { const int rr = gr + dr - 1, cc = tok + dc - 1; valid = rr >= 0 && rr < 128 && cc >= 0 && cc < 64; nrow = tl.row0 + (dr - 1) * 64 + cc; }
                else { const int cc = tl.T0 + tok + dc - 1; valid = (dr == 1) && cc >= 0 && cc < CTXL; nrow = tl.row0 + tok + dc - 1; }
                if (valid) { const bf16_t* up = U + (size_t)nrow * UPITCH + uu * 256 + cg8 * 16; const float* wa = wl + (dr * 3 + dc) * 256 + cg8 * 16;
                    const u32x4 a0 = *(const u32x4*)up, a1 = *(const u32x4*)(up + 8), g0 = *(const u32x4*)(up + 128), g1 = *(const u32x4*)(up + 136);
                    const unsigned av[8] = {a0.x, a0.y, a0.z, a0.w, a1.x, a1.y, a1.z, a1.w}; const unsigned gv[8] = {g0.x, g0.y, g0.z, g0.w, g1.x, g1.y, g1.z, g1.w};
#pragma unroll
                    for (int q = 0; q < 8; ++q) { aA[2 * q] += bflo(av[q]) * wa[2 * q]; aA[2 * q + 1] += bfhi(av[q]) * wa[2 * q + 1];
                        aG[2 * q] += bflo(gv[q]) * wa[128 + 2 * q]; aG[2 * q + 1] += bfhi(gv[q]) * wa[128 + 2 * q + 1]; } }
            }
        u32x4 w0, w1;
        w0.x = cvt_pk_bf16(siluf_(aG[0]) * aA[0], siluf_(aG[1]) * aA[1]); w0.y = cvt_pk_bf16(siluf_(aG[2]) * aA[2], siluf_(aG[3]) * aA[3]);
        w0.z = cvt_pk_bf16(siluf_(aG[4]) * aA[4], siluf_(aG[5]) * aA[5]); w0.w = cvt_pk_bf16(siluf_(aG[6]) * aA[6], siluf_(aG[7]) * aA[7]);
        w1.x = cvt_pk_bf16(siluf_(aG[8]) * aA[8], siluf_(aG[9]) * aA[9]); w1.y = cvt_pk_bf16(siluf_(aG[10]) * aA[10], siluf_(aG[11]) * aA[11]);
        w1.z = cvt_pk_bf16(siluf_(aG[12]) * aA[12], siluf_(aG[13]) * aA[13]); w1.w = cvt_pk_bf16(siluf_(aG[14]) * aA[14], siluf_(aG[15]) * aA[15]);
        bf16_t* ap = ACT + (size_t)(tl.row0 + tok) * kc + uu * 128 + cg8 * 16;
        *(u32x4*)ap = w0; *(u32x4*)(ap + 8) = w1;
        __syncthreads();
    }
}

DEVI void grid_barrier(unsigned* ctr, unsigned target) {
    asm volatile("s_waitcnt vmcnt(0)" ::: "memory");
    __syncthreads();
    if (threadIdx.x == 0) {
        __builtin_amdgcn_fence(__ATOMIC_RELEASE, "agent");
        asm volatile("s_waitcnt vmcnt(0)" ::: "memory");
        __hip_atomic_fetch_add(ctr, 1u, __ATOMIC_RELAXED, __HIP_MEMORY_SCOPE_AGENT);
        unsigned spins = 0;
        while (__hip_atomic_load(ctr, __ATOMIC_RELAXED, __HIP_MEMORY_SCOPE_AGENT) < target) { __builtin_amdgcn_s_sleep(1); if (++spins > (1u << 24)) break; }
        __builtin_amdgcn_fence(__ATOMIC_ACQUIRE, "agent");
        asm volatile("s_waitcnt vmcnt(0)" ::: "memory");
    }
    __syncthreads();
}

constexpr int PH_PER_LAYER = 17, N_PHASES = 1 + 2 * PH_PER_LAYER;

DEVI void run_phase(unsigned char* shm, const Params& p, int ph) {
    LAS unsigned char* lds3 = (LAS unsigned char*)shm;
    unsigned char* ws = p.ws;
    const float* mods = (const float*)(ws + OFF_MODS);
    float* X = (float*)(ws + OFF_X); bf16_t* H = (bf16_t*)(ws + OFF_H); bf16_t* Z = (bf16_t*)(ws + OFF_Z); bf16_t* U = (bf16_t*)(ws + OFF_U); bf16_t* ACT = (bf16_t*)(ws + OFF_ACT);
    if (ph == 0) { prep_phase(shm, p); return; }
    const int l = (ph - 1) / PH_PER_LAYER, k = (ph - 1) % PH_PER_LAYER;
    const float* ml = mods + l * 5 * 6144;
    const int Mrows = (l == 0) ? ROWS : NLAT;
    pg8::StaticOrder S;
    switch (k) {
    case 0: if (l == 0) ln_phase(p.wave, p.x, p.ctx, ROWS, nullptr, nullptr, nullptr, nullptr, ml, 0, H); break;
    case 1: { pg8::Gemm g{H, (const bf16_t*)(ws + OFF_WIN) + (size_t)l * 2304 * 1024, ROWS, ZP, 1024}; S.init(g.M, g.N, gridDim.x, blockIdx.x);
        pg8::EpiBf16 E{Z, ZP}; pg8::gemm_phase(lds3, g, S, E, p.wave); } break;
    case 2: mix_phase(shm, p, l); break;
    case 3: gla_scan_phase(p); break;
    case 4: gla_out_phase(shm, p, l); break;
    case 5: { pg8::Gemm g{H, (const bf16_t*)(ws + OFF_WOUT) + (size_t)l * 1024 * 1024, Mrows, 1024, 1024}; S.init(g.M, g.N, gridDim.x, blockIdx.x);
        pg8::EpiRes E{X, l == 0 ? p.x : X, l == 0 ? p.ctx : X + (size_t)NLAT * DM, ml, 2 * 1024, 0}; pg8::gemm_phase(lds3, g, S, E, p.wave); } break;
    case 6: ln_phase(p.wave, X, X + (size_t)NLAT * DM, Mrows, p.post_ln_w + (l * 2 + 0) * 1024, p.post_ln_b + (l * 2 + 0) * 1024, X, nullptr, ml, 3 * 1024, H); break;
    case 7: case 10: case 13: { const int ch = (k - 7) / 3; const int u0 = c_cu0[ch], nu = c_cnu[ch];
        pg8::Gemm g{H, (const bf16_t*)(ws + OFF_WUP) + (size_t)l * 5632 * 1024 + (size_t)u0 * 256 * 1024, Mrows, nu * 256, 1024}; S.init(g.M, g.N, gridDim.x, blockIdx.x);
        pg8::EpiBf16 E{U, UPITCH}; pg8::gemm_phase(lds3, g, S, E, p.wave); } break;
    case 8: case 11: case 14: ffnconv_phase(shm, p, l, (k - 8) / 3); break;
    case 9: case 12: case 15: { const int ch = (k - 9) / 3; const int u0 = c_cu0[ch], nu = c_cnu[ch];
        pg8::Gemm g{ACT, (const bf16_t*)(ws + OFF_WDN) + (size_t)l * 1024 * FH + (size_t)u0 * 128 * 1024, Mrows, 1024, nu * 128}; S.init(g.M, g.N, gridDim.x, blockIdx.x);
        pg8::EpiRes E{X, X, X + (size_t)NLAT * DM, ml, 5 * 1024, ch == 0 ? 0 : 1}; pg8::gemm_phase(lds3, g, S, E, p.wave); } break;
    case 16:
        if (l == 0) ln_phase(p.wave, X, X + (size_t)NLAT * DM, ROWS, p.post_ln_w + (l * 2 + 1) * 1024, p.post_ln_b + (l * 2 + 1) * 1024, X, nullptr, mods + 5 * 6144, 0, H);
        else ln_phase(p.wave, X, X + (size_t)NLAT * DM, NLAT, p.post_ln_w + (l * 2 + 1) * 1024, p.post_ln_b + (l * 2 + 1) * 1024, nullptr, p.out, nullptr, 0, nullptr);
        break;
    }
}

__global__ void __launch_bounds__(512, 2) mega(Params p, int ph_lo, int ph_hi, int coop) {
    extern __shared__ __attribute__((aligned(16))) unsigned char shm[];
    unsigned* ctr = (unsigned*)(p.ws + OFF_CTL);
    unsigned epoch = 0;
    Params q = p; q.wave = __builtin_amdgcn_readfirstlane((int)(threadIdx.x >> 6));
    for (int ph = ph_lo; ph < ph_hi; ++ph) {
        if (ph == 1 + PH_PER_LAYER) continue;
        run_phase(shm, q, ph);
        if (coop && ph + 1 < ph_hi) {
            if (ph == 0) cg::this_grid().sync();
            else { ++epoch; grid_barrier(ctr, epoch * gridDim.x); }
        }
    }
}

extern "C" void kernel_launch(void* const* d_in, const int* in_sizes, int n_in, void* d_out, int out_size, void* d_ws, size_t ws_size, hipStream_t stream) {
    static int grid = 0;
    if (grid == 0) {
        if (n_in != 26 || ws_size < WS_END) { fprintf(stderr, "kernel_launch: unexpected n_in %d / ws_size %zu (need %zu)\n", n_in, ws_size, (size_t)WS_END); grid = -1; return; }
        int dev = 0, cus = 0, per_cu = 0;
        hipGetDevice(&dev); hipDeviceGetAttribute(&cus, hipDeviceAttributeMultiprocessorCount, dev);
        if (hipFuncSetAttribute((const void*)mega, hipFuncAttributeMaxDynamicSharedMemorySize, LDS_BYTES) != hipSuccess) { fprintf(stderr, "kernel_launch: hipFuncSetAttribute failed\n"); grid = -1; return; }
        if (hipOccupancyMaxActiveBlocksPerMultiprocessor(&per_cu, (const void*)mega, 512, LDS_BYTES) != hipSuccess || per_cu < 1) { fprintf(stderr, "kernel_launch: occupancy query says %d\n", per_cu); per_cu = 1; }
        (void)hipGetLastError();
        grid = cus * 1;
    }
    if (grid < 0) return;
    Params p{};
    const float** pp = (const float**)&p;
    for (int i = 0; i < 26; ++i) pp[i] = (const float*)d_in[i];
    p.wave = 0; p.pad_ = 0;
    p.out = (float*)d_out; p.ws = (unsigned char*)d_ws;
#if MK_COOP
    hipMemsetAsync((char*)d_ws + OFF_CTL, 0, 4096, stream);
    int lo = 0, hi = N_PHASES, coop = 1;
    void* args[] = {&p, &lo, &hi, &coop};
    hipError_t e = hipLaunchCooperativeKernel((const void*)mega, dim3(grid), dim3(512), args, LDS_BYTES, stream);
    if (e != hipSuccess) fprintf(stderr, "cooperative launch failed: %s (grid %d)\n", hipGetErrorString(e), grid);
#else
    for (int ph = 0; ph < N_PHASES; ++ph) {
        if (ph == 1 + PH_PER_LAYER) continue;
        hipLaunchKernelGGL(mega, dim3(grid), dim3(512), LDS_BYTES, stream, p, ph, ph + 1, 0);
    }
#endif
}
```

```cpp
#include <hip/hip_runtime.h>
#include <hip/hip_cooperative_groups.h>
#include <cstdio>
#include <cstdint>
namespace cg = cooperative_groups;

#ifndef PROBE_REP
#define PROBE_REP 0
#define PROBE_PH -1
#define PROBE_PH2 -1
#endif
#ifndef MK_COOP
#define MK_COOP 1
#endif

#define DEVI __device__ __forceinline__
#define LAS __attribute__((address_space(3)))
typedef unsigned short bf16_t;
typedef short bf16x8 __attribute__((ext_vector_type(8)));
typedef float f32x4 __attribute__((ext_vector_type(4)));
typedef float f32x2 __attribute__((ext_vector_type(2)));
typedef unsigned u32x4 __attribute__((ext_vector_type(4)));
typedef unsigned u32x2 __attribute__((ext_vector_type(2)));

constexpr int DM = 1024, SEQ = 8192, CTXL = 256, NLAT = 32768, NCTX = 1024, ROWS = 33792;
constexpr int ZP = 2304;
constexpr int ZQ = 0, ZK = 128, ZV = 256, ZR = 512, ZLF = 768, ZB = 800, ZCU = 1056, ZCV = 1312, ZDA = 1568, ZDG = 1824;
constexpr int FH = 2816, UPITCH = 2048;
constexpr float ALPHA = 1.41421356237f, EPS = 1e-6f;
constexpr int LDS_BYTES = 160 * 1024;
constexpr int NCHUNK64 = 528;

constexpr size_t OFF_CTL = 0;
constexpr size_t OFF_MODS = 4096;
constexpr size_t OFF_SGUW = OFF_MODS + 2ull * 5 * 6144 * 4;
constexpr size_t OFF_POOLW = OFF_SGUW + 2ull * 4 * 128 * 128 * 2;
constexpr size_t OFF_WIN = OFF_POOLW + 2ull * 4 * 64 * 64 * 2;
constexpr size_t OFF_WOUT = OFF_WIN + 2ull * 2304 * 1024 * 2;
constexpr size_t OFF_WUP = OFF_WOUT + 2ull * 1024 * 1024 * 2;
constexpr size_t OFF_WDN = OFF_WUP + 2ull * 5632 * 1024 * 2;
constexpr size_t OFF_X = OFF_WDN + 2ull * 1024 * 2816 * 2;
constexpr size_t OFF_H = OFF_X + (size_t)ROWS * 1024 * 4;
constexpr size_t OFF_R1 = OFF_H + (size_t)ROWS * 1024 * 2;
constexpr size_t OFF_Z = OFF_R1;
constexpr size_t OFF_ST = OFF_Z + (size_t)ROWS * ZP * 2;
constexpr size_t OFF_DEC = OFF_ST + (size_t)NCHUNK64 * 8 * 2048 * 4;
constexpr size_t OFF_U = OFF_R1;
constexpr size_t OFF_ACT = OFF_U + (size_t)ROWS * UPITCH * 2;
constexpr size_t WS_END = OFF_ACT + (size_t)ROWS * 1024 * 2;

struct Params {
    const float *x, *c, *ctx, *c_ctx, *w_mod, *b_mod, *w_in, *gla_w_gate, *gla_b_gate, *gla_norm_w, *pool_w, *pool_scale, *sgu_w, *sgu_b,
        *sgu_ln_w, *sgu_ln_b, *cm_conv_w, *cm_conv_b, *cm_ln_w, *cm_ln_b, *w_out, *ffn_w_up, *ffn_conv_w, *ffn_w_down, *post_ln_w, *post_ln_b;
    float* out; unsigned char* ws;
    int wave, pad_;
};

DEVI float bf2f(unsigned v) { return __uint_as_float(v << 16); }
DEVI float bflo(unsigned v) { return __uint_as_float(v << 16); }
DEVI float bfhi(unsigned v) { return __uint_as_float(v & 0xffff0000u); }
DEVI unsigned cvt_pk_bf16(float lo, float hi) { unsigned r; asm volatile("v_cvt_pk_bf16_f32 %0, %1, %2" : "=v"(r) : "v"(lo), "v"(hi)); return r; }
DEVI bf16_t f2bf(float f) { return (bf16_t)(cvt_pk_bf16(f, 0.f) & 0xffffu); }
DEVI int my_lane() { int t; asm volatile("v_mbcnt_lo_u32_b32 %0, -1, 0\n\tv_mbcnt_hi_u32_b32 %0, -1, %0" : "=v"(t)); return t; }
DEVI int my_tid_w(int wave) { return (wave << 6) | my_lane(); }
DEVI float shx(float v, int o, int lane) { return __int_as_float(__builtin_amdgcn_ds_bpermute((lane ^ o) << 2, __float_as_int(v))); }
DEVI float wsum(float v, int lane) {
#pragma unroll
    for (int o = 32; o; o >>= 1) v += shx(v, o, lane);
    return v; }
DEVI float sigmoidf_(float x) { return 1.0f / (1.0f + __expf(-x)); }
DEVI float siluf_(float x) { return x / (1.0f + __expf(-x)); }
DEVI float geluf_(float x) { const float u = 0.7978845608f * (x + 0.044715f * x * x * x); return x / (1.0f + __expf(-2.0f * u)); }
DEVI float logsigf_(float x) { return fminf(x, 0.f) - log1pf(__expf(-fabsf(x))); }
#define MFMA16(a, b, c) __builtin_amdgcn_mfma_f32_16x16x32_bf16((a), (b), (c), 0, 0, 0)

namespace pg8 {
constexpr int BM = 256, BK = 64, HALF = 128, HTB = HALF * BK * 2, STAGE_BYTES = 8 * HTB, NXCD = 8, WGM = 8;
DEVI int lds_byte(int r, int c) { const int st = (r >> 4) * 2 + (c >> 5), rr = r & 15, cc = c & 31, ob = rr * 64 + cc * 2; return st * 1024 + (ob ^ (((ob >> 9) & 1) << 5)); }
DEVI void stage_rc(int b, int& R, int& C) { const int st = b / 1024, sb = b % 1024, swz = sb ^ (((sb >> 9) & 1) << 5); R = (st >> 1) * 16 + swz / 64; C = (st & 1) * 32 + (swz % 64) / 2; }
DEVI int perm32(int rho) { const int n = rho >> 4, i = rho & 15; return 8 * (i >> 2) + 4 * n + (i & 3); }
struct Unit { int pm, pn; };
struct Gemm { const bf16_t* A; const bf16_t* Bt; int M, N, K; };
struct StaticOrder {
    int nM, nN, nwg, G, c;
    DEVI void init(int M, int N, int G_, int c_) { nM = M / BM; nN = N / BM; nwg = nM * nN; G = G_; c = c_; }
    DEVI bool next(int i, Unit& u) const {
        const long L = (long)i * G + c; if (L >= nwg) return false;
        int wgid = (int)L; { const int q = nwg / NXCD, r = nwg % NXCD, xcd = wgid % NXCD, off = wgid / NXCD; wgid = (xcd < r ? xcd * (q + 1) : r * (q + 1) + (xcd - r) * q) + off; }
        const int nig = WGM * nN, gid = wgid / nig, fm = gid * WGM, gsz = (nM - fm) < WGM ? (nM - fm) : WGM;
        u.pm = fm + ((wgid % nig) % gsz); u.pn = (wgid % nig) / gsz; return true;
    }
    DEVI void a_ready(const Unit&) const {}
    DEVI void done(const Unit&) const {}
};

struct EpiBf16 {
    static constexpr bool PERM = true;
    bf16_t* O; int ldc;
    DEVI void operator()(const f32x4 (&acc)[2][2][4][2], const Unit& u, int wr, int wc, int, int) const {
        const int ln = my_lane(), fr = ln & 15, fq = ln >> 4;
        const int row0 = u.pm * BM + wr * 64 + fr; const int col0 = u.pn * BM + wc * 32 + 8 * fq;
#pragma unroll
        for (int ai = 0; ai < 2; ++ai)
#pragma unroll
            for (int m = 0; m < 4; ++m) { bf16_t* rowp = O + (size_t)(row0 + ai * HALF + m * 16) * ldc + col0;
#pragma unroll
                for (int bj = 0; bj < 2; ++bj) { const f32x4 v0 = acc[ai][bj][m][0], v1 = acc[ai][bj][m][1];
                    u32x4 w; w.x = cvt_pk_bf16(v0[0], v0[1]); w.y = cvt_pk_bf16(v0[2], v0[3]); w.z = cvt_pk_bf16(v1[0], v1[1]); w.w = cvt_pk_bf16(v1[2], v1[3]);
                    *(u32x4*)(rowp + bj * HALF) = w; } }
    }
};
struct EpiRes {
    static constexpr bool PERM = true;
    float* X; const float* srcL; const float* srcC; const float* mods; int goff; int mode;
    DEVI void operator()(const f32x4 (&acc)[2][2][4][2], const Unit& u, int wr, int wc, int, int) const {
        const int ln = my_lane(), fr = ln & 15, fq = ln >> 4;
        const int rowt = u.pm * BM; const int b = rowt < NLAT ? (rowt >> 13) : 4;
        float* dst = X + (size_t)rowt * DM;
        const float* src = (mode == 0) ? (rowt < NLAT ? srcL + (size_t)rowt * DM : srcC + (size_t)(rowt - NLAT) * DM) : dst;
        const float al = (mode == 0) ? ALPHA : 1.0f;
        const int rl = wr * 64 + fr;
        const int col0 = u.pn * BM + wc * 32 + 8 * fq;
        const float* gp = mods + b * 6144 + goff + col0;
        f32x4 gv[2][2];
#pragma unroll
        for (int bj = 0; bj < 2; ++bj)
#pragma unroll
            for (int n = 0; n < 2; ++n) gv[bj][n] = *(const f32x4*)(gp + bj * HALF + n * 4);
#pragma unroll
        for (int ai = 0; ai < 2; ++ai)
#pragma unroll
            for (int m = 0; m < 4; ++m) { const size_t ro = (size_t)(rl + ai * HALF + m * 16) * DM + col0;
#pragma unroll
                for (int bj = 0; bj < 2; ++bj) { const f32x4 x0 = *(const f32x4*)(src + ro + bj * HALF), x1 = *(const f32x4*)(src + ro + bj * HALF + 4);
                    *(f32x4*)(dst + ro + bj * HALF) = al * x0 + gv[bj][0] * acc[ai][bj][m][0];
                    *(f32x4*)(dst + ro + bj * HALF + 4) = al * x1 + gv[bj][1] * acc[ai][bj][m][1]; } }
    }
};

template <class Epi, class Sched>
DEVI void gemm_phase(LAS unsigned char* lds, const Gemm g, const Sched& S, const Epi& E, int wave) {
    const int tid = my_tid_w(wave), wid = __builtin_amdgcn_readfirstlane(tid >> 6), lane = tid & 63, wr = wid >> 2, wc = wid & 3, fr = lane & 15, fq = lane >> 4;
    const int K = g.K, nt = K / BK;
    unsigned voffA[2], voffB[2];
#pragma unroll
    for (int i = 0; i < 2; ++i) { int R, C; stage_rc(tid * 16 + i * 8192, R, C); const int Rb = Epi::PERM ? ((R & ~31) + perm32(R & 31)) : R;
        voffA[i] = (unsigned)(R * K + C) * 2u; voffB[i] = (unsigned)(Rb * K + C) * 2u; }
    const size_t kstep = (size_t)(BK * 2);
    const size_t hstep = (size_t)HALF * K * 2;
    const size_t tstep = 2 * hstep;
    const unsigned ldsw = (unsigned)wid * 1024u;
    const int aoff = lds_byte(wr * 64 + fr, fq * 8), boff = lds_byte(wc * 32 + fr, fq * 8);
#define PG8_SA(b, h) (((b) * 2 + (h)) * HTB)
#define PG8_SB(b, h) ((4 + (b) * 2 + (h)) * HTB)
#define PG8_STAGE(bufoff, gbase, voff) do { _Pragma("unroll") for (int _i = 0; _i < 2; ++_i) \
        __builtin_amdgcn_global_load_lds((const unsigned*)((const char*)(gbase) + (voff)[_i]), (LAS unsigned*)(lds + (bufoff) + ldsw + _i * 8192), 16, 0, 0); } while (0)
#define PG8_LDA(dst, b, h) do { _Pragma("unroll") for (int m = 0; m < 4; ++m) _Pragma("unroll") for (int k = 0; k < 2; ++k) dst[m][k] = *(const LAS bf16x8*)(lds + PG8_SA(b, h) + aoff + m * 2048 + k * 1024); } while (0)
#define PG8_LDB(dst, b, h) do { _Pragma("unroll") for (int n = 0; n < 2; ++n) _Pragma("unroll") for (int k = 0; k < 2; ++k) dst[n][k] = *(const LAS bf16x8*)(lds + PG8_SB(b, h) + boff + n * 2048 + k * 1024); } while (0)
#define PG8_MMA(ai, bj, At, Bt) do { __builtin_amdgcn_s_setprio(1); _Pragma("unroll") for (int m = 0; m < 4; ++m) _Pragma("unroll") for (int n = 0; n < 2; ++n) _Pragma("unroll") for (int k = 0; k < 2; ++k) \
        acc[ai][bj][m][n] = __builtin_amdgcn_mfma_f32_16x16x32_bf16(Bt[n][k], At[m][k], acc[ai][bj][m][n], 0, 0, 0); __builtin_amdgcn_s_setprio(0); } while (0)
#define PG8_WAIT_V(n) asm volatile("s_waitcnt vmcnt(" #n ")" ::: "memory")
#define PG8_WAIT_L(n) asm volatile("s_waitcnt lgkmcnt(" #n ")" ::: "memory")
#define PG8_BAR __builtin_amdgcn_s_barrier()
#define PG8_SCHED __builtin_amdgcn_sched_barrier(0)
    Unit cur, nxt; int ui = 0;
    if (!S.next(0, cur)) return;
    f32x4 acc[2][2][4][2];
#pragma unroll
    for (int a = 0; a < 2; ++a)
#pragma unroll
        for (int b = 0; b < 2; ++b)
#pragma unroll
            for (int m = 0; m < 4; ++m)
#pragma unroll
                for (int n = 0; n < 2; ++n) acc[a][b][m][n] = (f32x4){0.f, 0.f, 0.f, 0.f};
    bf16x8 At[4][2], B0[2][2], B1[2][2];
    const char* cA = (const char*)g.A + (size_t)cur.pm * tstep; const char* cB = (const char*)g.Bt + (size_t)cur.pn * tstep;
    S.a_ready(cur);
    PG8_STAGE(PG8_SB(0, 0), cB, voffB); PG8_STAGE(PG8_SA(0, 0), cA, voffA); PG8_STAGE(PG8_SB(0, 1), cB + hstep, voffB); PG8_STAGE(PG8_SA(0, 1), cA + hstep, voffA);
    if (wr == 1) PG8_BAR;
    PG8_WAIT_V(4); PG8_BAR;
    PG8_STAGE(PG8_SB(1, 0), cB + kstep, voffB); PG8_STAGE(PG8_SA(1, 0), cA + kstep, voffA); PG8_STAGE(PG8_SB(1, 1), cB + hstep + kstep, voffB);
    PG8_WAIT_V(6); PG8_BAR;
    for (;;) {
        const bool has_next = S.next(ui + 1, nxt);
        const char* nA = has_next ? (const char*)g.A + (size_t)nxt.pm * tstep : cA; const char* nB = has_next ? (const char*)g.Bt + (size_t)nxt.pn * tstep : cB;
        for (int t = 0; t < nt; t += 2) {
            const bool last = (t == nt - 2);
            const char* a1 = cA + (size_t)(t + 1) * kstep;
            const char* a2 = last ? nA : cA + (size_t)(t + 2) * kstep; const char* b2 = last ? nB : cB + (size_t)(t + 2) * kstep;
            const char* a3 = a2 + kstep; const char* b3 = b2 + kstep;
            if (last && has_next) S.a_ready(nxt);
            PG8_LDB(B0, 0, 0); PG8_SCHED; PG8_LDA(At, 0, 0); PG8_STAGE(PG8_SA(1, 1), a1 + hstep, voffA);
            PG8_WAIT_L(8); PG8_BAR; PG8_WAIT_L(0); PG8_MMA(0, 0, At, B0); PG8_BAR; PG8_SCHED;
            PG8_LDB(B1, 0, 1); PG8_STAGE(PG8_SB(0, 0), b2, voffB);
            PG8_BAR; PG8_WAIT_L(0); PG8_MMA(0, 1, At, B1); PG8_BAR;
            PG8_LDA(At, 0, 1); PG8_STAGE(PG8_SA(0, 0), a2, voffA);
            PG8_BAR; PG8_WAIT_L(0); PG8_MMA(1, 0, At, B0); PG8_BAR; PG8_SCHED;
            PG8_STAGE(PG8_SB(0, 1), b2 + hstep, voffB);
            PG8_WAIT_V(6); PG8_BAR; PG8_MMA(1, 1, At, B1); PG8_BAR;
            PG8_LDB(B0, 1, 0); PG8_SCHED; PG8_LDA(At, 1, 0); PG8_STAGE(PG8_SA(0, 1), a2 + hstep, voffA);
            PG8_WAIT_L(8); PG8_BAR; PG8_WAIT_L(0); PG8_MMA(0, 0, At, B0); PG8_BAR; PG8_SCHED;
            PG8_LDB(B1, 1, 1); PG8_STAGE(PG8_SB(1, 0), b3, voffB);
            PG8_BAR; PG8_WAIT_L(0); PG8_MMA(0, 1, At, B1); PG8_BAR;
            PG8_LDA(At, 1, 1); PG8_STAGE(PG8_SA(1, 0), a3, voffA);
            PG8_BAR; PG8_WAIT_L(0); PG8_MMA(1, 0, At, B0); PG8_BAR; PG8_SCHED;
            PG8_STAGE(PG8_SB(1, 1), b3 + hstep, voffB);
            PG8_WAIT_V(6); PG8_BAR; PG8_MMA(1, 1, At, B1); PG8_BAR;
        }
        E(acc, cur, wr, wc, fr, fq); S.done(cur);
        if (!has_next) break;
#pragma unroll
        for (int a = 0; a < 2; ++a)
#pragma unroll
            for (int b = 0; b < 2; ++b)
#pragma unroll
                for (int m = 0; m < 4; ++m)
#pragma unroll
                    for (int n = 0; n < 2; ++n) acc[a][b][m][n] = (f32x4){0.f, 0.f, 0.f, 0.f};
        cur = nxt; cA = nA; cB = nB; ++ui;
    }
    PG8_WAIT_V(0);
    if (wr == 0) PG8_BAR;
    PG8_BAR;
#undef PG8_SA
#undef PG8_SB
#undef PG8_STAGE
#undef PG8_LDA
#undef PG8_LDB
#undef PG8_MMA
#undef PG8_WAIT_V
#undef PG8_WAIT_L
#undef PG8_BAR
#undef PG8_SCHED
}
}

DEVI void transpose_tile(int wave, float* tile, const float* src, int ld_src, int k0, int n0s, int nvalid, bf16_t* dst, int ld_dst, int n0d, int k0d) {
    const int tid = my_tid_w(wave);
#pragma unroll
    for (int i = 0; i < 8; ++i) { const int kk = i * 8 + (tid >> 6), nn = tid & 63; const int col = n0s + nn;
        tile[kk * 65 + nn] = (col < nvalid) ? src[(size_t)(k0 + kk) * ld_src + col] : 0.f; }
    __syncthreads();
#pragma unroll
    for (int i = 0; i < 8; ++i) { const int nn = i * 8 + (tid >> 6), kk = tid & 63; dst[(size_t)(n0d + nn) * ld_dst + k0d + kk] = f2bf(tile[kk * 65 + nn]); }
    __syncthreads();
}

DEVI void mods_item(float* lf, const Params& p, int item) {
    const int tid = my_tid_w(p.wave); const int l = item / 96, cgp = item % 96;
    float* s = lf;
    float* red = lf + 5120;
    for (int i = tid; i < 5120; i += 512) { const int r = i >> 10, k = i & 1023; const float v = (r < 4) ? p.c[r * 1024 + k] : p.c_ctx[k]; s[i] = siluf_(v); }
    __syncthreads();
    const int cc = tid & 63, kg = tid >> 6; const int col = cgp * 64 + cc;
    const float* W = p.w_mod + (size_t)l * 1024 * 6144 + col;
    float a0 = 0.f, a1 = 0.f, a2 = 0.f, a3 = 0.f, a4 = 0.f;
#pragma unroll 8
    for (int k = kg * 128; k < kg * 128 + 128; ++k) { const float w = W[(size_t)k * 6144];
        a0 += s[k] * w; a1 += s[1024 + k] * w; a2 += s[2048 + k] * w; a3 += s[3072 + k] * w; a4 += s[4096 + k] * w; }
    red[(kg * 5 + 0) * 64 + cc] = a0; red[(kg * 5 + 1) * 64 + cc] = a1; red[(kg * 5 + 2) * 64 + cc] = a2; red[(kg * 5 + 3) * 64 + cc] = a3; red[(kg * 5 + 4) * 64 + cc] = a4;
    __syncthreads();
    if (tid < 320) { const int r = tid >> 6, c2 = tid & 63; float sum = p.b_mod[l * 6144 + cgp * 64 + c2];
#pragma unroll
        for (int q = 0; q < 8; ++q) sum += red[(q * 5 + r) * 64 + c2];
        ((float*)(p.ws + OFF_MODS))[(l * 5 + r) * 6144 + cgp * 64 + c2] = sum; }
    __syncthreads();
}

__constant__ int c_cu0[3] = {0, 8, 15};
__constant__ int c_cnu[3] = {8, 7, 7};

DEVI void prep_phase(unsigned char* lds, const Params& p) {
    float* lf = (float*)lds;
    const int T_IN = 16 * 36, T_OUT = 256, T_UP = 16 * 88, T_DN = 44 * 16, T_L = T_IN + T_OUT + T_UP + T_DN;
    const int N_MODS = 192, N_TR = 2 * T_L, N_SGU = 32, N_POOL = 8;
    const int total = N_MODS + N_TR + N_SGU + N_POOL;
    for (int item = blockIdx.x; item < total; item += gridDim.x) {
        if (item < N_MODS) { mods_item(lf, p, item); continue; }
        int it = item - N_MODS;
        if (it < N_TR) {
            const int l = it / T_L; int r = it % T_L;
            if (r < T_IN) { const int kt = r / 36, ntl = r % 36;
                transpose_tile(p.wave, lf, p.w_in + (size_t)l * 1024 * 2080, 2080, kt * 64, ntl * 64, 2080, (bf16_t*)(p.ws + OFF_WIN) + (size_t)l * 2304 * 1024, 1024, ntl * 64, kt * 64); continue; }
            r -= T_IN;
            if (r < T_OUT) { const int kt = r / 16, ntl = r % 16;
                transpose_tile(p.wave, lf, p.w_out + (size_t)l * 1024 * 1024, 1024, kt * 64, ntl * 64, 1024, (bf16_t*)(p.ws + OFF_WOUT) + (size_t)l * 1024 * 1024, 1024, ntl * 64, kt * 64); continue; }
            r -= T_OUT;
            if (r < T_UP) { const int kt = r / 88, ntl = r % 88; const int n0d = ntl * 64; const int unit = n0d >> 8, sgn = (n0d >> 7) & 1, j0 = n0d & 127;
                transpose_tile(p.wave, lf, p.ffn_w_up + (size_t)l * 1024 * 5632, 5632, kt * 64, sgn * FH + unit * 128 + j0, 5632, (bf16_t*)(p.ws + OFF_WUP) + (size_t)l * 5632 * 1024, 1024, n0d, kt * 64); continue; }
            r -= T_UP;
            { const int kt = r / 16, ntl = r % 16; const int k0 = kt * 64; const int unit = k0 >> 7; const int ch = unit < 8 ? 0 : (unit < 15 ? 1 : 2); const int u0 = c_cu0[ch], kc = c_cnu[ch] * 128;
                transpose_tile(p.wave, lf, p.ffn_w_down + (size_t)l * FH * 1024, 1024, k0, ntl * 64, 1024, (bf16_t*)(p.ws + OFF_WDN) + (size_t)l * 1024 * FH + (size_t)u0 * 128 * 1024, kc, ntl * 64, k0 - u0 * 128); continue; }
        }
        it -= N_TR;
        if (it < N_SGU) { bf16_t* d = (bf16_t*)(p.ws + OFF_SGUW); const int base = it * 4096;
#pragma unroll
            for (int i = 0; i < 8; ++i) { const int idx = base + i * 512 + my_tid_w(p.wave); d[idx] = f2bf(p.sgu_w[idx]); }
            continue; }
        it -= N_SGU;
        { transpose_tile(p.wave, lf, p.pool_w + (size_t)it * 4096, 64, 0, 0, 64, (bf16_t*)(p.ws + OFF_POOLW) + (size_t)it * 4096, 64, 0, 0); }
    }
}

DEVI void ln_phase(int wave, const float* srcL, const float* srcC, int nrows, const float* lnw, const float* lnb, float* dstX, float* dstOut, const float* mods, int soff, bf16_t* H) {
    const int lane = my_lane(); int wid = wave; asm volatile("" : "+s"(wid));
    const int rstep = gridDim.x * 8;
    int r = blockIdx.x * 8 + wid;
    f32x4 vn[4];
    if (r < nrows) { const float* src = r < NLAT ? srcL + (size_t)r * DM : srcC + (size_t)(r - NLAT) * DM;
#pragma unroll
        for (int i = 0; i < 4; ++i) vn[i] = *(const f32x4*)(src + i * 256 + lane * 4); }
    for (; r < nrows; r += rstep) {
        f32x4 v[4];
#pragma unroll
        for (int i = 0; i < 4; ++i) v[i] = vn[i];
        { const int rn = r + rstep; if (rn < nrows) { const float* src = rn < NLAT ? srcL + (size_t)rn * DM : srcC + (size_t)(rn - NLAT) * DM;
#pragma unroll
            for (int i = 0; i < 4; ++i) vn[i] = *(const f32x4*)(src + i * 256 + lane * 4); } }
        float s = 0.f;
#pragma unroll
        for (int i = 0; i < 4; ++i) s += v[i][0] + v[i][1] + v[i][2] + v[i][3];
        float mean = wsum(s, lane) * (1.0f / 1024.0f);
        float q = 0.f;
#pragma unroll
        for (int i = 0; i < 4; ++i) { v[i] -= mean; q += v[i][0] * v[i][0] + v[i][1] * v[i][1] + v[i][2] * v[i][2] + v[i][3] * v[i][3]; }
        float rstd = rsqrtf(wsum(q, lane) * (1.0f / 1024.0f) + EPS);
        if (lnw) {
#pragma unroll
            for (int i = 0; i < 4; ++i) { const f32x4 w = *(const f32x4*)(lnw + i * 256 + lane * 4), b = *(const f32x4*)(lnb + i * 256 + lane * 4); v[i] = v[i] * rstd * w + b; }
            if (dstX) {
#pragma unroll
                for (int i = 0; i < 4; ++i) *(f32x4*)(dstX + (size_t)r * DM + i * 256 + lane * 4) = v[i]; }
            if (dstOut && r < NLAT) {
#pragma unroll
                for (int i = 0; i < 4; ++i) *(f32x4*)(dstOut + (size_t)r * DM + i * 256 + lane * 4) = v[i]; }
            if (mods) {
                s = 0.f;
#pragma unroll
                for (int i = 0; i < 4; ++i) s += v[i][0] + v[i][1] + v[i][2] + v[i][3];
                mean = wsum(s, lane) * (1.0f / 1024.0f); q = 0.f;
#pragma unroll
                for (int i = 0; i < 4; ++i) { v[i] -= mean; q += v[i][0] * v[i][0] + v[i][1] * v[i][1] + v[i][2] * v[i][2] + v[i][3] * v[i][3]; }
                rstd = rsqrtf(wsum(q, lane) * (1.0f / 1024.0f) + EPS);
            }
        }
        if (mods) {
            const int b = r < NLAT ? (r >> 13) : 4; const float* mp = mods + b * 6144 + soff;
#pragma unroll
            for (int i = 0; i < 4; ++i) { const f32x4 sh = *(const f32x4*)(mp + i * 256 + lane * 4), sc = *(const f32x4*)(mp + 1024 + i * 256 + lane * 4);
                const f32x4 h = v[i] * rstd * (1.0f + sc) + sh;
                u32x2 w; w.x = cvt_pk_bf16(h[0], h[1]); w.y = cvt_pk_bf16(h[2], h[3]);
                *(u32x2*)(H + (size_t)r * DM + i * 256 + lane * 4) = w; }
        }
    }
}

struct Tile { int row0, T0, L; };
DEVI Tile tile_of(int t, int tl) {
    const int nlat = NLAT / tl; Tile r;
    if (t < nlat) { r.row0 = t * tl; r.T0 = r.row0 & (SEQ - 1); r.L = SEQ; }
    else { const int q = (t - nlat) * tl; r.row0 = NLAT + q; r.T0 = q & (CTXL - 1); r.L = CTXL; }
    return r;
}

DEVI void pool_item(unsigned char* lds, const Params& p, int l, const Tile tl) {
    const int tid = my_tid_w(p.wave), wid = tid >> 6, lane = tid & 63, fr = lane & 15, fq = lane >> 4;
    bf16_t* zs = (bf16_t*)lds;
    bf16_t* ys = (bf16_t*)(lds + 80 * 256 * 2);
    const bf16_t* z = (const bf16_t*)(p.ws + OFF_Z);
    bf16_t* ycat = (bf16_t*)(p.ws + OFF_H);
    for (int i = tid; i < 80 * 32; i += 512) { const int r = i >> 5, c8 = i & 31; const int T = tl.T0 - 8 + r; u32x4 v = (u32x4){0u, 0u, 0u, 0u};
        if (T >= 0 && T < tl.L) v = *(const u32x4*)(z + (size_t)(tl.row0 - 8 + r) * ZP + ZB + c8 * 8);
        *(u32x4*)(zs + r * 256 + c8 * 8) = v; }
    __syncthreads();
    { const int c2 = tid & 127, tq = tid >> 7; const int ch = c2 * 2; const int g = ch >> 6; const int hw = 1 << g;
#pragma unroll 1
        for (int tt = 0; tt < 16; ++tt) { const int t = tq * 16 + tt; const int T = tl.T0 + t; const int lo = max(T - hw, 0), hi = min(T + hw, tl.L);
            float s0 = 0.f, s1 = 0.f;
            for (int q = lo; q < hi; ++q) { const unsigned v = *(const unsigned*)(zs + (q - tl.T0 + 8) * 256 + ch); s0 += bflo(v); s1 += bfhi(v); }
            const float inv = 1.0f / (float)(hi - lo); const unsigned xv = *(const unsigned*)(zs + (t + 8) * 256 + ch);
            *(unsigned*)(ys + t * 264 + ch) = cvt_pk_bf16(s0 * inv - bflo(xv), s1 * inv - bfhi(xv)); } }
    __syncthreads();
    { const int g = wid >> 1; const bf16_t* Wt = (const bf16_t*)(p.ws + OFF_POOLW) + (size_t)(l * 4 + g) * 4096;
#pragma unroll
        for (int mi = 0; mi < 2; ++mi) { const int mt = (wid & 1) * 2 + mi; const int t = mt * 16 + fr;
            const bf16x8 a0 = *(const bf16x8*)(ys + t * 264 + g * 64 + fq * 8), a1 = *(const bf16x8*)(ys + t * 264 + g * 64 + 32 + fq * 8);
#pragma unroll
            for (int nt = 0; nt < 4; ++nt) { const bf16x8 b0 = *(const bf16x8*)(Wt + (nt * 16 + fr) * 64 + fq * 8), b1 = *(const bf16x8*)(Wt + (nt * 16 + fr) * 64 + 32 + fq * 8);
                f32x4 acc = (f32x4){0.f, 0.f, 0.f, 0.f}; acc = MFMA16(b0, a0, acc); acc = MFMA16(b1, a1, acc);
                const int col = g * 64 + nt * 16 + 4 * fq; const f32x4 sc = *(const f32x4*)(p.pool_scale + l * 256 + col); acc *= sc;
                u32x2 w; w.x = cvt_pk_bf16(acc[0], acc[1]); w.y = cvt_pk_bf16(acc[2], acc[3]);
                *(u32x2*)(ycat + (size_t)(tl.row0 + t) * DM + 256 + col) = w; } } }
    __syncthreads();
}

DEVI void sgu_item(unsigned char* lds, const Params& p, int l, const Tile tl) {
    const int tid = my_tid_w(p.wave), wid = tid >> 6, lane = tid & 63, fr = lane & 15, fq = lane >> 4;
    bf16_t* vT = (bf16_t*)lds;
    const bf16_t* z = (const bf16_t*)(p.ws + OFF_Z);
    bf16_t* ycat = (bf16_t*)(p.ws + OFF_H);
    { const f32x4 lw = *(const f32x4*)(p.sgu_ln_w + l * 256 + lane * 4), lb = *(const f32x4*)(p.sgu_ln_b + l * 256 + lane * 4);
#pragma unroll 2
        for (int i = 0; i < 16; ++i) { const int s = wid * 16 + i; const u32x2 raw = *(const u32x2*)(z + (size_t)(tl.row0 + s) * ZP + ZCV + lane * 4);
            f32x4 v; v[0] = geluf_(bflo(raw.x)); v[1] = geluf_(bfhi(raw.x)); v[2] = geluf_(bflo(raw.y)); v[3] = geluf_(bfhi(raw.y));
            const float mean = wsum(v[0] + v[1] + v[2] + v[3], lane) * (1.0f / 256.0f); v -= mean;
            const float rstd = rsqrtf(wsum(v[0] * v[0] + v[1] * v[1] + v[2] * v[2] + v[3] * v[3], lane) * (1.0f / 256.0f) + EPS);
            v = v * rstd * lw + lb;
#pragma unroll
            for (int j = 0; j < 4; ++j) vT[(lane * 4 + j) * 136 + s] = f2bf(v[j]); } }
    __syncthreads();
    { const int h = wid >> 1; const bf16_t* W = (const bf16_t*)(p.ws + OFF_SGUW) + (size_t)(l * 4 + h) * 16384;
#pragma unroll 1
        for (int mi = 0; mi < 4; ++mi) { const int mt = (wid & 1) * 4 + mi; const int t = mt * 16 + fr;
            bf16x8 a[4];
#pragma unroll
            for (int ks = 0; ks < 4; ++ks) a[ks] = *(const bf16x8*)(W + t * 128 + ks * 32 + fq * 8);
            const float bias = p.sgu_b[(l * 4 + h) * 128 + t];
#pragma unroll
            for (int nt = 0; nt < 4; ++nt) { f32x4 acc = (f32x4){0.f, 0.f, 0.f, 0.f};
#pragma unroll
                for (int ks = 0; ks < 4; ++ks) { const bf16x8 b = *(const bf16x8*)(vT + (h * 64 + nt * 16 + fr) * 136 + ks * 32 + fq * 8); acc = MFMA16(b, a[ks], acc); }
                const int col = h * 64 + nt * 16 + 4 * fq; const u32x2 raw = *(const u32x2*)(z + (size_t)(tl.row0 + t) * ZP + ZCU + col);
                const float o0 = geluf_(bflo(raw.x)) * (acc[0] + bias), o1 = geluf_(bfhi(raw.x)) * (acc[1] + bias), o2 = geluf_(bflo(raw.y)) * (acc[2] + bias), o3 = geluf_(bfhi(raw.y)) * (acc[3] + bias);
                u32x2 w; w.x = cvt_pk_bf16(o0, o1); w.y = cvt_pk_bf16(o2, o3);
                *(u32x2*)(ycat + (size_t)(tl.row0 + t) * DM + 512 + col) = w; } } }
    __syncthreads();
}

DEVI void cm_item(unsigned char* lds, const Params& p, int l, const Tile tl) {
    const int tid = my_tid_w(p.wave), wid = tid >> 6, lane = tid & 63;
    float* yg = (float*)lds;
    const bf16_t* z = (const bf16_t*)(p.ws + OFF_Z);
    bf16_t* ycat = (bf16_t*)(p.ws + OFF_H);
#pragma unroll 2
    for (int i = tid; i < 94 * 64; i += 512) { const int r = i >> 6, c4 = (i & 63) * 4; const int T = tl.T0 - 15 + r; f32x4 o = (f32x4){0.f, 0.f, 0.f, 0.f};
        if (T >= 0 && T < tl.L) { const bf16_t* zp = z + (size_t)(tl.row0 - 15 + r) * ZP; const u32x2 a = *(const u32x2*)(zp + ZDA + c4), g = *(const u32x2*)(zp + ZDG + c4);
            o[0] = bflo(a.x) * sigmoidf_(bflo(g.x)); o[1] = bfhi(a.x) * sigmoidf_(bfhi(g.x)); o[2] = bflo(a.y) * sigmoidf_(bflo(g.y)); o[3] = bfhi(a.y) * sigmoidf_(bfhi(g.y)); }
        *(f32x4*)(yg + r * 256 + c4) = o; }
    __syncthreads();
    const int c = tid & 255, th = tid >> 8;
    float* yo = (float*)(lds + 94 * 256 * 4);
    { float w[31];
#pragma unroll
        for (int j = 0; j < 31; ++j) w[j] = p.cm_conv_w[(l * 31 + j) * 256 + c];
        const float cb = p.cm_conv_b[l * 256 + c];
#pragma unroll 1
        for (int bt = 0; bt < 8; ++bt) { float in[34];
#pragma unroll
            for (int i = 0; i < 34; ++i) in[i] = yg[(th * 32 + bt * 4 + i) * 256 + c];
            float s0 = cb, s1 = cb, s2 = cb, s3 = cb;
#pragma unroll
            for (int j = 0; j < 31; ++j) { s0 += in[j] * w[j]; s1 += in[j + 1] * w[j]; s2 += in[j + 2] * w[j]; s3 += in[j + 3] * w[j]; }
            float* op = yo + (th * 32 + bt * 4) * 256 + c; op[0] = s0; op[256] = s1; op[512] = s2; op[768] = s3; } }
    __syncthreads();
    { const f32x4 lw = *(const f32x4*)(p.cm_ln_w + l * 256 + lane * 4), lb = *(const f32x4*)(p.cm_ln_b + l * 256 + lane * 4);
#pragma unroll 2
        for (int i = 0; i < 8; ++i) { const int t = wid * 8 + i; f32x4 v = *(const f32x4*)(yo + t * 256 + lane * 4);
            const float mean = wsum(v[0] + v[1] + v[2] + v[3], lane) * (1.0f / 256.0f); v -= mean;
            const float rstd = rsqrtf(wsum(v[0] * v[0] + v[1] * v[1] + v[2] * v[2] + v[3] * v[3], lane) * (1.0f / 256.0f) + EPS);
            v = v * rstd * lw + lb;
            u32x2 w; w.x = cvt_pk_bf16(siluf_(v[0]), siluf_(v[1])); w.y = cvt_pk_bf16(siluf_(v[2]), siluf_(v[3]));
            *(u32x2*)(ycat + (size_t)(tl.row0 + t) * DM + 768 + lane * 4) = w; } }
    __syncthreads();
}

constexpr int GL_G = 0, GL_WG = 32768, GL_BG = 40960, GL_LOW = 41472, GL_VT = 49664, GL_QIN = 86528, GL_KIN = 103936, GL_STT = 121344, GL_KD = 86528;

DEVI void gla_load_common(int wave, unsigned char* lds, const bf16_t* z, const Tile tl) {
    const int tid = my_tid_w(wave);
    float* low = (float*)(lds + GL_LOW); bf16_t* vT = (bf16_t*)(lds + GL_VT);
    if (tid < 256) { const int t = tid >> 2, part = tid & 3; const u32x4 v = *(const u32x4*)(z + (size_t)(tl.row0 + t) * ZP + ZLF + part * 8);
        float* d = low + t * 32 + part * 8; d[0] = bflo(v.x); d[1] = bfhi(v.x); d[2] = bflo(v.y); d[3] = bfhi(v.y); d[4] = bflo(v.z); d[5] = bfhi(v.z); d[6] = bflo(v.w); d[7] = bfhi(v.w); }
#pragma unroll 1
    for (int i = tid; i < 64 * 32; i += 512) { const int t = i >> 5, c8 = (i & 31) * 8; const u32x4 v = *(const u32x4*)(z + (size_t)(tl.row0 + t) * ZP + ZV + c8);
        vT[(c8 + 0) * 72 + t] = (bf16_t)(v.x & 0xffffu); vT[(c8 + 1) * 72 + t] = (bf16_t)(v.x >> 16); vT[(c8 + 2) * 72 + t] = (bf16_t)(v.y & 0xffffu); vT[(c8 + 3) * 72 + t] = (bf16_t)(v.y >> 16);
        vT[(c8 + 4) * 72 + t] = (bf16_t)(v.z & 0xffffu); vT[(c8 + 5) * 72 + t] = (bf16_t)(v.z >> 16); vT[(c8 + 6) * 72 + t] = (bf16_t)(v.w & 0xffffu); vT[(c8 + 7) * 72 + t] = (bf16_t)(v.w >> 16); }
}
DEVI void gla_gates(unsigned char* lds, const Params& p, int l, int dir) {
    const int tid = my_tid_w(p.wave);
    float* G = (float*)(lds + GL_G); float* WG = (float*)(lds + GL_WG); float* BG = (float*)(lds + GL_BG); const float* low = (const float*)(lds + GL_LOW);
    *(f32x4*)(WG + tid * 4) = *(const f32x4*)(p.gla_w_gate + (size_t)(l * 2 + dir) * 2048 + tid * 4);
    if (tid < 128) BG[tid] = p.gla_b_gate[(l * 2 + dir) * 128 + tid];
    __syncthreads();
    { const int t = tid >> 3, cgp = tid & 7; float lv[16];
#pragma unroll
        for (int r = 0; r < 16; ++r) lv[r] = low[t * 32 + dir * 16 + r];
#pragma unroll
        for (int j = 0; j < 16; ++j) { const int col = cgp * 16 + j; float a = BG[col];
#pragma unroll
            for (int r = 0; r < 16; ++r) a += lv[r] * WG[r * 128 + col];
            G[t * 128 + col] = fmaxf(logsigf_(a) * (1.0f / 16.0f), -1.0f); } }
    __syncthreads();
    if (tid < 128) { float run = 0.f;
        if (dir == 0) {
#pragma unroll 4
            for (int t = 0; t < 64; ++t) { run += G[t * 128 + tid]; G[t * 128 + tid] = run; } }
        else {
#pragma unroll 4
            for (int t = 63; t >= 0; --t) { run += G[t * 128 + tid]; G[t * 128 + tid] = run; } } }
    __syncthreads();
}

DEVI void gla_sum_item(unsigned char* lds, const Params& p, int l, const Tile tl) {
    const int tid = my_tid_w(p.wave), wid = tid >> 6, lane = tid & 63, fr = lane & 15, fq = lane >> 4;
    const bf16_t* z = (const bf16_t*)(p.ws + OFF_Z);
    float* ST = (float*)(p.ws + OFF_ST); float* DEC = (float*)(p.ws + OFF_DEC);
    const float* G = (const float*)(lds + GL_G); bf16_t* KD = (bf16_t*)(lds + GL_KD); const bf16_t* vT = (const bf16_t*)(lds + GL_VT);
    const int cid = tl.row0 >> 6;
    gla_load_common(p.wave, lds, z, tl);
    for (int dir = 0; dir < 2; ++dir) {
        gla_gates(lds, p, l, dir);
        { const int col = tid & 127, tq = tid >> 7; const float cl = G[(dir ? 0 : 63) * 128 + col];
#pragma unroll 4
            for (int tt = 0; tt < 16; ++tt) { const int t = tq * 16 + tt; const float k = bf2f(z[(size_t)(tl.row0 + t) * ZP + ZK + col]);
                KD[col * 72 + t] = f2bf(k * __expf(cl - G[t * 128 + col])); }
            if (tid < 128) DEC[((size_t)(cid * 4 + (col >> 5)) * 2 + dir) * 32 + (col & 31)] = __expf(cl); }
        __syncthreads();
        { const int h = wid >> 1, mt = wid & 1;
            const bf16x8 a0 = *(const bf16x8*)(KD + (h * 32 + mt * 16 + fr) * 72 + fq * 8), a1 = *(const bf16x8*)(KD + (h * 32 + mt * 16 + fr) * 72 + 32 + fq * 8);
#pragma unroll
            for (int nt = 0; nt < 4; ++nt) { const bf16x8 b0 = *(const bf16x8*)(vT + (h * 64 + nt * 16 + fr) * 72 + fq * 8), b1 = *(const bf16x8*)(vT + (h * 64 + nt * 16 + fr) * 72 + 32 + fq * 8);
                f32x4 acc = (f32x4){0.f, 0.f, 0.f, 0.f}; acc = MFMA16(b0, a0, acc); acc = MFMA16(b1, a1, acc);
                *(f32x4*)(ST + ((size_t)(cid * 4 + h) * 2 + dir) * 2048 + (mt * 16 + fr) * 64 + nt * 16 + 4 * fq) = acc; } }
        __syncthreads();
    }
}

DEVI void gla_scan_phase(const Params& p) {
    float* ST = (float*)(p.ws + OFF_ST); const float* DEC = (const float*)(p.ws + OFF_DEC);
    for (int gt = blockIdx.x * 512 + my_tid_w(p.wave); gt < 65536; gt += gridDim.x * 512) {
        const int chain = gt >> 11, e = gt & 2047; const int dir = chain & 1, h = (chain >> 1) & 3, b = chain >> 3; const int d = e >> 6;
        float S = 0.f;
        for (int s0 = 0; s0 < 132; s0 += 12) {
            float kv[12], dc[12];
#pragma unroll
            for (int j = 0; j < 12; ++j) { const int s = s0 + j; const int cid = (s < 4) ? (512 + b * 4 + (dir ? 3 - s : s)) : (b * 128 + (dir ? 131 - s : s - 4));
                const size_t slot = (size_t)(cid * 4 + h) * 2 + dir; kv[j] = ST[slot * 2048 + e]; dc[j] = DEC[slot * 32 + d]; }
#pragma unroll
            for (int j = 0; j < 12; ++j) { const int s = s0 + j; const int cid = (s < 4) ? (512 + b * 4 + (dir ? 3 - s : s)) : (b * 128 + (dir ? 131 - s : s - 4));
                const size_t slot = (size_t)(cid * 4 + h) * 2 + dir; ST[slot * 2048 + e] = S; S = dc[j] * S + kv[j]; }
        }
    }
}

DEVI void gla_out_item(unsigned char* lds, const Params& p, int l, const Tile tl) {
    const int tid = my_tid_w(p.wave), wid = tid >> 6, lane = tid & 63, fr = lane & 15, fq = lane >> 4;
    const bf16_t* z = (const bf16_t*)(p.ws + OFF_Z);
    bf16_t* ycat = (bf16_t*)(p.ws + OFF_H);
    const float* ST = (const float*)(p.ws + OFF_ST);
    const float* G = (const float*)(lds + GL_G); bf16_t* QIN = (bf16_t*)(lds + GL_QIN); bf16_t* KIN = (bf16_t*)(lds + GL_KIN); bf16_t* STT = (bf16_t*)(lds + GL_STT);
    const bf16_t* vT = (const bf16_t*)(lds + GL_VT); bf16_t* AB = (bf16_t*)(lds + GL_G) + wid * 2304;
    const int cid = tl.row0 >> 6; const int h = wid >> 1, half = wid & 1;
    gla_load_common(p.wave, lds, z, tl);
    f32x4 o[2][4];
#pragma unroll
    for (int mi = 0; mi < 2; ++mi)
#pragma unroll
        for (int nt = 0; nt < 4; ++nt) o[mi][nt] = (f32x4){0.f, 0.f, 0.f, 0.f};
    for (int dir = 0; dir < 2; ++dir) {
        gla_gates(lds, p, l, dir);
        { const int col = tid & 127, tq = tid >> 7;
#pragma unroll 2
            for (int tt = 0; tt < 16; ++tt) { const int t = tq * 16 + tt; const float cum = G[t * 128 + col];
                const float q = bf2f(z[(size_t)(tl.row0 + t) * ZP + ZQ + col]) * 0.17677669529663687f * __expf(cum);
                const float k = bf2f(z[(size_t)(tl.row0 + t) * ZP + ZK + col]) * __expf(-cum);
                QIN[t * 136 + col] = f2bf(q); KIN[t * 136 + col] = f2bf(k); }
#pragma unroll 1
            for (int i = tid; i < 2048; i += 512) { const int hh = i >> 9, rem = i & 511; const int dd = rem >> 4, e4 = (rem & 15) * 4;
                const f32x4 v = *(const f32x4*)(ST + ((size_t)(cid * 4 + hh) * 2 + dir) * 2048 + dd * 64 + e4);
#pragma unroll
                for (int j = 0; j < 4; ++j) STT[(hh * 64 + e4 + j) * 40 + dd] = f2bf(v[j]); } }
        __syncthreads();
#pragma unroll
        for (int mi = 0; mi < 2; ++mi) { const int t = (half * 2 + mi) * 16 + fr; const bf16x8 qa = *(const bf16x8*)(QIN + t * 136 + h * 32 + fq * 8);
#pragma unroll
            for (int st = 0; st < 4; ++st) { const bf16x8 kb = *(const bf16x8*)(KIN + (st * 16 + fr) * 136 + h * 32 + fq * 8);
                f32x4 acc = (f32x4){0.f, 0.f, 0.f, 0.f}; acc = MFMA16(kb, qa, acc);
                const int s0 = st * 16 + 4 * fq;
#pragma unroll
                for (int j = 0; j < 4; ++j) { const int s = s0 + j; const bool keep = dir ? (s >= t) : (s <= t); acc[j] = keep ? acc[j] : 0.f; }
                u32x2 w; w.x = cvt_pk_bf16(acc[0], acc[1]); w.y = cvt_pk_bf16(acc[2], acc[3]);
                *(u32x2*)(AB + (mi * 16 + fr) * 72 + s0) = w; } }
        __syncthreads();
#pragma unroll
        for (int mi = 0; mi < 2; ++mi) { const int t = (half * 2 + mi) * 16 + fr;
            const bf16x8 aa0 = *(const bf16x8*)(AB + (mi * 16 + fr) * 72 + fq * 8), aa1 = *(const bf16x8*)(AB + (mi * 16 + fr) * 72 + 32 + fq * 8);
            const bf16x8 qa = *(const bf16x8*)(QIN + t * 136 + h * 32 + fq * 8);
#pragma unroll
            for (int nt = 0; nt < 4; ++nt) { const int er = h * 64 + nt * 16 + fr;
                const bf16x8 vb0 = *(const bf16x8*)(vT + er * 72 + fq * 8), vb1 = *(const bf16x8*)(vT + er * 72 + 32 + fq * 8), sb = *(const bf16x8*)(STT + er * 40 + fq * 8);
                o[mi][nt] = MFMA16(vb0, aa0, o[mi][nt]); o[mi][nt] = MFMA16(vb1, aa1, o[mi][nt]); o[mi][nt] = MFMA16(sb, qa, o[mi][nt]); } }
        __syncthreads();
    }
#pragma unroll
    for (int mi = 0; mi < 2; ++mi) { const int t = (half * 2 + mi) * 16 + fr; float ss = 0.f;
#pragma unroll
        for (int nt = 0; nt < 4; ++nt) ss += o[mi][nt][0] * o[mi][nt][0] + o[mi][nt][1] * o[mi][nt][1] + o[mi][nt][2] * o[mi][nt][2] + o[mi][nt][3] * o[mi][nt][3];
        ss += shx(ss, 16, lane); ss += shx(ss, 32, lane);
        const float rs = rsqrtf(ss * (1.0f / 64.0f) + EPS);
#pragma unroll
        for (int nt = 0; nt < 4; ++nt) { const int col = h * 64 + nt * 16 + 4 * fq; const f32x4 nw = *(const f32x4*)(p.gla_norm_w + l * 256 + col);
            const u32x2 raw = *(const u32x2*)(z + (size_t)(tl.row0 + t) * ZP + ZR + col);
            const float v0 = o[mi][nt][0] * rs * nw[0] * siluf_(bflo(raw.x)), v1 = o[mi][nt][1] * rs * nw[1] * siluf_(bfhi(raw.x)), v2 = o[mi][nt][2] * rs * nw[2] * siluf_(bflo(raw.y)), v3 = o[mi][nt][3] * rs * nw[3] * siluf_(bfhi(raw.y));
            u32x2 w; w.x = cvt_pk_bf16(v0, v1); w.y = cvt_pk_bf16(v2, v3);
            *(u32x2*)(ycat + (size_t)(tl.row0 + t) * DM + col) = w; } }
    __syncthreads();
}

DEVI void mix_phase(unsigned char* lds, const Params& p, int l) {
    const int n64 = (l == 0) ? 528 : 512, n128 = (l == 0) ? 264 : 256;
    const int nD = n64, nS = 528, nB = n64, nC = n128;
    const int total = nD + nS + nB + nC;
    for (int item = blockIdx.x; item < total; item += gridDim.x) {
        int it = item;
        if (it < nD) { cm_item(lds, p, l, tile_of(it, 64)); continue; }
        it -= nD;
        if (it < nS) { gla_sum_item(lds, p, l, tile_of(it, 64)); continue; }
        it -= nS;
        if (it < nB) { pool_item(lds, p, l, tile_of(it, 64)); continue; }
        it -= nB;
        sgu_item(lds, p, l, tile_of(it, 128));
    }
}
DEVI void gla_out_phase(unsigned char* lds, const Params& p, int l) {
    const int n64 = (l == 0) ? 528 : 512;
    for (int item = blockIdx.x; item < n64; item += gridDim.x) gla_out_item(lds, p, l, tile_of(item, 64));
}

DEVI void ffnconv_phase(unsigned char* lds, const Params& p, int l, int chunk) {
    const int lane = my_lane(); const int tg = p.wave;
    const int nu = c_cnu[chunk], u0 = c_cu0[chunk]; const int kc = nu * 128;
    const int ntile = (l == 0) ? 528 : 512, npx = ntile >> 3;
    const bf16_t* U = (const bf16_t*)(p.ws + OFF_U); bf16_t* ACT = (bf16_t*)(p.ws + OFF_ACT);
    const int xg = blockIdx.x & 7, slot = blockIdx.x >> 3, nslot = gridDim.x >> 3;
    float wA[9][2], wG[9][2];
#pragma unroll
    for (int t = 0; t < 9; ++t) { wA[t][0] = 0.f; wA[t][1] = 0.f; wG[t][0] = 0.f; wG[t][1] = 0.f; }
    int cur_uu = -1;
    for (int j = slot; j < nu * npx; j += nslot) {
        const int uu = j / npx, rt = xg * npx + (j % npx); const Tile tl = tile_of(rt, 64);
        if (uu != cur_uu) {
#pragma unroll
            for (int t = 0; t < 9; ++t) { const float* wp = p.ffn_conv_w + ((size_t)l * 9 + t) * 5632 + (u0 + uu) * 128 + lane * 2;
                const f32x2 a = *(const f32x2*)wp, g = *(const f32x2*)(wp + FH); wA[t][0] = a[0]; wA[t][1] = a[1]; wG[t][0] = g[0]; wG[t][1] = g[1]; }
            cur_uu = uu;
        }
        const bool lat = tl.L == SEQ; const int gr = tl.T0 >> 6;
        const int c0 = tg * 8; const int seqc0 = (lat ? 0 : tl.T0) + c0, width = lat ? 64 : CTXL;
        float aA[8][2], aG[8][2];
#pragma unroll
        for (int t = 0; t < 8; ++t) { aA[t][0] = 0.f; aA[t][1] = 0.f; aG[t][0] = 0.f; aG[t][1] = 0.f; }
#pragma unroll
        for (int dr = 0; dr < 3; ++dr) {
            const bool rvalid = lat ? (gr + dr - 1 >= 0 && gr + dr - 1 < 128) : (dr == 1);
            if (rvalid) {
                const bf16_t* pb = U + ((size_t)(tl.row0 + (lat ? (dr - 1) * 64 : 0) + c0 - 1) * UPITCH + uu * 256 + lane * 2);
                unsigned va[10], vg[10];
#pragma unroll
                for (int q = 0; q < 10; ++q) { const int col = seqc0 + q - 1; va[q] = 0u; vg[q] = 0u;
                    if (col >= 0 && col < width) { va[q] = *(const unsigned*)(pb + (size_t)q * UPITCH); vg[q] = *(const unsigned*)(pb + (size_t)q * UPITCH + 128); } }
#pragma unroll
                for (int t = 0; t < 8; ++t)
#pragma unroll
                    for (int dc = 0; dc < 3; ++dc) { const int tap = dr * 3 + dc; const unsigned a = va[t + dc], g = vg[t + dc];
                        aA[t][0] += bflo(a) * wA[tap][0]; aA[t][1] += bfhi(a) * wA[tap][1]; aG[t][0] += bflo(g) * wG[tap][0]; aG[t][1] += bfhi(g) * wG[tap][1]; }
            }
        }
        bf16_t* ap = ACT + (size_t)(tl.row0 + c0) * kc + uu * 128 + lane * 2;
#pragma unroll
        for (int t = 0; t < 8; ++t) *(unsigned*)(ap + (size_t)t * kc) = cvt_pk_bf16(siluf_(aG[t][0]) * aA[t][0], siluf_(aG[t][1]) * aA[t][1]);
    }
}

DEVI void grid_barrier(unsigned* ctr, unsigned target) {
    asm volatile("s_waitcnt vmcnt(0)" ::: "memory");
    __syncthreads();
    if (threadIdx.x == 0) {
        __builtin_amdgcn_fence(__ATOMIC_RELEASE, "agent");
        asm volatile("s_waitcnt vmcnt(0)" ::: "memory");
        __hip_atomic_fetch_add(ctr, 1u, __ATOMIC_RELAXED, __HIP_MEMORY_SCOPE_AGENT);
        unsigned spins = 0;
        while (__hip_atomic_load(ctr, __ATOMIC_RELAXED, __HIP_MEMORY_SCOPE_AGENT) < target) { __builtin_amdgcn_s_sleep(1); if (++spins > (1u << 24)) break; }
        __builtin_amdgcn_fence(__ATOMIC_ACQUIRE, "agent");
        asm volatile("s_waitcnt vmcnt(0)" ::: "memory");
    }
    __syncthreads();
}

constexpr int PH_PER_LAYER = 17, N_PHASES = 1 + 2 * PH_PER_LAYER;

DEVI void run_phase(unsigned char* shm, const Params& p, int ph) {
    LAS unsigned char* lds3 = (LAS unsigned char*)shm;
    unsigned char* ws = p.ws;
    const float* mods = (const float*)(ws + OFF_MODS);
    float* X = (float*)(ws + OFF_X); bf16_t* H = (bf16_t*)(ws + OFF_H); bf16_t* Z = (bf16_t*)(ws + OFF_Z); bf16_t* U = (bf16_t*)(ws + OFF_U); bf16_t* ACT = (bf16_t*)(ws + OFF_ACT);
    if (ph == 0) { prep_phase(shm, p); return; }
    const int l = (ph - 1) / PH_PER_LAYER, k = (ph - 1) % PH_PER_LAYER;
    const float* ml = mods + l * 5 * 6144;
    const int Mrows = (l == 0) ? ROWS : NLAT;
    pg8::StaticOrder S;
    switch (k) {
    case 0: if (l == 0) ln_phase(p.wave, p.x, p.ctx, ROWS, nullptr, nullptr, nullptr, nullptr, ml, 0, H); break;
    case 1: { pg8::Gemm g{H, (const bf16_t*)(ws + OFF_WIN) + (size_t)l * 2304 * 1024, ROWS, ZP, 1024}; S.init(g.M, g.N, gridDim.x, blockIdx.x);
        pg8::EpiBf16 E{Z, ZP}; pg8::gemm_phase(lds3, g, S, E, p.wave); } break;
    case 2: mix_phase(shm, p, l); break;
    case 3: gla_scan_phase(p); break;
    case 4: gla_out_phase(shm, p, l); break;
    case 5: { pg8::Gemm g{H, (const bf16_t*)(ws + OFF_WOUT) + (size_t)l * 1024 * 1024, Mrows, 1024, 1024}; S.init(g.M, g.N, gridDim.x, blockIdx.x);
        pg8::EpiRes E{X, l == 0 ? p.x : X, l == 0 ? p.ctx : X + (size_t)NLAT * DM, ml, 2 * 1024, 0}; pg8::gemm_phase(lds3, g, S, E, p.wave); } break;
    case 6: ln_phase(p.wave, X, X + (size_t)NLAT * DM, Mrows, p.post_ln_w + (l * 2 + 0) * 1024, p.post_ln_b + (l * 2 + 0) * 1024, X, nullptr, ml, 3 * 1024, H); break;
    case 7: case 10: case 13: { const int ch = (k - 7) / 3; const int u0 = c_cu0[ch], nu = c_cnu[ch];
        pg8::Gemm g{H, (const bf16_t*)(ws + OFF_WUP) + (size_t)l * 5632 * 1024 + (size_t)u0 * 256 * 1024, Mrows, nu * 256, 1024}; S.init(g.M, g.N, gridDim.x, blockIdx.x);
        pg8::EpiBf16 E{U, UPITCH}; pg8::gemm_phase(lds3, g, S, E, p.wave); } break;
    case 8: case 11: case 14: ffnconv_phase(shm, p, l, (k - 8) / 3); break;
    case 9: case 12: case 15: { const int ch = (k - 9) / 3; const int u0 = c_cu0[ch], nu = c_cnu[ch];
        pg8::Gemm g{ACT, (const bf16_t*)(ws + OFF_WDN) + (size_t)l * 1024 * FH + (size_t)u0 * 128 * 1024, Mrows, 1024, nu * 128}; S.init(g.M, g.N, gridDim.x, blockIdx.x);
        pg8::EpiRes E{X, X, X + (size_t)NLAT * DM, ml, 5 * 1024, ch == 0 ? 0 : 1}; pg8::gemm_phase(lds3, g, S, E, p.wave); } break;
    case 16:
        if (l == 0) ln_phase(p.wave, X, X + (size_t)NLAT * DM, ROWS, p.post_ln_w + (l * 2 + 1) * 1024, p.post_ln_b + (l * 2 + 1) * 1024, X, nullptr, mods + 5 * 6144, 0, H);
        else ln_phase(p.wave, X, X + (size_t)NLAT * DM, NLAT, p.post_ln_w + (l * 2 + 1) * 1024, p.post_ln_b + (l * 2 + 1) * 1024, nullptr, p.out, nullptr, 0, nullptr);
        break;
    }
}

__global__ void __launch_bounds__(512, 2) mega(Params p, int ph_lo, int ph_hi, int coop) {
    extern __shared__ __attribute__((aligned(16))) unsigned char shm[];
    unsigned* ctr = (unsigned*)(p.ws + OFF_CTL);
    unsigned epoch = 0;
    Params q = p; q.wave = __builtin_amdgcn_readfirstlane((int)(threadIdx.x >> 6));
    for (int ph = ph_lo; ph < ph_hi; ++ph) {
        if (ph == 1 + PH_PER_LAYER) continue;
        run_phase(shm, q, ph);
#if PROBE_REP > 0
        if (ph == PROBE_PH || ph == PROBE_PH2) for (int rep = 0; rep < PROBE_REP; ++rep) { ++epoch; grid_barrier(ctr, epoch * gridDim.x); run_phase(shm, q, ph); }
#endif
        if (coop && ph + 1 < ph_hi) {
            if (ph == 0) cg::this_grid().sync();
            else { ++epoch; grid_barrier(ctr, epoch * gridDim.x); }
        }
    }
}

extern "C" void kernel_launch(void* const* d_in, const int* in_sizes, int n_in, void* d_out, int out_size, void* d_ws, size_t ws_size, hipStream_t stream) {
    static int grid = 0;
    if (grid == 0) {
        if (n_in != 26 || ws_size < WS_END) { fprintf(stderr, "kernel_launch: unexpected n_in %d / ws_size %zu (need %zu)\n", n_in, ws_size, (size_t)WS_END); grid = -1; return; }
        int dev = 0, cus = 0, per_cu = 0;
        hipGetDevice(&dev); hipDeviceGetAttribute(&cus, hipDeviceAttributeMultiprocessorCount, dev);
        if (hipFuncSetAttribute((const void*)mega, hipFuncAttributeMaxDynamicSharedMemorySize, LDS_BYTES) != hipSuccess) { fprintf(stderr, "kernel_launch: hipFuncSetAttribute failed\n"); grid = -1; return; }
        if (hipOccupancyMaxActiveBlocksPerMultiprocessor(&per_cu, (const void*)mega, 512, LDS_BYTES) != hipSuccess || per_cu < 1) { fprintf(stderr, "kernel_launch: occupancy query says %d\n", per_cu); per_cu = 1; }
        (void)hipGetLastError();
        grid = cus * 1;
    }
    if (grid < 0) return;
    Params p{};
    const float** pp = (const float**)&p;
    for (int i = 0; i < 26; ++i) pp[i] = (const float*)d_in[i];
    p.wave = 0; p.pad_ = 0;
    p.out = (float*)d_out; p.ws = (unsigned char*)d_ws;
#if MK_COOP
    hipMemsetAsync((char*)d_ws + OFF_CTL, 0, 4096, stream);
    int lo = 0, hi = N_PHASES, coop = 1;
    void* args[] = {&p, &lo, &hi, &coop};
    hipError_t e = hipLaunchCooperativeKernel((const void*)mega, dim3(grid), dim3(512), args, LDS_BYTES, stream);
    if (e != hipSuccess) fprintf(stderr, "cooperative launch failed: %s (grid %d)\n", hipGetErrorString(e), grid);
#else
    for (int ph = 0; ph < N_PHASES; ++ph) {
        if (ph == 1 + PH_PER_LAYER) continue;
        hipLaunchKernelGGL(mega, dim3(grid), dim3(512), LDS_BYTES, stream, p, ph, ph + 1, 0);
    }
#endif
}
```

```cpp
#include <hip/hip_runtime.h>
#include <hip/hip_cooperative_groups.h>
#include <cstdio>
#include <cstdint>
namespace cg = cooperative_groups;

#ifndef PROBE_REP
#define PROBE_REP 0
#define PROBE_PH -1
#define PROBE_PH2 -1
#endif
#ifndef MK_COOP
#define MK_COOP 1
#endif

#define DEVI __device__ __forceinline__
#define LAS __attribute__((address_space(3)))
typedef unsigned short bf16_t;
typedef short bf16x8 __attribute__((ext_vector_type(8)));
typedef float f32x4 __attribute__((ext_vector_type(4)));
typedef float f32x2 __attribute__((ext_vector_type(2)));
typedef unsigned u32x4 __attribute__((ext_vector_type(4)));
typedef unsigned u32x2 __attribute__((ext_vector_type(2)));

constexpr int DM = 1024, SEQ = 8192, CTXL = 256, NLAT = 32768, NCTX = 1024, ROWS = 33792;
constexpr int ZP = 2304;
constexpr int ZQ = 0, ZK = 128, ZV = 256, ZR = 512, ZLF = 768, ZB = 800, ZCU = 1056, ZCV = 1312, ZDA = 1568, ZDG = 1824;
constexpr int FH = 2816, UPITCH = 1280;
constexpr float ALPHA = 1.41421356237f, EPS = 1e-6f;
constexpr int LDS_BYTES = 160 * 1024;
constexpr int NCHUNK64 = 528;

constexpr size_t OFF_CTL = 0;
constexpr size_t OFF_MODS = 4096;
constexpr size_t OFF_SGUW = OFF_MODS + 2ull * 5 * 6144 * 4;
constexpr size_t OFF_POOLW = OFF_SGUW + 2ull * 4 * 128 * 128 * 2;
constexpr size_t OFF_WIN = OFF_POOLW + 2ull * 4 * 64 * 64 * 2;
constexpr size_t OFF_WOUT = OFF_WIN + 2ull * 2304 * 1024 * 2;
constexpr size_t OFF_WUP = OFF_WOUT + 2ull * 1024 * 1024 * 2;
constexpr size_t OFF_WDN = OFF_WUP + 2ull * 5632 * 1024 * 2;
constexpr size_t OFF_X = OFF_WDN + 2ull * 1024 * 2816 * 2;
constexpr size_t OFF_H = OFF_X + (size_t)ROWS * 1024 * 4;
constexpr size_t OFF_R1 = OFF_H + (size_t)ROWS * 1024 * 2;
constexpr size_t OFF_Z = OFF_R1;
constexpr size_t OFF_ST = OFF_Z + (size_t)ROWS * ZP * 2;
constexpr size_t OFF_DEC = OFF_ST + (size_t)NCHUNK64 * 8 * 2048 * 4;
constexpr size_t OFF_U = OFF_R1;
constexpr size_t OFF_ACT = OFF_U + (size_t)ROWS * UPITCH * 2;
constexpr size_t WS_END = OFF_ACT + (size_t)ROWS * FH * 2;
static_assert(WS_END <= 536870912ull, "workspace map exceeds the guaranteed 4 x largest-tensor size");
static_assert(OFF_DEC + (size_t)NCHUNK64 * 8 * 32 * 4 <= WS_END, "mixer scratch must fit");

struct Params {
    const float *x, *c, *ctx, *c_ctx, *w_mod, *b_mod, *w_in, *gla_w_gate, *gla_b_gate, *gla_norm_w, *pool_w, *pool_scale, *sgu_w, *sgu_b,
        *sgu_ln_w, *sgu_ln_b, *cm_conv_w, *cm_conv_b, *cm_ln_w, *cm_ln_b, *w_out, *ffn_w_up, *ffn_conv_w, *ffn_w_down, *post_ln_w, *post_ln_b;
    float* out; unsigned char* ws;
    int wave, pad_;
};

DEVI float bf2f(unsigned v) { return __uint_as_float(v << 16); }
DEVI float bflo(unsigned v) { return __uint_as_float(v << 16); }
DEVI float bfhi(unsigned v) { return __uint_as_float(v & 0xffff0000u); }
DEVI unsigned cvt_pk_bf16(float lo, float hi) { unsigned r; asm volatile("v_cvt_pk_bf16_f32 %0, %1, %2" : "=v"(r) : "v"(lo), "v"(hi)); return r; }
DEVI bf16_t f2bf(float f) { return (bf16_t)(cvt_pk_bf16(f, 0.f) & 0xffffu); }
DEVI int my_lane() { int t; asm volatile("v_mbcnt_lo_u32_b32 %0, -1, 0\n\tv_mbcnt_hi_u32_b32 %0, -1, %0" : "=v"(t)); return t; }
DEVI int my_tid_w(int wave) { return (wave << 6) | my_lane(); }
DEVI float shx(float v, int o, int lane) { return __int_as_float(__builtin_amdgcn_ds_bpermute((lane ^ o) << 2, __float_as_int(v))); }
DEVI float wsum(float v, int lane) {
#pragma unroll
    for (int o = 32; o; o >>= 1) v += shx(v, o, lane);
    return v; }
DEVI float sigmoidf_(float x) { return 1.0f / (1.0f + __expf(-x)); }
DEVI float siluf_(float x) { return x / (1.0f + __expf(-x)); }
DEVI float geluf_(float x) { const float u = 0.7978845608f * (x + 0.044715f * x * x * x); return x / (1.0f + __expf(-2.0f * u)); }
DEVI float logsigf_(float x) { return fminf(x, 0.f) - log1pf(__expf(-fabsf(x))); }
#define MFMA16(a, b, c) __builtin_amdgcn_mfma_f32_16x16x32_bf16((a), (b), (c), 0, 0, 0)

namespace pg8 {
constexpr int BM = 256, BK = 64, HALF = 128, HTB = HALF * BK * 2, STAGE_BYTES = 8 * HTB, NXCD = 8, WGM = 8;
DEVI int lds_byte(int r, int c) { const int st = (r >> 4) * 2 + (c >> 5), rr = r & 15, cc = c & 31, ob = rr * 64 + cc * 2; return st * 1024 + (ob ^ (((ob >> 9) & 1) << 5)); }
DEVI void stage_rc(int b, int& R, int& C) { const int st = b / 1024, sb = b % 1024, swz = sb ^ (((sb >> 9) & 1) << 5); R = (st >> 1) * 16 + swz / 64; C = (st & 1) * 32 + (swz % 64) / 2; }
DEVI int perm32(int rho) { const int n = rho >> 4, i = rho & 15; return 8 * (i >> 2) + 4 * n + (i & 3); }
struct Unit { int pm, pn; };
struct Gemm { const bf16_t* A; const bf16_t* Bt; int M, N, K; };
struct StaticOrder {
    int nM, nN, nwg, G, c;
    DEVI void init(int M, int N, int G_, int c_) { nM = M / BM; nN = N / BM; nwg = nM * nN; G = G_; c = c_; }
    DEVI bool next(int i, Unit& u) const {
        const long L = (long)i * G + c; if (L >= nwg) return false;
        int wgid = (int)L; { const int q = nwg / NXCD, r = nwg % NXCD, xcd = wgid % NXCD, off = wgid / NXCD; wgid = (xcd < r ? xcd * (q + 1) : r * (q + 1) + (xcd - r) * q) + off; }
        const int nig = WGM * nN, gid = wgid / nig, fm = gid * WGM, gsz = (nM - fm) < WGM ? (nM - fm) : WGM;
        u.pm = fm + ((wgid % nig) % gsz); u.pn = (wgid % nig) / gsz; return true;
    }
    DEVI void a_ready(const Unit&) const {}
    DEVI void done(const Unit&) const {}
};

struct EpiBf16 {
    static constexpr bool PERM = true;
    bf16_t* O; int ldc;
    DEVI void operator()(const f32x4 (&acc)[2][2][4][2], const Unit& u, int wr, int wc, int, int) const {
        const int ln = my_lane(), fr = ln & 15, fq = ln >> 4;
        const int row0 = u.pm * BM + wr * 64 + fr; const int col0 = u.pn * BM + wc * 32 + 8 * fq;
#pragma unroll
        for (int ai = 0; ai < 2; ++ai)
#pragma unroll
            for (int m = 0; m < 4; ++m) { bf16_t* rowp = O + (size_t)(row0 + ai * HALF + m * 16) * ldc + col0;
#pragma unroll
                for (int bj = 0; bj < 2; ++bj) { const f32x4 v0 = acc[ai][bj][m][0], v1 = acc[ai][bj][m][1];
                    u32x4 w; w.x = cvt_pk_bf16(v0[0], v0[1]); w.y = cvt_pk_bf16(v0[2], v0[3]); w.z = cvt_pk_bf16(v1[0], v1[1]); w.w = cvt_pk_bf16(v1[2], v1[3]);
                    *(u32x4*)(rowp + bj * HALF) = w; } }
    }
};
struct EpiRes {
    static constexpr bool PERM = true;
    float* X; const float* srcL; const float* srcC; const float* mods; int goff; int mode;
    DEVI void operator()(const f32x4 (&acc)[2][2][4][2], const Unit& u, int wr, int wc, int, int) const {
        const int ln = my_lane(), fr = ln & 15, fq = ln >> 4;
        const int rowt = u.pm * BM; const int b = rowt < NLAT ? (rowt >> 13) : 4;
        float* dst = X + (size_t)rowt * DM;
        const float* src = (mode == 0) ? (rowt < NLAT ? srcL + (size_t)rowt * DM : srcC + (size_t)(rowt - NLAT) * DM) : dst;
        const float al = (mode == 0) ? ALPHA : 1.0f;
        const int rl = wr * 64 + fr;
        const int col0 = u.pn * BM + wc * 32 + 8 * fq;
        const float* gp = mods + b * 6144 + goff + col0;
        f32x4 gv[2][2];
#pragma unroll
        for (int bj = 0; bj < 2; ++bj)
#pragma unroll
            for (int n = 0; n < 2; ++n) gv[bj][n] = *(const f32x4*)(gp + bj * HALF + n * 4);
#pragma unroll
        for (int ai = 0; ai < 2; ++ai)
#pragma unroll
            for (int m = 0; m < 4; ++m) { const size_t ro = (size_t)(rl + ai * HALF + m * 16) * DM + col0;
#pragma unroll
                for (int bj = 0; bj < 2; ++bj) { const f32x4 x0 = *(const f32x4*)(src + ro + bj * HALF), x1 = *(const f32x4*)(src + ro + bj * HALF + 4);
                    *(f32x4*)(dst + ro + bj * HALF) = al * x0 + gv[bj][0] * acc[ai][bj][m][0];
                    *(f32x4*)(dst + ro + bj * HALF + 4) = al * x1 + gv[bj][1] * acc[ai][bj][m][1]; } }
    }
};

template <class Epi, class Sched>
DEVI void gemm_phase(LAS unsigned char* lds, const Gemm g, const Sched& S, const Epi& E, int wave) {
    const int tid = my_tid_w(wave), wid = __builtin_amdgcn_readfirstlane(tid >> 6), lane = tid & 63, wr = wid >> 2, wc = wid & 3, fr = lane & 15, fq = lane >> 4;
    const int K = g.K, nt = K / BK;
    unsigned voffA[2], voffB[2];
#pragma unroll
    for (int i = 0; i < 2; ++i) { int R, C; stage_rc(tid * 16 + i * 8192, R, C); const int Rb = Epi::PERM ? ((R & ~31) + perm32(R & 31)) : R;
        voffA[i] = (unsigned)(R * K + C) * 2u; voffB[i] = (unsigned)(Rb * K + C) * 2u; }
    const size_t kstep = (size_t)(BK * 2);
    const size_t hstep = (size_t)HALF * K * 2;
    const size_t tstep = 2 * hstep;
    const unsigned ldsw = (unsigned)wid * 1024u;
    const int aoff = lds_byte(wr * 64 + fr, fq * 8), boff = lds_byte(wc * 32 + fr, fq * 8);
#define PG8_SA(b, h) (((b) * 2 + (h)) * HTB)
#define PG8_SB(b, h) ((4 + (b) * 2 + (h)) * HTB)
#define PG8_STAGE(bufoff, gbase, voff) do { _Pragma("unroll") for (int _i = 0; _i < 2; ++_i) \
        __builtin_amdgcn_global_load_lds((const unsigned*)((const char*)(gbase) + (voff)[_i]), (LAS unsigned*)(lds + (bufoff) + ldsw + _i * 8192), 16, 0, 0); } while (0)
#define PG8_LDA(dst, b, h) do { _Pragma("unroll") for (int m = 0; m < 4; ++m) _Pragma("unroll") for (int k = 0; k < 2; ++k) dst[m][k] = *(const LAS bf16x8*)(lds + PG8_SA(b, h) + aoff + m * 2048 + k * 1024); } while (0)
#define PG8_LDB(dst, b, h) do { _Pragma("unroll") for (int n = 0; n < 2; ++n) _Pragma("unroll") for (int k = 0; k < 2; ++k) dst[n][k] = *(const LAS bf16x8*)(lds + PG8_SB(b, h) + boff + n * 2048 + k * 1024); } while (0)
#define PG8_MMA(ai, bj, At, Bt) do { __builtin_amdgcn_s_setprio(1); _Pragma("unroll") for (int m = 0; m < 4; ++m) _Pragma("unroll") for (int n = 0; n < 2; ++n) _Pragma("unroll") for (int k = 0; k < 2; ++k) \
        acc[ai][bj][m][n] = __builtin_amdgcn_mfma_f32_16x16x32_bf16(Bt[n][k], At[m][k], acc[ai][bj][m][n], 0, 0, 0); __builtin_amdgcn_s_setprio(0); } while (0)
#define PG8_WAIT_V(n) asm volatile("s_waitcnt vmcnt(" #n ")" ::: "memory")
#define PG8_WAIT_L(n) asm volatile("s_waitcnt lgkmcnt(" #n ")" ::: "memory")
#define PG8_BAR __builtin_amdgcn_s_barrier()
#define PG8_SCHED __builtin_amdgcn_sched_barrier(0)
    Unit cur, nxt; int ui = 0;
    if (!S.next(0, cur)) return;
    f32x4 acc[2][2][4][2];
#pragma unroll
    for (int a = 0; a < 2; ++a)
#pragma unroll
        for (int b = 0; b < 2; ++b)
#pragma unroll
            for (int m = 0; m < 4; ++m)
#pragma unroll
                for (int n = 0; n < 2; ++n) acc[a][b][m][n] = (f32x4){0.f, 0.f, 0.f, 0.f};
    bf16x8 At[4][2], B0[2][2], B1[2][2];
    const char* cA = (const char*)g.A + (size_t)cur.pm * tstep; const char* cB = (const char*)g.Bt + (size_t)cur.pn * tstep;
    S.a_ready(cur);
    PG8_STAGE(PG8_SB(0, 0), cB, voffB); PG8_STAGE(PG8_SA(0, 0), cA, voffA); PG8_STAGE(PG8_SB(0, 1), cB + hstep, voffB); PG8_STAGE(PG8_SA(0, 1), cA + hstep, voffA);
    if (wr == 1) PG8_BAR;
    PG8_WAIT_V(4); PG8_BAR;
    PG8_STAGE(PG8_SB(1, 0), cB + kstep, voffB); PG8_STAGE(PG8_SA(1, 0), cA + kstep, voffA); PG8_STAGE(PG8_SB(1, 1), cB + hstep + kstep, voffB);
    PG8_WAIT_V(6); PG8_BAR;
    for (;;) {
        const bool has_next = S.next(ui + 1, nxt);
        const char* nA = has_next ? (const char*)g.A + (size_t)nxt.pm * tstep : cA; const char* nB = has_next ? (const char*)g.Bt + (size_t)nxt.pn * tstep : cB;
        for (int t = 0; t < nt; t += 2) {
            const bool last = (t == nt - 2);
            const char* a1 = cA + (size_t)(t + 1) * kstep;
            const char* a2 = last ? nA : cA + (size_t)(t + 2) * kstep; const char* b2 = last ? nB : cB + (size_t)(t + 2) * kstep;
            const char* a3 = a2 + kstep; const char* b3 = b2 + kstep;
            if (last && has_next) S.a_ready(nxt);
            PG8_LDB(B0, 0, 0); PG8_SCHED; PG8_LDA(At, 0, 0); PG8_STAGE(PG8_SA(1, 1), a1 + hstep, voffA);
            PG8_WAIT_L(8); PG8_BAR; PG8_WAIT_L(0); PG8_MMA(0, 0, At, B0); PG8_BAR; PG8_SCHED;
            PG8_LDB(B1, 0, 1); PG8_STAGE(PG8_SB(0, 0), b2, voffB);
            PG8_BAR; PG8_WAIT_L(0); PG8_MMA(0, 1, At, B1); PG8_BAR;
            PG8_LDA(At, 0, 1); PG8_STAGE(PG8_SA(0, 0), a2, voffA);
            PG8_BAR; PG8_WAIT_L(0); PG8_MMA(1, 0, At, B0); PG8_BAR; PG8_SCHED;
            PG8_STAGE(PG8_SB(0, 1), b2 + hstep, voffB);
            PG8_WAIT_V(6); PG8_BAR; PG8_MMA(1, 1, At, B1); PG8_BAR;
            PG8_LDB(B0, 1, 0); PG8_SCHED; PG8_LDA(At, 1, 0); PG8_STAGE(PG8_SA(0, 1), a2 + hstep, voffA);
            PG8_WAIT_L(8); PG8_BAR; PG8_WAIT_L(0); PG8_MMA(0, 0, At, B0); PG8_BAR; PG8_SCHED;
            PG8_LDB(B1, 1, 1); PG8_STAGE(PG8_SB(1, 0), b3, voffB);
            PG8_BAR; PG8_WAIT_L(0); PG8_MMA(0, 1, At, B1); PG8_BAR;
            PG8_LDA(At, 1, 1); PG8_STAGE(PG8_SA(1, 0), a3, voffA);
            PG8_BAR; PG8_WAIT_L(0); PG8_MMA(1, 0, At, B0); PG8_BAR; PG8_SCHED;
            PG8_STAGE(PG8_SB(1, 1), b3 + hstep, voffB);
            PG8_WAIT_V(6); PG8_BAR; PG8_MMA(1, 1, At, B1); PG8_BAR;
        }
        E(acc, cur, wr, wc, fr, fq); S.done(cur);
        if (!has_next) break;
#pragma unroll
        for (int a = 0; a < 2; ++a)
#pragma unroll
            for (int b = 0; b < 2; ++b)
#pragma unroll
                for (int m = 0; m < 4; ++m)
#pragma unroll
                    for (int n = 0; n < 2; ++n) acc[a][b][m][n] = (f32x4){0.f, 0.f, 0.f, 0.f};
        cur = nxt; cA = nA; cB = nB; ++ui;
    }
    PG8_WAIT_V(0);
    if (wr == 0) PG8_BAR;
    PG8_BAR;
#undef PG8_SA
#undef PG8_SB
#undef PG8_STAGE
#undef PG8_LDA
#undef PG8_LDB
#undef PG8_MMA
#undef PG8_WAIT_V
#undef PG8_WAIT_L
#undef PG8_BAR
#undef PG8_SCHED
}
}

DEVI void transpose_tile(int wave, float* tile, const float* src, int ld_src, int k0, int n0s, int nvalid, bf16_t* dst, int ld_dst, int n0d, int k0d) {
    const int tid = my_tid_w(wave);
#pragma unroll
    for (int i = 0; i < 8; ++i) { const int kk = i * 8 + (tid >> 6), nn = tid & 63; const int col = n0s + nn;
        tile[kk * 65 + nn] = (col < nvalid) ? src[(size_t)(k0 + kk) * ld_src + col] : 0.f; }
    __syncthreads();
#pragma unroll
    for (int i = 0; i < 8; ++i) { const int nn = i * 8 + (tid >> 6), kk = tid & 63; dst[(size_t)(n0d + nn) * ld_dst + k0d + kk] = f2bf(tile[kk * 65 + nn]); }
    __syncthreads();
}

DEVI void mods_item(float* lf, const Params& p, int item) {
    const int tid = my_tid_w(p.wave); const int l = item / 96, cgp = item % 96;
    float* s = lf;
    float* red = lf + 5120;
    for (int i = tid; i < 5120; i += 512) { const int r = i >> 10, k = i & 1023; const float v = (r < 4) ? p.c[r * 1024 + k] : p.c_ctx[k]; s[i] = siluf_(v); }
    __syncthreads();
    const int cc = tid & 63, kg = tid >> 6; const int col = cgp * 64 + cc;
    const float* W = p.w_mod + (size_t)l * 1024 * 6144 + col;
    float a0 = 0.f, a1 = 0.f, a2 = 0.f, a3 = 0.f, a4 = 0.f;
#pragma unroll 8
    for (int k = kg * 128; k < kg * 128 + 128; ++k) { const float w = W[(size_t)k * 6144];
        a0 += s[k] * w; a1 += s[1024 + k] * w; a2 += s[2048 + k] * w; a3 += s[3072 + k] * w; a4 += s[4096 + k] * w; }
    red[(kg * 5 + 0) * 64 + cc] = a0; red[(kg * 5 + 1) * 64 + cc] = a1; red[(kg * 5 + 2) * 64 + cc] = a2; red[(kg * 5 + 3) * 64 + cc] = a3; red[(kg * 5 + 4) * 64 + cc] = a4;
    __syncthreads();
    if (tid < 320) { const int r = tid >> 6, c2 = tid & 63; float sum = p.b_mod[l * 6144 + cgp * 64 + c2];
#pragma unroll
        for (int q = 0; q < 8; ++q) sum += red[(q * 5 + r) * 64 + c2];
        ((float*)(p.ws + OFF_MODS))[(l * 5 + r) * 6144 + cgp * 64 + c2] = sum; }
    __syncthreads();
}

__constant__ int c_cu0[5] = {0, 5, 10, 14, 18};
__constant__ int c_cnu[5] = {5, 5, 4, 4, 4};

DEVI void prep_phase(unsigned char* lds, const Params& p) {
    float* lf = (float*)lds;
    const int T_IN = 16 * 36, T_OUT = 256, T_UP = 16 * 88, T_DN = 44 * 16, T_L = T_IN + T_OUT + T_UP + T_DN;
    const int N_MODS = 192, N_TR = 2 * T_L, N_SGU = 32, N_POOL = 8;
    const int total = N_MODS + N_TR + N_SGU + N_POOL;
    for (int item = blockIdx.x; item < total; item += gridDim.x) {
        if (item < N_MODS) { mods_item(lf, p, item); continue; }
        int it = item - N_MODS;
        if (it < N_TR) {
            const int l = it / T_L; int r = it % T_L;
            if (r < T_IN) { const int kt = r / 36, ntl = r % 36;
                transpose_tile(p.wave, lf, p.w_in + (size_t)l * 1024 * 2080, 2080, kt * 64, ntl * 64, 2080, (bf16_t*)(p.ws + OFF_WIN) + (size_t)l * 2304 * 1024, 1024, ntl * 64, kt * 64); continue; }
            r -= T_IN;
            if (r < T_OUT) { const int kt = r / 16, ntl = r % 16;
                transpose_tile(p.wave, lf, p.w_out + (size_t)l * 1024 * 1024, 1024, kt * 64, ntl * 64, 1024, (bf16_t*)(p.ws + OFF_WOUT) + (size_t)l * 1024 * 1024, 1024, ntl * 64, kt * 64); continue; }
            r -= T_OUT;
            if (r < T_UP) { const int kt = r / 88, ntl = r % 88; const int n0d = ntl * 64; const int unit = n0d >> 8, sgn = (n0d >> 7) & 1, j0 = n0d & 127;
                transpose_tile(p.wave, lf, p.ffn_w_up + (size_t)l * 1024 * 5632, 5632, kt * 64, sgn * FH + unit * 128 + j0, 5632, (bf16_t*)(p.ws + OFF_WUP) + (size_t)l * 5632 * 1024, 1024, n0d, kt * 64); continue; }
            r -= T_UP;
            { const int kt = r / 16, ntl = r % 16;
                transpose_tile(p.wave, lf, p.ffn_w_down + (size_t)l * FH * 1024, 1024, kt * 64, ntl * 64, 1024, (bf16_t*)(p.ws + OFF_WDN) + (size_t)l * 1024 * FH, FH, ntl * 64, kt * 64); continue; }
        }
        it -= N_TR;
        if (it < N_SGU) { bf16_t* d = (bf16_t*)(p.ws + OFF_SGUW); const int base = it * 4096;
#pragma unroll
            for (int i = 0; i < 8; ++i) { const int idx = base + i * 512 + my_tid_w(p.wave); d[idx] = f2bf(p.sgu_w[idx]); }
            continue; }
        it -= N_SGU;
        { transpose_tile(p.wave, lf, p.pool_w + (size_t)it * 4096, 64, 0, 0, 64, (bf16_t*)(p.ws + OFF_POOLW) + (size_t)it * 4096, 64, 0, 0); }
    }
}

DEVI void ln_phase(int wave, const float* srcL, const float* srcC, int nrows, const float* lnw, const float* lnb, float* dstX, float* dstOut, const float* mods, int soff, bf16_t* H) {
    const int lane = my_lane(); int wid = wave; asm volatile("" : "+s"(wid));
    const int rstep = gridDim.x * 8;
    int r = blockIdx.x * 8 + wid;
    f32x4 vn[4];
    if (r < nrows) { const float* src = r < NLAT ? srcL + (size_t)r * DM : srcC + (size_t)(r - NLAT) * DM;
#pragma unroll
        for (int i = 0; i < 4; ++i) vn[i] = *(const f32x4*)(src + i * 256 + lane * 4); }
    for (; r < nrows; r += rstep) {
        f32x4 v[4];
#pragma unroll
        for (int i = 0; i < 4; ++i) v[i] = vn[i];
        { const int rn = r + rstep; if (rn < nrows) { const float* src = rn < NLAT ? srcL + (size_t)rn * DM : srcC + (size_t)(rn - NLAT) * DM;
#pragma unroll
            for (int i = 0; i < 4; ++i) vn[i] = *(const f32x4*)(src + i * 256 + lane * 4); } }
        float s = 0.f;
#pragma unroll
        for (int i = 0; i < 4; ++i) s += v[i][0] + v[i][1] + v[i][2] + v[i][3];
        float mean = wsum(s, lane) * (1.0f / 1024.0f);
        float q = 0.f;
#pragma unroll
        for (int i = 0; i < 4; ++i) { v[i] -= mean; q += v[i][0] * v[i][0] + v[i][1] * v[i][1] + v[i][2] * v[i][2] + v[i][3] * v[i][3]; }
        float rstd = rsqrtf(wsum(q, lane) * (1.0f / 1024.0f) + EPS);
        if (lnw) {
#pragma unroll
            for (int i = 0; i < 4; ++i) { const f32x4 w = *(const f32x4*)(lnw + i * 256 + lane * 4), b = *(const f32x4*)(lnb + i * 256 + lane * 4); v[i] = v[i] * rstd * w + b; }
            if (dstX) {
#pragma unroll
                for (int i = 0; i < 4; ++i) *(f32x4*)(dstX + (size_t)r * DM + i * 256 + lane * 4) = v[i]; }
            if (dstOut && r < NLAT) {
#pragma unroll
                for (int i = 0; i < 4; ++i) *(f32x4*)(dstOut + (size_t)r * DM + i * 256 + lane * 4) = v[i]; }
            if (mods) {
                s = 0.f;
#pragma unroll
                for (int i = 0; i < 4; ++i) s += v[i][0] + v[i][1] + v[i][2] + v[i][3];
                mean = wsum(s, lane) * (1.0f / 1024.0f); q = 0.f;
#pragma unroll
                for (int i = 0; i < 4; ++i) { v[i] -= mean; q += v[i][0] * v[i][0] + v[i][1] * v[i][1] + v[i][2] * v[i][2] + v[i][3] * v[i][3]; }
                rstd = rsqrtf(wsum(q, lane) * (1.0f / 1024.0f) + EPS);
            }
        }
        if (mods) {
            const int b = r < NLAT ? (r >> 13) : 4; const float* mp = mods + b * 6144 + soff;
#pragma unroll
            for (int i = 0; i < 4; ++i) { const f32x4 sh = *(const f32x4*)(mp + i * 256 + lane * 4), sc = *(const f32x4*)(mp + 1024 + i * 256 + lane * 4);
                const f32x4 h = v[i] * rstd * (1.0f + sc) + sh;
                u32x2 w; w.x = cvt_pk_bf16(h[0], h[1]); w.y = cvt_pk_bf16(h[2], h[3]);
                *(u32x2*)(H + (size_t)r * DM + i * 256 + lane * 4) = w; }
        }
    }
}

struct Tile { int row0, T0, L; };
DEVI Tile tile_of(int t, int tl) {
    const int nlat = NLAT / tl; Tile r;
    if (t < nlat) { r.row0 = t * tl; r.T0 = r.row0 & (SEQ - 1); r.L = SEQ; }
    else { const int q = (t - nlat) * tl; r.row0 = NLAT + q; r.T0 = q & (CTXL - 1); r.L = CTXL; }
    return r;
}

DEVI void pool_item(unsigned char* lds, const Params& p, int l, const Tile tl) {
    const int tid = my_tid_w(p.wave), wid = tid >> 6, lane = tid & 63, fr = lane & 15, fq = lane >> 4;
    bf16_t* zs = (bf16_t*)lds;
    bf16_t* ys = (bf16_t*)(lds + 80 * 256 * 2);
    const bf16_t* z = (const bf16_t*)(p.ws + OFF_Z);
    bf16_t* ycat = (bf16_t*)(p.ws + OFF_H);
    for (int i = tid; i < 80 * 32; i += 512) { const int r = i >> 5, c8 = i & 31; const int T = tl.T0 - 8 + r; u32x4 v = (u32x4){0u, 0u, 0u, 0u};
        if (T >= 0 && T < tl.L) v = *(const u32x4*)(z + (size_t)(tl.row0 - 8 + r) * ZP + ZB + c8 * 8);
        *(u32x4*)(zs + r * 256 + c8 * 8) = v; }
    __syncthreads();
    { const int c2 = tid & 127, tq = tid >> 7; const int ch = c2 * 2; const int g = ch >> 6; const int hw = 1 << g;
#pragma unroll 1
        for (int tt = 0; tt < 16; ++tt) { const int t = tq * 16 + tt; const int T = tl.T0 + t; const int lo = max(T - hw, 0), hi = min(T + hw, tl.L);
            float s0 = 0.f, s1 = 0.f;
            for (int q = lo; q < hi; ++q) { const unsigned v = *(const unsigned*)(zs + (q - tl.T0 + 8) * 256 + ch); s0 += bflo(v); s1 += bfhi(v); }
            const float inv = 1.0f / (float)(hi - lo); const unsigned xv = *(const unsigned*)(zs + (t + 8) * 256 + ch);
            *(unsigned*)(ys + t * 264 + ch) = cvt_pk_bf16(s0 * inv - bflo(xv), s1 * inv - bfhi(xv)); } }
    __syncthreads();
    { const int g = wid >> 1; const bf16_t* Wt = (const bf16_t*)(p.ws + OFF_POOLW) + (size_t)(l * 4 + g) * 4096;
#pragma unroll
        for (int mi = 0; mi < 2; ++mi) { const int mt = (wid & 1) * 2 + mi; const int t = mt * 16 + fr;
            const bf16x8 a0 = *(const bf16x8*)(ys + t * 264 + g * 64 + fq * 8), a1 = *(const bf16x8*)(ys + t * 264 + g * 64 + 32 + fq * 8);
#pragma unroll
            for (int nt = 0; nt < 4; ++nt) { const bf16x8 b0 = *(const bf16x8*)(Wt + (nt * 16 + fr) * 64 + fq * 8), b1 = *(const bf16x8*)(Wt + (nt * 16 + fr) * 64 + 32 + fq * 8);
                f32x4 acc = (f32x4){0.f, 0.f, 0.f, 0.f}; acc = MFMA16(b0, a0, acc); acc = MFMA16(b1, a1, acc);
                const int col = g * 64 + nt * 16 + 4 * fq; const f32x4 sc = *(const f32x4*)(p.pool_scale + l * 256 + col); acc *= sc;
                u32x2 w; w.x = cvt_pk_bf16(acc[0], acc[1]); w.y = cvt_pk_bf16(acc[2], acc[3]);
                *(u32x2*)(ycat + (size_t)(tl.row0 + t) * DM + 256 + col) = w; } } }
    __syncthreads();
}

DEVI void sgu_item(unsigned char* lds, const Params& p, int l, const Tile tl) {
    const int tid = my_tid_w(p.wave), wid = tid >> 6, lane = tid & 63, fr = lane & 15, fq = lane >> 4;
    bf16_t* vT = (bf16_t*)lds;
    const bf16_t* z = (const bf16_t*)(p.ws + OFF_Z);
    bf16_t* ycat = (bf16_t*)(p.ws + OFF_H);
    { const f32x4 lw = *(const f32x4*)(p.sgu_ln_w + l * 256 + lane * 4), lb = *(const f32x4*)(p.sgu_ln_b + l * 256 + lane * 4);
#pragma unroll 4
        for (int i = 0; i < 16; ++i) { const int s = wid * 16 + i; const u32x2 raw = *(const u32x2*)(z + (size_t)(tl.row0 + s) * ZP + ZCV + lane * 4);
            f32x4 v; v[0] = geluf_(bflo(raw.x)); v[1] = geluf_(bfhi(raw.x)); v[2] = geluf_(bflo(raw.y)); v[3] = geluf_(bfhi(raw.y));
            const float mean = wsum(v[0] + v[1] + v[2] + v[3], lane) * (1.0f / 256.0f); v -= mean;
            const float rstd = rsqrtf(wsum(v[0] * v[0] + v[1] * v[1] + v[2] * v[2] + v[3] * v[3], lane) * (1.0f / 256.0f) + EPS);
            v = v * rstd * lw + lb;
#pragma unroll
            for (int j = 0; j < 4; ++j) vT[(lane * 4 + j) * 136 + s] = f2bf(v[j]); } }
    __syncthreads();
    { const int h = wid >> 1; const bf16_t* W = (const bf16_t*)(p.ws + OFF_SGUW) + (size_t)(l * 4 + h) * 16384;
#pragma unroll 1
        for (int mi = 0; mi < 4; ++mi) { const int mt = (wid & 1) * 4 + mi; const int t = mt * 16 + fr;
            bf16x8 a[4];
#pragma unroll
            for (int ks = 0; ks < 4; ++ks) a[ks] = *(const bf16x8*)(W + t * 128 + ks * 32 + fq * 8);
            const float bias = p.sgu_b[(l * 4 + h) * 128 + t];
#pragma unroll
            for (int nt = 0; nt < 4; ++nt) { f32x4 acc = (f32x4){0.f, 0.f, 0.f, 0.f};
#pragma unroll
                for (int ks = 0; ks < 4; ++ks) { const bf16x8 b = *(const bf16x8*)(vT + (h * 64 + nt * 16 + fr) * 136 + ks * 32 + fq * 8); acc = MFMA16(b, a[ks], acc); }
                const int col = h * 64 + nt * 16 + 4 * fq; const u32x2 raw = *(const u32x2*)(z + (size_t)(tl.row0 + t) * ZP + ZCU + col);
                const float o0 = geluf_(bflo(raw.x)) * (acc[0] + bias), o1 = geluf_(bfhi(raw.x)) * (acc[1] + bias), o2 = geluf_(bflo(raw.y)) * (acc[2] + bias), o3 = geluf_(bfhi(raw.y)) * (acc[3] + bias);
                u32x2 w; w.x = cvt_pk_bf16(o0, o1); w.y = cvt_pk_bf16(o2, o3);
                *(u32x2*)(ycat + (size_t)(tl.row0 + t) * DM + 512 + col) = w; } } }
    __syncthreads();
}

DEVI void cm_item(unsigned char* lds, const Params& p, int l, const Tile tl) {
    const int tid = my_tid_w(p.wave), wid = tid >> 6, lane = tid & 63;
    float* yg = (float*)lds;
    const bf16_t* z = (const bf16_t*)(p.ws + OFF_Z);
    bf16_t* ycat = (bf16_t*)(p.ws + OFF_H);
#pragma unroll 4
    for (int i = tid; i < 94 * 64; i += 512) { const int r = i >> 6, c4 = (i & 63) * 4; const int T = tl.T0 - 15 + r; f32x4 o = (f32x4){0.f, 0.f, 0.f, 0.f};
        if (T >= 0 && T < tl.L) { const bf16_t* zp = z + (size_t)(tl.row0 - 15 + r) * ZP; const u32x2 a = *(const u32x2*)(zp + ZDA + c4), g = *(const u32x2*)(zp + ZDG + c4);
            o[0] = bflo(a.x) * sigmoidf_(bflo(g.x)); o[1] = bfhi(a.x) * sigmoidf_(bfhi(g.x)); o[2] = bflo(a.y) * sigmoidf_(bflo(g.y)); o[3] = bfhi(a.y) * sigmoidf_(bfhi(g.y)); }
        *(f32x4*)(yg + r * 256 + c4) = o; }
    __syncthreads();
    const int c = tid & 255, th = tid >> 8;
    float* yo = (float*)(lds + 94 * 256 * 4);
    { float w[31];
#pragma unroll
        for (int j = 0; j < 31; ++j) w[j] = p.cm_conv_w[(l * 31 + j) * 256 + c];
        const float cb = p.cm_conv_b[l * 256 + c];
#pragma unroll 1
        for (int bt = 0; bt < 8; ++bt) { float in[34];
#pragma unroll
            for (int i = 0; i < 34; ++i) in[i] = yg[(th * 32 + bt * 4 + i) * 256 + c];
            float s0 = cb, s1 = cb, s2 = cb, s3 = cb;
#pragma unroll
            for (int j = 0; j < 31; ++j) { s0 += in[j] * w[j]; s1 += in[j + 1] * w[j]; s2 += in[j + 2] * w[j]; s3 += in[j + 3] * w[j]; }
            float* op = yo + (th * 32 + bt * 4) * 256 + c; op[0] = s0; op[256] = s1; op[512] = s2; op[768] = s3; } }
    __syncthreads();
    { const f32x4 lw = *(const f32x4*)(p.cm_ln_w + l * 256 + lane * 4), lb = *(const f32x4*)(p.cm_ln_b + l * 256 + lane * 4);
#pragma unroll 2
        for (int i = 0; i < 8; ++i) { const int t = wid * 8 + i; f32x4 v = *(const f32x4*)(yo + t * 256 + lane * 4);
            const float mean = wsum(v[0] + v[1] + v[2] + v[3], lane) * (1.0f / 256.0f); v -= mean;
            const float rstd = rsqrtf(wsum(v[0] * v[0] + v[1] * v[1] + v[2] * v[2] + v[3] * v[3], lane) * (1.0f / 256.0f) + EPS);
            v = v * rstd * lw + lb;
            u32x2 w; w.x = cvt_pk_bf16(siluf_(v[0]), siluf_(v[1])); w.y = cvt_pk_bf16(siluf_(v[2]), siluf_(v[3]));
            *(u32x2*)(ycat + (size_t)(tl.row0 + t) * DM + 768 + lane * 4) = w; } }
    __syncthreads();
}

constexpr int GL_G = 0, GL_WG = 32768, GL_BG = 40960, GL_LOW = 41472, GL_VT = 49664, GL_QIN = 86528, GL_KIN = 103936, GL_STT = 121344, GL_KD = 86528;

DEVI void gla_load_common(int wave, unsigned char* lds, const bf16_t* z, const Tile tl) {
    const int tid = my_tid_w(wave);
    float* low = (float*)(lds + GL_LOW); bf16_t* vT = (bf16_t*)(lds + GL_VT);
    if (tid < 256) { const int t = tid >> 2, part = tid & 3; const u32x4 v = *(const u32x4*)(z + (size_t)(tl.row0 + t) * ZP + ZLF + part * 8);
        float* d = low + t * 32 + part * 8; d[0] = bflo(v.x); d[1] = bfhi(v.x); d[2] = bflo(v.y); d[3] = bfhi(v.y); d[4] = bflo(v.z); d[5] = bfhi(v.z); d[6] = bflo(v.w); d[7] = bfhi(v.w); }
#pragma unroll 1
    for (int i = tid; i < 64 * 32; i += 512) { const int t = i >> 5, c8 = (i & 31) * 8; const u32x4 v = *(const u32x4*)(z + (size_t)(tl.row0 + t) * ZP + ZV + c8);
        vT[(c8 + 0) * 72 + t] = (bf16_t)(v.x & 0xffffu); vT[(c8 + 1) * 72 + t] = (bf16_t)(v.x >> 16); vT[(c8 + 2) * 72 + t] = (bf16_t)(v.y & 0xffffu); vT[(c8 + 3) * 72 + t] = (bf16_t)(v.y >> 16);
        vT[(c8 + 4) * 72 + t] = (bf16_t)(v.z & 0xffffu); vT[(c8 + 5) * 72 + t] = (bf16_t)(v.z >> 16); vT[(c8 + 6) * 72 + t] = (bf16_t)(v.w & 0xffffu); vT[(c8 + 7) * 72 + t] = (bf16_t)(v.w >> 16); }
}
DEVI void gla_gates(unsigned char* lds, const Params& p, int l, int dir) {
    const int tid = my_tid_w(p.wave);
    float* G = (float*)(lds + GL_G); float* WG = (float*)(lds + GL_WG); float* BG = (float*)(lds + GL_BG); const float* low = (const float*)(lds + GL_LOW);
    *(f32x4*)(WG + tid * 4) = *(const f32x4*)(p.gla_w_gate + (size_t)(l * 2 + dir) * 2048 + tid * 4);
    if (tid < 128) BG[tid] = p.gla_b_gate[(l * 2 + dir) * 128 + tid];
    __syncthreads();
    { const int t = tid >> 3, cgp = tid & 7; float lv[16];
#pragma unroll
        for (int r = 0; r < 16; ++r) lv[r] = low[t * 32 + dir * 16 + r];
#pragma unroll
        for (int j = 0; j < 16; ++j) { const int col = cgp * 16 + j; float a = BG[col];
#pragma unroll
            for (int r = 0; r < 16; ++r) a += lv[r] * WG[r * 128 + col];
            G[t * 128 + col] = fmaxf(logsigf_(a) * (1.0f / 16.0f), -1.0f); } }
    __syncthreads();
    {
        const int col = tid & 127, seg = tid >> 7; float loc[16]; float run = 0.f;
#pragma unroll
        for (int i = 0; i < 16; ++i) { const int t = dir ? (seg * 16 + 15 - i) : (seg * 16 + i); run += G[t * 128 + col]; loc[i] = run; }
        WG[seg * 128 + col] = run;
        __syncthreads();
        float off = 0.f;
#pragma unroll
        for (int sg = 0; sg < 4; ++sg) { const float v = WG[sg * 128 + col]; off += (dir ? (sg > seg) : (sg < seg)) ? v : 0.f; }
#pragma unroll
        for (int i = 0; i < 16; ++i) { const int t = dir ? (seg * 16 + 15 - i) : (seg * 16 + i); G[t * 128 + col] = loc[i] + off; }
    }
    __syncthreads();
}

DEVI void gla_sum_item(unsigned char* lds, const Params& p, int l, const Tile tl) {
    const int tid = my_tid_w(p.wave), wid = tid >> 6, lane = tid & 63, fr = lane & 15, fq = lane >> 4;
    const bf16_t* z = (const bf16_t*)(p.ws + OFF_Z);
    float* ST = (float*)(p.ws + OFF_ST); float* DEC = (float*)(p.ws + OFF_DEC);
    const float* G = (const float*)(lds + GL_G); bf16_t* KD = (bf16_t*)(lds + GL_KD); const bf16_t* vT = (const bf16_t*)(lds + GL_VT);
    const int cid = tl.row0 >> 6;
    gla_load_common(p.wave, lds, z, tl);
    for (int dir = 0; dir < 2; ++dir) {
        gla_gates(lds, p, l, dir);
        { const int col = tid & 127, tq = tid >> 7; const float cl = G[(dir ? 0 : 63) * 128 + col];
            bf16_t kr[16];
#pragma unroll
            for (int tt = 0; tt < 16; ++tt) kr[tt] = z[(size_t)(tl.row0 + tq * 16 + tt) * ZP + ZK + col];
#pragma unroll
            for (int tt = 0; tt < 16; ++tt) { const int t = tq * 16 + tt; KD[col * 72 + t] = f2bf(bf2f(kr[tt]) * __expf(cl - G[t * 128 + col])); }
            if (tid < 128) DEC[((size_t)(cid * 4 + (col >> 5)) * 2 + dir) * 32 + (col & 31)] = __expf(cl); }
        __syncthreads();
        { const int h = wid >> 1, mt = wid & 1;
            const bf16x8 a0 = *(const bf16x8*)(KD + (h * 32 + mt * 16 + fr) * 72 + fq * 8), a1 = *(const bf16x8*)(KD + (h * 32 + mt * 16 + fr) * 72 + 32 + fq * 8);
#pragma unroll
            for (int nt = 0; nt < 4; ++nt) { const bf16x8 b0 = *(const bf16x8*)(vT + (h * 64 + nt * 16 + fr) * 72 + fq * 8), b1 = *(const bf16x8*)(vT + (h * 64 + nt * 16 + fr) * 72 + 32 + fq * 8);
                f32x4 acc = (f32x4){0.f, 0.f, 0.f, 0.f}; acc = MFMA16(b0, a0, acc); acc = MFMA16(b1, a1, acc);
                *(f32x4*)(ST + ((size_t)(cid * 4 + h) * 2 + dir) * 2048 + (mt * 16 + fr) * 64 + nt * 16 + 4 * fq) = acc; } }
        __syncthreads();
    }
}

DEVI void gla_scan_phase(const Params& p) {
    float* ST = (float*)(p.ws + OFF_ST); const float* DEC = (const float*)(p.ws + OFF_DEC);
    for (int gt = blockIdx.x * 512 + my_tid_w(p.wave); gt < 65536; gt += gridDim.x * 512) {
        const int chain = gt >> 11, e = gt & 2047; const int dir = chain & 1, h = (chain >> 1) & 3, b = chain >> 3; const int d = e >> 6;
        float S = 0.f;
        for (int s0 = 0; s0 < 132; s0 += 12) {
            float kv[12], dc[12];
#pragma unroll
            for (int j = 0; j < 12; ++j) { const int s = s0 + j; const int cid = (s < 4) ? (512 + b * 4 + (dir ? 3 - s : s)) : (b * 128 + (dir ? 131 - s : s - 4));
                const size_t slot = (size_t)(cid * 4 + h) * 2 + dir; kv[j] = ST[slot * 2048 + e]; dc[j] = DEC[slot * 32 + d]; }
#pragma unroll
            for (int j = 0; j < 12; ++j) { const int s = s0 + j; const int cid = (s < 4) ? (512 + b * 4 + (dir ? 3 - s : s)) : (b * 128 + (dir ? 131 - s : s - 4));
                const size_t slot = (size_t)(cid * 4 + h) * 2 + dir; ST[slot * 2048 + e] = S; S = dc[j] * S + kv[j]; }
        }
    }
}

DEVI void gla_out_item(unsigned char* lds, const Params& p, int l, const Tile tl) {
    const int tid = my_tid_w(p.wave), wid = tid >> 6, lane = tid & 63, fr = lane & 15, fq = lane >> 4;
    const bf16_t* z = (const bf16_t*)(p.ws + OFF_Z);
    bf16_t* ycat = (bf16_t*)(p.ws + OFF_H);
    const float* ST = (const float*)(p.ws + OFF_ST);
    const float* G = (const float*)(lds + GL_G); bf16_t* QIN = (bf16_t*)(lds + GL_QIN); bf16_t* KIN = (bf16_t*)(lds + GL_KIN); bf16_t* STT = (bf16_t*)(lds + GL_STT);
    const bf16_t* vT = (const bf16_t*)(lds + GL_VT); bf16_t* AB = (bf16_t*)(lds + GL_G) + wid * 2304;
    const int cid = tl.row0 >> 6; const int h = wid >> 1, half = wid & 1;
    gla_load_common(p.wave, lds, z, tl);
    f32x4 o[2][4];
#pragma unroll
    for (int mi = 0; mi < 2; ++mi)
#pragma unroll
        for (int nt = 0; nt < 4; ++nt) o[mi][nt] = (f32x4){0.f, 0.f, 0.f, 0.f};
    for (int dir = 0; dir < 2; ++dir) {
        gla_gates(lds, p, l, dir);
        { const int col = tid & 127, tq = tid >> 7;
#pragma unroll 1
            for (int hb = 0; hb < 2; ++hb) {
                bf16_t qr[8], kr[8]; const bf16_t* zp = z + (size_t)(tl.row0 + tq * 16 + hb * 8) * ZP + col;
#pragma unroll
                for (int tt = 0; tt < 8; ++tt) { qr[tt] = zp[(size_t)tt * ZP + ZQ]; kr[tt] = zp[(size_t)tt * ZP + ZK]; }
#pragma unroll
                for (int tt = 0; tt < 8; ++tt) { const int t = tq * 16 + hb * 8 + tt; const float cum = G[t * 128 + col];
                    const float q = bf2f(qr[tt]) * 0.17677669529663687f * __expf(cum);
                    const float k = bf2f(kr[tt]) * __expf(-cum);
                    QIN[t * 136 + col] = f2bf(q); KIN[t * 136 + col] = f2bf(k); } }
#pragma unroll 1
            for (int i = tid; i < 2048; i += 512) { const int hh = i >> 9, rem = i & 511; const int dd = rem >> 4, e4 = (rem & 15) * 4;
                const f32x4 v = *(const f32x4*)(ST + ((size_t)(cid * 4 + hh) * 2 + dir) * 2048 + dd * 64 + e4);
#pragma unroll
                for (int j = 0; j < 4; ++j) STT[(hh * 64 + e4 + j) * 40 + dd] = f2bf(v[j]); } }
        __syncthreads();
#pragma unroll
        for (int mi = 0; mi < 2; ++mi) { const int t = (half * 2 + mi) * 16 + fr; const bf16x8 qa = *(const bf16x8*)(QIN + t * 136 + h * 32 + fq * 8);
#pragma unroll
            for (int st = 0; st < 4; ++st) { const bf16x8 kb = *(const bf16x8*)(KIN + (st * 16 + fr) * 136 + h * 32 + fq * 8);
                f32x4 acc = (f32x4){0.f, 0.f, 0.f, 0.f}; acc = MFMA16(kb, qa, acc);
                const int s0 = st * 16 + 4 * fq;
#pragma unroll
                for (int j = 0; j < 4; ++j) { const int s = s0 + j; const bool keep = dir ? (s >= t) : (s <= t); acc[j] = keep ? acc[j] : 0.f; }
                u32x2 w; w.x = cvt_pk_bf16(acc[0], acc[1]); w.y = cvt_pk_bf16(acc[2], acc[3]);
                *(u32x2*)(AB + (mi * 16 + fr) * 72 + s0) = w; } }
        __syncthreads();
#pragma unroll
        for (int mi = 0; mi < 2; ++mi) { const int t = (half * 2 + mi) * 16 + fr;
            const bf16x8 aa0 = *(const bf16x8*)(AB + (mi * 16 + fr) * 72 + fq * 8), aa1 = *(const bf16x8*)(AB + (mi * 16 + fr) * 72 + 32 + fq * 8);
            const bf16x8 qa = *(const bf16x8*)(QIN + t * 136 + h * 32 + fq * 8);
#pragma unroll
            for (int nt = 0; nt < 4; ++nt) { const int er = h * 64 + nt * 16 + fr;
                const bf16x8 vb0 = *(const bf16x8*)(vT + er * 72 + fq * 8), vb1 = *(const bf16x8*)(vT + er * 72 + 32 + fq * 8), sb = *(const bf16x8*)(STT + er * 40 + fq * 8);
                o[mi][nt] = MFMA16(vb0, aa0, o[mi][nt]); o[mi][nt] = MFMA16(vb1, aa1, o[mi][nt]); o[mi][nt] = MFMA16(sb, qa, o[mi][nt]); } }
        __syncthreads();
    }
#pragma unroll
    for (int mi = 0; mi < 2; ++mi) { const int t = (half * 2 + mi) * 16 + fr; float ss = 0.f;
#pragma unroll
        for (int nt = 0; nt < 4; ++nt) ss += o[mi][nt][0] * o[mi][nt][0] + o[mi][nt][1] * o[mi][nt][1] + o[mi][nt][2] * o[mi][nt][2] + o[mi][nt][3] * o[mi][nt][3];
        ss += shx(ss, 16, lane); ss += shx(ss, 32, lane);
        const float rs = rsqrtf(ss * (1.0f / 64.0f) + EPS);
#pragma unroll
        for (int nt = 0; nt < 4; ++nt) { const int col = h * 64 + nt * 16 + 4 * fq; const f32x4 nw = *(const f32x4*)(p.gla_norm_w + l * 256 + col);
            const u32x2 raw = *(const u32x2*)(z + (size_t)(tl.row0 + t) * ZP + ZR + col);
            const float v0 = o[mi][nt][0] * rs * nw[0] * siluf_(bflo(raw.x)), v1 = o[mi][nt][1] * rs * nw[1] * siluf_(bfhi(raw.x)), v2 = o[mi][nt][2] * rs * nw[2] * siluf_(bflo(raw.y)), v3 = o[mi][nt][3] * rs * nw[3] * siluf_(bfhi(raw.y));
            u32x2 w; w.x = cvt_pk_bf16(v0, v1); w.y = cvt_pk_bf16(v2, v3);
            *(u32x2*)(ycat + (size_t)(tl.row0 + t) * DM + col) = w; } }
    __syncthreads();
}

DEVI void mix_phase(unsigned char* lds, const Params& p, int l) {
    const int n64 = (l == 0) ? 528 : 512, n128 = (l == 0) ? 264 : 256;
    const int nD = n64, nS = 528, nB = n64, nC = n128;
    const int total = nD + nS + nB + nC;
    for (int item = blockIdx.x; item < total; item += gridDim.x) {
        int it = item;
        if (it < nD) { cm_item(lds, p, l, tile_of(it, 64)); continue; }
        it -= nD;
        if (it < nS) { gla_sum_item(lds, p, l, tile_of(it, 64)); continue; }
        it -= nS;
        if (it < nB) { pool_item(lds, p, l, tile_of(it, 64)); continue; }
        it -= nB;
        sgu_item(lds, p, l, tile_of(it, 128));
    }
}
DEVI void gla_out_phase(unsigned char* lds, const Params& p, int l) {
    const int n64 = (l == 0) ? 528 : 512;
    for (int item = blockIdx.x; item < n64; item += gridDim.x) gla_out_item(lds, p, l, tile_of(item, 64));
}

DEVI void ffnconv_phase(unsigned char* lds, const Params& p, int l, int chunk) {
    const int lane = my_lane(); const int tg = p.wave;
    const int nu = c_cnu[chunk], u0 = c_cu0[chunk]; const int kc = FH;
    const int ntile = (l == 0) ? 528 : 512, npx = ntile >> 3;
    const bf16_t* U = (const bf16_t*)(p.ws + OFF_U); bf16_t* ACT = (bf16_t*)(p.ws + OFF_ACT);
    const int xg = blockIdx.x & 7, slot = blockIdx.x >> 3, nslot = gridDim.x >> 3;
    float wA[9][2], wG[9][2];
#pragma unroll
    for (int t = 0; t < 9; ++t) { wA[t][0] = 0.f; wA[t][1] = 0.f; wG[t][0] = 0.f; wG[t][1] = 0.f; }
    int cur_uu = -1;
    for (int j = slot; j < nu * npx; j += nslot) {
        const int uu = j / npx, rt = xg * npx + (j % npx); const Tile tl = tile_of(rt, 64);
        if (uu != cur_uu) {
#pragma unroll
            for (int t = 0; t < 9; ++t) { const float* wp = p.ffn_conv_w + ((size_t)l * 9 + t) * 5632 + (u0 + uu) * 128 + lane * 2;
                const f32x2 a = *(const f32x2*)wp, g = *(const f32x2*)(wp + FH); wA[t][0] = a[0]; wA[t][1] = a[1]; wG[t][0] = g[0]; wG[t][1] = g[1]; }
            cur_uu = uu;
        }
        const bool lat = tl.L == SEQ; const int gr = tl.T0 >> 6;
        const int c0 = tg * 8; const int seqc0 = (lat ? 0 : tl.T0) + c0, width = lat ? 64 : CTXL;
        float aA[8][2], aG[8][2];
#pragma unroll
        for (int t = 0; t < 8; ++t) { aA[t][0] = 0.f; aA[t][1] = 0.f; aG[t][0] = 0.f; aG[t][1] = 0.f; }
#pragma unroll
        for (int dr = 0; dr < 3; ++dr) {
            const bool rvalid = lat ? (gr + dr - 1 >= 0 && gr + dr - 1 < 128) : (dr == 1);
            if (rvalid) {
                const bf16_t* pb = U + ((size_t)(tl.row0 + (lat ? (dr - 1) * 64 : 0) + c0 - 1) * UPITCH + uu * 256 + lane * 2);
                unsigned va[10], vg[10];
#pragma unroll
                for (int q = 0; q < 10; ++q) { const int col = seqc0 + q - 1; va[q] = 0u; vg[q] = 0u;
                    if (col >= 0 && col < width) { va[q] = *(const unsigned*)(pb + (size_t)q * UPITCH); vg[q] = *(const unsigned*)(pb + (size_t)q * UPITCH + 128); } }
#pragma unroll
                for (int t = 0; t < 8; ++t)
#pragma unroll
                    for (int dc = 0; dc < 3; ++dc) { const int tap = dr * 3 + dc; const unsigned a = va[t + dc], g = vg[t + dc];
                        aA[t][0] += bflo(a) * wA[tap][0]; aA[t][1] += bfhi(a) * wA[tap][1]; aG[t][0] += bflo(g) * wG[tap][0]; aG[t][1] += bfhi(g) * wG[tap][1]; }
            }
        }
        bf16_t* ap = ACT + (size_t)(tl.row0 + c0) * kc + (u0 + uu) * 128 + lane * 2;
#pragma unroll
        for (int t = 0; t < 8; ++t) *(unsigned*)(ap + (size_t)t * kc) = cvt_pk_bf16(siluf_(aG[t][0]) * aA[t][0], siluf_(aG[t][1]) * aA[t][1]);
    }
}

DEVI void grid_barrier(unsigned* ctr, unsigned target) {
    asm volatile("s_waitcnt vmcnt(0)" ::: "memory");
    __syncthreads();
    if (threadIdx.x == 0) {
        __builtin_amdgcn_fence(__ATOMIC_RELEASE, "agent");
        asm volatile("s_waitcnt vmcnt(0)" ::: "memory");
        __hip_atomic_fetch_add(ctr, 1u, __ATOMIC_RELAXED, __HIP_MEMORY_SCOPE_AGENT);
        unsigned spins = 0;
        while (__hip_atomic_load(ctr, __ATOMIC_RELAXED, __HIP_MEMORY_SCOPE_AGENT) < target) { __builtin_amdgcn_s_sleep(1); if (++spins > (1u << 24)) break; }
        __builtin_amdgcn_fence(__ATOMIC_ACQUIRE, "agent");
        asm volatile("s_waitcnt vmcnt(0)" ::: "memory");
    }
    __syncthreads();
}

constexpr int PH_PER_LAYER = 19, N_PHASES = 1 + 2 * PH_PER_LAYER;

DEVI void run_phase(unsigned char* shm, const Params& p, int ph) {
    LAS unsigned char* lds3 = (LAS unsigned char*)shm;
    unsigned char* ws = p.ws;
    const float* mods = (const float*)(ws + OFF_MODS);
    float* X = (float*)(ws + OFF_X); bf16_t* H = (bf16_t*)(ws + OFF_H); bf16_t* Z = (bf16_t*)(ws + OFF_Z); bf16_t* U = (bf16_t*)(ws + OFF_U); bf16_t* ACT = (bf16_t*)(ws + OFF_ACT);
    if (ph == 0) { prep_phase(shm, p); return; }
    const int l = (ph - 1) / PH_PER_LAYER, k = (ph - 1) % PH_PER_LAYER;
    const float* ml = mods + l * 5 * 6144;
    const int Mrows = (l == 0) ? ROWS : NLAT;
    pg8::StaticOrder S;
    switch (k) {
    case 0: if (l == 0) ln_phase(p.wave, p.x, p.ctx, ROWS, nullptr, nullptr, nullptr, nullptr, ml, 0, H); break;
    case 1: { pg8::Gemm g{H, (const bf16_t*)(ws + OFF_WIN) + (size_t)l * 2304 * 1024, ROWS, ZP, 1024}; S.init(g.M, g.N, gridDim.x, blockIdx.x);
        pg8::EpiBf16 E{Z, ZP}; pg8::gemm_phase(lds3, g, S, E, p.wave); } break;
    case 2: mix_phase(shm, p, l); break;
    case 3: gla_scan_phase(p); break;
    case 4: gla_out_phase(shm, p, l); break;
    case 5: { pg8::Gemm g{H, (const bf16_t*)(ws + OFF_WOUT) + (size_t)l * 1024 * 1024, Mrows, 1024, 1024}; S.init(g.M, g.N, gridDim.x, blockIdx.x);
        pg8::EpiRes E{X, l == 0 ? p.x : X, l == 0 ? p.ctx : X + (size_t)NLAT * DM, ml, 2 * 1024, 0}; pg8::gemm_phase(lds3, g, S, E, p.wave); } break;
    case 6: ln_phase(p.wave, X, X + (size_t)NLAT * DM, Mrows, p.post_ln_w + (l * 2 + 0) * 1024, p.post_ln_b + (l * 2 + 0) * 1024, X, nullptr, ml, 3 * 1024, H); break;
    case 7: case 9: case 11: case 13: case 15: { const int ch = (k - 7) >> 1; const int u0 = c_cu0[ch], nu = c_cnu[ch];
        pg8::Gemm g{H, (const bf16_t*)(ws + OFF_WUP) + (size_t)l * 5632 * 1024 + (size_t)u0 * 256 * 1024, Mrows, nu * 256, 1024}; S.init(g.M, g.N, gridDim.x, blockIdx.x);
        pg8::EpiBf16 E{U, UPITCH}; pg8::gemm_phase(lds3, g, S, E, p.wave); } break;
    case 8: case 10: case 12: case 14: case 16: ffnconv_phase(shm, p, l, (k - 8) >> 1); break;
    case 17: { pg8::Gemm g{ACT, (const bf16_t*)(ws + OFF_WDN) + (size_t)l * 1024 * FH, Mrows, 1024, FH}; S.init(g.M, g.N, gridDim.x, blockIdx.x);
        pg8::EpiRes E{X, X, X + (size_t)NLAT * DM, ml, 5 * 1024, 0}; pg8::gemm_phase(lds3, g, S, E, p.wave); } break;
    case 18:
        if (l == 0) ln_phase(p.wave, X, X + (size_t)NLAT * DM, ROWS, p.post_ln_w + (l * 2 + 1) * 1024, p.post_ln_b + (l * 2 + 1) * 1024, X, nullptr, mods + 5 * 6144, 0, H);
        else ln_phase(p.wave, X, X + (size_t)NLAT * DM, NLAT, p.post_ln_w + (l * 2 + 1) * 1024, p.post_ln_b + (l * 2 + 1) * 1024, nullptr, p.out, nullptr, 0, nullptr);
        break;
    }
}

__global__ void __launch_bounds__(512, 2) mega(Params p, int ph_lo, int ph_hi, int coop) {
    extern __shared__ __attribute__((aligned(16))) unsigned char shm[];
    unsigned* ctr = (unsigned*)(p.ws + OFF_CTL);
    unsigned epoch = 0;
    Params q = p; q.wave = __builtin_amdgcn_readfirstlane((int)(threadIdx.x >> 6));
    for (int ph = ph_lo; ph < ph_hi; ++ph) {
        if (ph == 1 + PH_PER_LAYER) continue;
        run_phase(shm, q, ph);
#if PROBE_REP > 0
        if (ph == PROBE_PH || ph == PROBE_PH2) for (int rep = 0; rep < PROBE_REP; ++rep) { ++epoch; grid_barrier(ctr, epoch * gridDim.x); run_phase(shm, q, ph); }
#endif
        if (coop && ph + 1 < ph_hi) {
            if (ph == 0) cg::this_grid().sync();
            else { ++epoch; grid_barrier(ctr, epoch * gridDim.x); }
        }
    }
}

extern "C" void kernel_launch(void* const* d_in, const int* in_sizes, int n_in, void* d_out, int out_size, void* d_ws, size_t ws_size, hipStream_t stream) {
    static int grid = 0;
    if (grid == 0) {
        if (n_in != 26 || ws_size < WS_END) { fprintf(stderr, "kernel_launch: unexpected n_in %d / ws_size %zu (need %zu)\n", n_in, ws_size, (size_t)WS_END); grid = -1; return; }
        int dev = 0, cus = 0, per_cu = 0;
        hipGetDevice(&dev); hipDeviceGetAttribute(&cus, hipDeviceAttributeMultiprocessorCount, dev);
        if (hipFuncSetAttribute((const void*)mega, hipFuncAttributeMaxDynamicSharedMemorySize, LDS_BYTES) != hipSuccess) { fprintf(stderr, "kernel_launch: hipFuncSetAttribute failed\n"); grid = -1; return; }
        if (hipOccupancyMaxActiveBlocksPerMultiprocessor(&per_cu, (const void*)mega, 512, LDS_BYTES) != hipSuccess || per_cu < 1) { fprintf(stderr, "kernel_launch: occupancy query says %d\n", per_cu); per_cu = 1; }
        (void)hipGetLastError();
        grid = cus * 1;
    }
    if (grid < 0) return;
    Params p{};
    const float** pp = (const float**)&p;
    for (int i = 0; i < 26; ++i) pp[i] = (const float*)d_in[i];
    p.wave = 0; p.pad_ = 0;
    p.out = (float*)d_out; p.ws = (unsigned char*)d_ws;
#if MK_COOP
    hipMemsetAsync((char*)d_ws + OFF_CTL, 0, 4096, stream);
    int lo = 0, hi = N_PHASES, coop = 1;
    void* args[] = {&p, &lo, &hi, &coop};
    hipError_t e = hipLaunchCooperativeKernel((const void*)mega, dim3(grid), dim3(512), args, LDS_BYTES, stream);
    if (e != hipSuccess) fprintf(stderr, "cooperative launch failed: %s (grid %d)\n", hipGetErrorString(e), grid);
#else
    for (int ph = 0; ph < N_PHASES; ++ph) {
        if (ph == 1 + PH_PER_LAYER) continue;
        hipLaunchKernelGGL(mega, dim3(grid), dim3(512), LDS_BYTES, stream, p, ph, ph + 1, 0);
    }
#endif
}
```

```cpp
#include <hip/hip_runtime.h>
#include <hip/hip_cooperative_groups.h>
#include <cstdio>
#include <cstdint>
namespace cg = cooperative_groups;

#ifndef PROBE_REP
#define PROBE_REP 0
#define PROBE_PH -1
#define PROBE_PH2 -1
#endif
#ifndef MK_COOP
#define MK_COOP 1
#endif

#define DEVI __device__ __forceinline__
#define LAS __attribute__((address_space(3)))
typedef unsigned short bf16_t;
typedef short bf16x8 __attribute__((ext_vector_type(8)));
typedef float f32x4 __attribute__((ext_vector_type(4)));
typedef float f32x2 __attribute__((ext_vector_type(2)));
typedef unsigned u32x4 __attribute__((ext_vector_type(4)));
typedef unsigned u32x2 __attribute__((ext_vector_type(2)));

constexpr int DM = 1024, SEQ = 8192, CTXL = 256, NLAT = 32768, NCTX = 1024, ROWS = 33792;
constexpr int ZP = 2304;
constexpr int ZQ = 0, ZK = 128, ZV = 256, ZR = 512, ZLF = 768, ZB = 800, ZCU = 1056, ZCV = 1312, ZDA = 1568, ZDG = 1824;
constexpr int FH = 2816, UPITCH = 1280;
constexpr float ALPHA = 1.41421356237f, EPS = 1e-6f;
constexpr int LDS_BYTES = 160 * 1024;
constexpr int NCHUNK64 = 528;

constexpr size_t OFF_CTL = 0;
constexpr size_t OFF_MODS = 4096;
constexpr size_t OFF_SGUW = OFF_MODS + 2ull * 5 * 6144 * 4;
constexpr size_t OFF_POOLW = OFF_SGUW + 2ull * 4 * 128 * 128 * 2;
constexpr size_t OFF_WIN = OFF_POOLW + 2ull * 4 * 64 * 64 * 2;
constexpr size_t OFF_WOUT = OFF_WIN + 2ull * 2304 * 1024 * 2;
constexpr size_t OFF_WUP = OFF_WOUT + 2ull * 1024 * 1024 * 2;
constexpr size_t OFF_WDN = OFF_WUP + 2ull * 5632 * 1024 * 2;
constexpr size_t OFF_X = OFF_WDN + 2ull * 1024 * 2816 * 2;
constexpr size_t OFF_H = OFF_X + (size_t)ROWS * 1024 * 4;
constexpr size_t OFF_R1 = OFF_H + (size_t)ROWS * 1024 * 2;
constexpr size_t OFF_Z = OFF_R1;
constexpr size_t OFF_ST = OFF_Z + (size_t)ROWS * ZP * 2;
constexpr size_t OFF_DEC = OFF_ST + (size_t)NCHUNK64 * 8 * 2048 * 4;
constexpr size_t OFF_U = OFF_R1;
constexpr size_t OFF_ACT = OFF_U + (size_t)ROWS * UPITCH * 2;
constexpr size_t WS_END = OFF_ACT + (size_t)ROWS * FH * 2;
static_assert(WS_END <= 536870912ull, "workspace map exceeds the guaranteed 4 x largest-tensor size");
static_assert(OFF_DEC + (size_t)NCHUNK64 * 8 * 32 * 4 <= WS_END, "mixer scratch must fit");

struct Params {
    const float *x, *c, *ctx, *c_ctx, *w_mod, *b_mod, *w_in, *gla_w_gate, *gla_b_gate, *gla_norm_w, *pool_w, *pool_scale, *sgu_w, *sgu_b,
        *sgu_ln_w, *sgu_ln_b, *cm_conv_w, *cm_conv_b, *cm_ln_w, *cm_ln_b, *w_out, *ffn_w_up, *ffn_conv_w, *ffn_w_down, *post_ln_w, *post_ln_b;
    float* out; unsigned char* ws;
    int wave, pad_;
};

DEVI float bf2f(unsigned v) { return __uint_as_float(v << 16); }
DEVI float bflo(unsigned v) { return __uint_as_float(v << 16); }
DEVI float bfhi(unsigned v) { return __uint_as_float(v & 0xffff0000u); }
DEVI unsigned cvt_pk_bf16(float lo, float hi) { unsigned r; asm volatile("v_cvt_pk_bf16_f32 %0, %1, %2" : "=v"(r) : "v"(lo), "v"(hi)); return r; }
DEVI bf16_t f2bf(float f) { return (bf16_t)(cvt_pk_bf16(f, 0.f) & 0xffffu); }
DEVI int my_lane() { int t; asm volatile("v_mbcnt_lo_u32_b32 %0, -1, 0\n\tv_mbcnt_hi_u32_b32 %0, -1, %0" : "=v"(t)); return t; }
DEVI int my_tid_w(int wave) { return (wave << 6) | my_lane(); }
DEVI float shx(float v, int o, int lane) { return __int_as_float(__builtin_amdgcn_ds_bpermute((lane ^ o) << 2, __float_as_int(v))); }
DEVI float wsum(float v, int lane) {
#pragma unroll
    for (int o = 32; o; o >>= 1) v += shx(v, o, lane);
    return v; }
DEVI float sigmoidf_(float x) { return __builtin_amdgcn_rcpf(1.0f + __expf(-x)); }
DEVI float siluf_(float x) { return x * __builtin_amdgcn_rcpf(1.0f + __expf(-x)); }
DEVI float geluf_(float x) { const float u = 0.7978845608f * (x + 0.044715f * x * x * x); return x * __builtin_amdgcn_rcpf(1.0f + __expf(-2.0f * u)); }
DEVI float logsigf_(float x) { return fminf(x, 0.f) - log1pf(__expf(-fabsf(x))); }
#define MFMA16(a, b, c) __builtin_amdgcn_mfma_f32_16x16x32_bf16((a), (b), (c), 0, 0, 0)

namespace pg8 {
constexpr int BM = 256, BK = 64, HALF = 128, HTB = HALF * BK * 2, STAGE_BYTES = 8 * HTB, NXCD = 8, WGM = 8;
DEVI int lds_byte(int r, int c) { const int st = (r >> 4) * 2 + (c >> 5), rr = r & 15, cc = c & 31, ob = rr * 64 + cc * 2; return st * 1024 + (ob ^ (((ob >> 9) & 1) << 5)); }
DEVI void stage_rc(int b, int& R, int& C) { const int st = b / 1024, sb = b % 1024, swz = sb ^ (((sb >> 9) & 1) << 5); R = (st >> 1) * 16 + swz / 64; C = (st & 1) * 32 + (swz % 64) / 2; }
DEVI int perm32(int rho) { const int n = rho >> 4, i = rho & 15; return 8 * (i >> 2) + 4 * n + (i & 3); }
struct Unit { int pm, pn; };
struct Gemm { const bf16_t* A; const bf16_t* Bt; int M, N, K; };
struct StaticOrder {
    int nM, nN, nwg, G, c;
    DEVI void init(int M, int N, int G_, int c_) { nM = M / BM; nN = N / BM; nwg = nM * nN; G = G_; c = c_; }
    DEVI bool next(int i, Unit& u) const {
        const long L = (long)i * G + c; if (L >= nwg) return false;
        int wgid = (int)L; { const int q = nwg / NXCD, r = nwg % NXCD, xcd = wgid % NXCD, off = wgid / NXCD; wgid = (xcd < r ? xcd * (q + 1) : r * (q + 1) + (xcd - r) * q) + off; }
        const int nig = WGM * nN, gid = wgid / nig, fm = gid * WGM, gsz = (nM - fm) < WGM ? (nM - fm) : WGM;
        u.pm = fm + ((wgid % nig) % gsz); u.pn = (wgid % nig) / gsz; return true;
    }
    DEVI void a_ready(const Unit&) const {}
    DEVI void done(const Unit&) const {}
};

struct EpiBf16 {
    static constexpr bool PERM = true;
    bf16_t* O; int ldc;
    DEVI void operator()(const f32x4 (&acc)[2][2][4][2], const Unit& u, int wr, int wc, int, int) const {
        const int ln = my_lane(), fr = ln & 15, fq = ln >> 4;
        const int row0 = u.pm * BM + wr * 64 + fr; const int col0 = u.pn * BM + wc * 32 + 8 * fq;
#pragma unroll
        for (int ai = 0; ai < 2; ++ai)
#pragma unroll
            for (int m = 0; m < 4; ++m) { bf16_t* rowp = O + (size_t)(row0 + ai * HALF + m * 16) * ldc + col0;
#pragma unroll
                for (int bj = 0; bj < 2; ++bj) { const f32x4 v0 = acc[ai][bj][m][0], v1 = acc[ai][bj][m][1];
                    u32x4 w; w.x = cvt_pk_bf16(v0[0], v0[1]); w.y = cvt_pk_bf16(v0[2], v0[3]); w.z = cvt_pk_bf16(v1[0], v1[1]); w.w = cvt_pk_bf16(v1[2], v1[3]);
                    *(u32x4*)(rowp + bj * HALF) = w; } }
    }
};
struct EpiRes {
    static constexpr bool PERM = true;
    float* X; const float* srcL; const float* srcC; const float* mods; int goff; int mode;
    DEVI void operator()(const f32x4 (&acc)[2][2][4][2], const Unit& u, int wr, int wc, int, int) const {
        const int ln = my_lane(), fr = ln & 15, fq = ln >> 4;
        const int rowt = u.pm * BM; const int b = rowt < NLAT ? (rowt >> 13) : 4;
        float* dst = X + (size_t)rowt * DM;
        const float* src = (mode == 0) ? (rowt < NLAT ? srcL + (size_t)rowt * DM : srcC + (size_t)(rowt - NLAT) * DM) : dst;
        const float al = (mode == 0) ? ALPHA : 1.0f;
        const int rl = wr * 64 + fr;
        const int col0 = u.pn * BM + wc * 32 + 8 * fq;
        const float* gp = mods + b * 6144 + goff + col0;
        f32x4 gv[2][2];
#pragma unroll
        for (int bj = 0; bj < 2; ++bj)
#pragma unroll
            for (int n = 0; n < 2; ++n) gv[bj][n] = *(const f32x4*)(gp + bj * HALF + n * 4);
#pragma unroll
        for (int ai = 0; ai < 2; ++ai)
#pragma unroll
            for (int m = 0; m < 4; ++m) { const size_t ro = (size_t)(rl + ai * HALF + m * 16) * DM + col0;
#pragma unroll
                for (int bj = 0; bj < 2; ++bj) { const f32x4 x0 = *(const f32x4*)(src + ro + bj * HALF), x1 = *(const f32x4*)(src + ro + bj * HALF + 4);
                    *(f32x4*)(dst + ro + bj * HALF) = al * x0 + gv[bj][0] * acc[ai][bj][m][0];
                    *(f32x4*)(dst + ro + bj * HALF + 4) = al * x1 + gv[bj][1] * acc[ai][bj][m][1]; } }
    }
};

template <class Epi, class Sched>
DEVI void gemm_phase(LAS unsigned char* lds, const Gemm g, const Sched& S, const Epi& E, int wave) {
    const int tid = my_tid_w(wave), wid = __builtin_amdgcn_readfirstlane(tid >> 6), lane = tid & 63, wr = wid >> 2, wc = wid & 3, fr = lane & 15, fq = lane >> 4;
    const int K = g.K, nt = K / BK;
    unsigned voffA[2], voffB[2];
#pragma unroll
    for (int i = 0; i < 2; ++i) { int R, C; stage_rc(tid * 16 + i * 8192, R, C); const int Rb = Epi::PERM ? ((R & ~31) + perm32(R & 31)) : R;
        voffA[i] = (unsigned)(R * K + C) * 2u; voffB[i] = (unsigned)(Rb * K + C) * 2u; }
    const size_t kstep = (size_t)(BK * 2);
    const size_t hstep = (size_t)HALF * K * 2;
    const size_t tstep = 2 * hstep;
    const unsigned ldsw = (unsigned)wid * 1024u;
    const int aoff = lds_byte(wr * 64 + fr, fq * 8), boff = lds_byte(wc * 32 + fr, fq * 8);
#define PG8_SA(b, h) (((b) * 2 + (h)) * HTB)
#define PG8_SB(b, h) ((4 + (b) * 2 + (h)) * HTB)
#define PG8_STAGE(bufoff, gbase, voff) do { _Pragma("unroll") for (int _i = 0; _i < 2; ++_i) \
        __builtin_amdgcn_global_load_lds((const unsigned*)((const char*)(gbase) + (voff)[_i]), (LAS unsigned*)(lds + (bufoff) + ldsw + _i * 8192), 16, 0, 0); } while (0)
#define PG8_LDA(dst, b, h) do { _Pragma("unroll") for (int m = 0; m < 4; ++m) _Pragma("unroll") for (int k = 0; k < 2; ++k) dst[m][k] = *(const LAS bf16x8*)(lds + PG8_SA(b, h) + aoff + m * 2048 + k * 1024); } while (0)
#define PG8_LDB(dst, b, h) do { _Pragma("unroll") for (int n = 0; n < 2; ++n) _Pragma("unroll") for (int k = 0; k < 2; ++k) dst[n][k] = *(const LAS bf16x8*)(lds + PG8_SB(b, h) + boff + n * 2048 + k * 1024); } while (0)
#define PG8_MMA(ai, bj, At, Bt) do { __builtin_amdgcn_s_setprio(1); _Pragma("unroll") for (int m = 0; m < 4; ++m) _Pragma("unroll") for (int n = 0; n < 2; ++n) _Pragma("unroll") for (int k = 0; k < 2; ++k) \
        acc[ai][bj][m][n] = __builtin_amdgcn_mfma_f32_16x16x32_bf16(Bt[n][k], At[m][k], acc[ai][bj][m][n], 0, 0, 0); __builtin_amdgcn_s_setprio(0); } while (0)
#define PG8_WAIT_V(n) asm volatile("s_waitcnt vmcnt(" #n ")" ::: "memory")
#define PG8_WAIT_L(n) asm volatile("s_waitcnt lgkmcnt(" #n ")" ::: "memory")
#define PG8_BAR __builtin_amdgcn_s_barrier()
#define PG8_SCHED __builtin_amdgcn_sched_barrier(0)
    Unit cur, nxt; int ui = 0;
    if (!S.next(0, cur)) return;
    f32x4 acc[2][2][4][2];
#pragma unroll
    for (int a = 0; a < 2; ++a)
#pragma unroll
        for (int b = 0; b < 2; ++b)
#pragma unroll
            for (int m = 0; m < 4; ++m)
#pragma unroll
                for (int n = 0; n < 2; ++n) acc[a][b][m][n] = (f32x4){0.f, 0.f, 0.f, 0.f};
    bf16x8 At[4][2], B0[2][2], B1[2][2];
    const char* cA = (const char*)g.A + (size_t)cur.pm * tstep; const char* cB = (const char*)g.Bt + (size_t)cur.pn * tstep;
    S.a_ready(cur);
    PG8_STAGE(PG8_SB(0, 0), cB, voffB); PG8_STAGE(PG8_SA(0, 0), cA, voffA); PG8_STAGE(PG8_SB(0, 1), cB + hstep, voffB); PG8_STAGE(PG8_SA(0, 1), cA + hstep, voffA);
    if (wr == 1) PG8_BAR;
    PG8_WAIT_V(4); PG8_BAR;
    PG8_STAGE(PG8_SB(1, 0), cB + kstep, voffB); PG8_STAGE(PG8_SA(1, 0), cA + kstep, voffA); PG8_STAGE(PG8_SB(1, 1), cB + hstep + kstep, voffB);
    PG8_WAIT_V(6); PG8_BAR;
    for (;;) {
        const bool has_next = S.next(ui + 1, nxt);
        const char* nA = has_next ? (const char*)g.A + (size_t)nxt.pm * tstep : cA; const char* nB = has_next ? (const char*)g.Bt + (size_t)nxt.pn * tstep : cB;
        for (int t = 0; t < nt; t += 2) {
            const bool last = (t == nt - 2);
            const char* a1 = cA + (size_t)(t + 1) * kstep;
            const char* a2 = last ? nA : cA + (size_t)(t + 2) * kstep; const char* b2 = last ? nB : cB + (size_t)(t + 2) * kstep;
            const char* a3 = a2 + kstep; const char* b3 = b2 + kstep;
            if (last && has_next) S.a_ready(nxt);
            PG8_LDB(B0, 0, 0); PG8_SCHED; PG8_LDA(At, 0, 0); PG8_STAGE(PG8_SA(1, 1), a1 + hstep, voffA);
            PG8_WAIT_L(8); PG8_BAR; PG8_WAIT_L(0); PG8_MMA(0, 0, At, B0); PG8_BAR; PG8_SCHED;
            PG8_LDB(B1, 0, 1); PG8_STAGE(PG8_SB(0, 0), b2, voffB);
            PG8_BAR; PG8_WAIT_L(0); PG8_MMA(0, 1, At, B1); PG8_BAR;
            PG8_LDA(At, 0, 1); PG8_STAGE(PG8_SA(0, 0), a2, voffA);
            PG8_BAR; PG8_WAIT_L(0); PG8_MMA(1, 0, At, B0); PG8_BAR; PG8_SCHED;
            PG8_STAGE(PG8_SB(0, 1), b2 + hstep, voffB);
            PG8_WAIT_V(6); PG8_BAR; PG8_MMA(1, 1, At, B1); PG8_BAR;
            PG8_LDB(B0, 1, 0); PG8_SCHED; PG8_LDA(At, 1, 0); PG8_STAGE(PG8_SA(0, 1), a2 + hstep, voffA);
            PG8_WAIT_L(8); PG8_BAR; PG8_WAIT_L(0); PG8_MMA(0, 0, At, B0); PG8_BAR; PG8_SCHED;
            PG8_LDB(B1, 1, 1); PG8_STAGE(PG8_SB(1, 0), b3, voffB);
            PG8_BAR; PG8_WAIT_L(0); PG8_MMA(0, 1, At, B1); PG8_BAR;
            PG8_LDA(At, 1, 1); PG8_STAGE(PG8_SA(1, 0), a3, voffA);
            PG8_BAR; PG8_WAIT_L(0); PG8_MMA(1, 0, At, B0); PG8_BAR; PG8_SCHED;
            PG8_STAGE(PG8_SB(1, 1), b3 + hstep, voffB);
            PG8_WAIT_V(6); PG8_BAR; PG8_MMA(1, 1, At, B1); PG8_BAR;
        }
        E(acc, cur, wr, wc, fr, fq); S.done(cur);
        if (!has_next) break;
#pragma unroll
        for (int a = 0; a < 2; ++a)
#pragma unroll
            for (int b = 0; b < 2; ++b)
#pragma unroll
                for (int m = 0; m < 4; ++m)
#pragma unroll
                    for (int n = 0; n < 2; ++n) acc[a][b][m][n] = (f32x4){0.f, 0.f, 0.f, 0.f};
        cur = nxt; cA = nA; cB = nB; ++ui;
    }
    PG8_WAIT_V(0);
    if (wr == 0) PG8_BAR;
    PG8_BAR;
#undef PG8_SA
#undef PG8_SB
#undef PG8_STAGE
#undef PG8_LDA
#undef PG8_LDB
#undef PG8_MMA
#undef PG8_WAIT_V
#undef PG8_WAIT_L
#undef PG8_BAR
#undef PG8_SCHED
}
}

DEVI void transpose_tile(int wave, float* tile, const float* src, int ld_src, int k0, int n0s, int nvalid, bf16_t* dst, int ld_dst, int n0d, int k0d) {
    const int tid = my_tid_w(wave);
#pragma unroll
    for (int i = 0; i < 8; ++i) { const int kk = i * 8 + (tid >> 6), nn = tid & 63; const int col = n0s + nn;
        tile[kk * 65 + nn] = (col < nvalid) ? src[(size_t)(k0 + kk) * ld_src + col] : 0.f; }
    __syncthreads();
#pragma unroll
    for (int i = 0; i < 8; ++i) { const int nn = i * 8 + (tid >> 6), kk = tid & 63; dst[(size_t)(n0d + nn) * ld_dst + k0d + kk] = f2bf(tile[kk * 65 + nn]); }
    __syncthreads();
}

DEVI void mods_item(float* lf, const Params& p, int item) {
    const int tid = my_tid_w(p.wave); const int l = item / 96, cgp = item % 96;
    float* s = lf;
    float* red = lf + 5120;
    for (int i = tid; i < 5120; i += 512) { const int r = i >> 10, k = i & 1023; const float v = (r < 4) ? p.c[r * 1024 + k] : p.c_ctx[k]; s[i] = siluf_(v); }
    __syncthreads();
    const int cc = tid & 63, kg = tid >> 6; const int col = cgp * 64 + cc;
    const float* W = p.w_mod + (size_t)l * 1024 * 6144 + col;
    float a0 = 0.f, a1 = 0.f, a2 = 0.f, a3 = 0.f, a4 = 0.f;
#pragma unroll 8
    for (int k = kg * 128; k < kg * 128 + 128; ++k) { const float w = W[(size_t)k * 6144];
        a0 += s[k] * w; a1 += s[1024 + k] * w; a2 += s[2048 + k] * w; a3 += s[3072 + k] * w; a4 += s[4096 + k] * w; }
    red[(kg * 5 + 0) * 64 + cc] = a0; red[(kg * 5 + 1) * 64 + cc] = a1; red[(kg * 5 + 2) * 64 + cc] = a2; red[(kg * 5 + 3) * 64 + cc] = a3; red[(kg * 5 + 4) * 64 + cc] = a4;
    __syncthreads();
    if (tid < 320) { const int r = tid >> 6, c2 = tid & 63; float sum = p.b_mod[l * 6144 + cgp * 64 + c2];
#pragma unroll
        for (int q = 0; q < 8; ++q) sum += red[(q * 5 + r) * 64 + c2];
        ((float*)(p.ws + OFF_MODS))[(l * 5 + r) * 6144 + cgp * 64 + c2] = sum; }
    __syncthreads();
}

__constant__ int c_cu0[5] = {0, 5, 10, 14, 18};
__constant__ int c_cnu[5] = {5, 5, 4, 4, 4};

DEVI void prep_phase(unsigned char* lds, const Params& p) {
    float* lf = (float*)lds;
    const int T_IN = 16 * 36, T_OUT = 256, T_UP = 16 * 88, T_DN = 44 * 16, T_L = T_IN + T_OUT + T_UP + T_DN;
    const int N_MODS = 192, N_TR = 2 * T_L, N_SGU = 32, N_POOL = 8;
    const int total = N_MODS + N_TR + N_SGU + N_POOL;
    for (int item = blockIdx.x; item < total; item += gridDim.x) {
        if (item < N_MODS) { mods_item(lf, p, item); continue; }
        int it = item - N_MODS;
        if (it < N_TR) {
            const int l = it / T_L; int r = it % T_L;
            if (r < T_IN) { const int kt = r / 36, ntl = r % 36;
                transpose_tile(p.wave, lf, p.w_in + (size_t)l * 1024 * 2080, 2080, kt * 64, ntl * 64, 2080, (bf16_t*)(p.ws + OFF_WIN) + (size_t)l * 2304 * 1024, 1024, ntl * 64, kt * 64); continue; }
            r -= T_IN;
            if (r < T_OUT) { const int kt = r / 16, ntl = r % 16;
                transpose_tile(p.wave, lf, p.w_out + (size_t)l * 1024 * 1024, 1024, kt * 64, ntl * 64, 1024, (bf16_t*)(p.ws + OFF_WOUT) + (size_t)l * 1024 * 1024, 1024, ntl * 64, kt * 64); continue; }
            r -= T_OUT;
            if (r < T_UP) { const int kt = r / 88, ntl = r % 88; const int n0d = ntl * 64; const int unit = n0d >> 8, sgn = (n0d >> 7) & 1, j0 = n0d & 127;
                transpose_tile(p.wave, lf, p.ffn_w_up + (size_t)l * 1024 * 5632, 5632, kt * 64, sgn * FH + unit * 128 + j0, 5632, (bf16_t*)(p.ws + OFF_WUP) + (size_t)l * 5632 * 1024, 1024, n0d, kt * 64); continue; }
            r -= T_UP;
            { const int kt = r / 16, ntl = r % 16;
                transpose_tile(p.wave, lf, p.ffn_w_down + (size_t)l * FH * 1024, 1024, kt * 64, ntl * 64, 1024, (bf16_t*)(p.ws + OFF_WDN) + (size_t)l * 1024 * FH, FH, ntl * 64, kt * 64); continue; }
        }
        it -= N_TR;
        if (it < N_SGU) { bf16_t* d = (bf16_t*)(p.ws + OFF_SGUW); const int base = it * 4096;
#pragma unroll
            for (int i = 0; i < 8; ++i) { const int idx = base + i * 512 + my_tid_w(p.wave); d[idx] = f2bf(p.sgu_w[idx]); }
            continue; }
        it -= N_SGU;
        { transpose_tile(p.wave, lf, p.pool_w + (size_t)it * 4096, 64, 0, 0, 64, (bf16_t*)(p.ws + OFF_POOLW) + (size_t)it * 4096, 64, 0, 0); }
    }
}

DEVI void ln_phase(int wave, const float* srcL, const float* srcC, int nrows, const float* lnw, const float* lnb, float* dstX, float* dstOut, const float* mods, int soff, bf16_t* H) {
    const int lane = my_lane(); int wid = wave; asm volatile("" : "+s"(wid));
    const int rstep = gridDim.x * 8;
    int r = blockIdx.x * 8 + wid;
    f32x4 vn[4];
    if (r < nrows) { const float* src = r < NLAT ? srcL + (size_t)r * DM : srcC + (size_t)(r - NLAT) * DM;
#pragma unroll
        for (int i = 0; i < 4; ++i) vn[i] = *(const f32x4*)(src + i * 256 + lane * 4); }
    for (; r < nrows; r += rstep) {
        f32x4 v[4];
#pragma unroll
        for (int i = 0; i < 4; ++i) v[i] = vn[i];
        { const int rn = r + rstep; if (rn < nrows) { const float* src = rn < NLAT ? srcL + (size_t)rn * DM : srcC + (size_t)(rn - NLAT) * DM;
#pragma unroll
            for (int i = 0; i < 4; ++i) vn[i] = *(const f32x4*)(src + i * 256 + lane * 4); } }
        float s = 0.f;
#pragma unroll
        for (int i = 0; i < 4; ++i) s += v[i][0] + v[i][1] + v[i][2] + v[i][3];
        float mean = wsum(s, lane) * (1.0f / 1024.0f);
        float q = 0.f;
#pragma unroll
        for (int i = 0; i < 4; ++i) { v[i] -= mean; q += v[i][0] * v[i][0] + v[i][1] * v[i][1] + v[i][2] * v[i][2] + v[i][3] * v[i][3]; }
        float rstd = rsqrtf(wsum(q, lane) * (1.0f / 1024.0f) + EPS);
        if (lnw) {
#pragma unroll
            for (int i = 0; i < 4; ++i) { const f32x4 w = *(const f32x4*)(lnw + i * 256 + lane * 4), b = *(const f32x4*)(lnb + i * 256 + lane * 4); v[i] = v[i] * rstd * w + b; }
            if (dstX) {
#pragma unroll
                for (int i = 0; i < 4; ++i) *(f32x4*)(dstX + (size_t)r * DM + i * 256 + lane * 4) = v[i]; }
            if (dstOut && r < NLAT) {
#pragma unroll
                for (int i = 0; i < 4; ++i) *(f32x4*)(dstOut + (size_t)r * DM + i * 256 + lane * 4) = v[i]; }
            if (mods) {
                s = 0.f;
#pragma unroll
                for (int i = 0; i < 4; ++i) s += v[i][0] + v[i][1] + v[i][2] + v[i][3];
                mean = wsum(s, lane) * (1.0f / 1024.0f); q = 0.f;
#pragma unroll
                for (int i = 0; i < 4; ++i) { v[i] -= mean; q += v[i][0] * v[i][0] + v[i][1] * v[i][1] + v[i][2] * v[i][2] + v[i][3] * v[i][3]; }
                rstd = rsqrtf(wsum(q, lane) * (1.0f / 1024.0f) + EPS);
            }
        }
        if (mods) {
            const int b = r < NLAT ? (r >> 13) : 4; const float* mp = mods + b * 6144 + soff;
#pragma unroll
            for (int i = 0; i < 4; ++i) { const f32x4 sh = *(const f32x4*)(mp + i * 256 + lane * 4), sc = *(const f32x4*)(mp + 1024 + i * 256 + lane * 4);
                const f32x4 h = v[i] * rstd * (1.0f + sc) + sh;
                u32x2 w; w.x = cvt_pk_bf16(h[0], h[1]); w.y = cvt_pk_bf16(h[2], h[3]);
                *(u32x2*)(H + (size_t)r * DM + i * 256 + lane * 4) = w; }
        }
    }
}

struct Tile { int row0, T0, L; };
DEVI Tile tile_of(int t, int tl) {
    const int nlat = NLAT / tl; Tile r;
    if (t < nlat) { r.row0 = t * tl; r.T0 = r.row0 & (SEQ - 1); r.L = SEQ; }
    else { const int q = (t - nlat) * tl; r.row0 = NLAT + q; r.T0 = q & (CTXL - 1); r.L = CTXL; }
    return r;
}

DEVI void pool_item(unsigned char* lds, const Params& p, int l, const Tile tl) {
    const int tid = my_tid_w(p.wave), wid = tid >> 6, lane = tid & 63, fr = lane & 15, fq = lane >> 4;
    bf16_t* zs = (bf16_t*)lds;
    bf16_t* ys = (bf16_t*)(lds + 80 * 256 * 2);
    const bf16_t* z = (const bf16_t*)(p.ws + OFF_Z);
    bf16_t* ycat = (bf16_t*)(p.ws + OFF_H);
    const int pg = wid >> 1; const bf16_t* Wt = (const bf16_t*)(p.ws + OFF_POOLW) + (size_t)(l * 4 + pg) * 4096;
    bf16x8 bw[4][2]; f32x4 psc[4];
#pragma unroll
    for (int nt = 0; nt < 4; ++nt) { bw[nt][0] = *(const bf16x8*)(Wt + (nt * 16 + fr) * 64 + fq * 8); bw[nt][1] = *(const bf16x8*)(Wt + (nt * 16 + fr) * 64 + 32 + fq * 8);
        psc[nt] = *(const f32x4*)(p.pool_scale + l * 256 + pg * 64 + nt * 16 + 4 * fq); }
#pragma unroll
    for (int i = tid; i < 80 * 32; i += 512) { const int r = i >> 5, c8 = i & 31; const int T = tl.T0 - 8 + r; u32x4 v = (u32x4){0u, 0u, 0u, 0u};
        if (T >= 0 && T < tl.L) v = *(const u32x4*)(z + (size_t)(tl.row0 - 8 + r) * ZP + ZB + c8 * 8);
        *(u32x4*)(zs + r * 256 + c8 * 8) = v; }
    __syncthreads();
    {
        const int g = wid & 3, hw = 1 << g; const int ch = g * 64 + (lane & 31) * 2; const int t0 = ((wid >> 2) * 2 + (lane >> 5)) * 16;
        unsigned rv[32];
#pragma unroll
        for (int i = 0; i < 32; ++i) rv[i] = *(const unsigned*)(zs + (t0 + i) * 256 + ch);
#pragma unroll
        for (int tt = 0; tt < 16; ++tt) { const int T = tl.T0 + t0 + tt; const int lo = max(T - hw, 0), hi = min(T + hw, tl.L);
            float s0 = 0.f, s1 = 0.f;
#pragma unroll
            for (int q = 0; q < 16; ++q) { const bool in = (q >= 8 - hw) && (q < 8 + hw); s0 += in ? bflo(rv[tt + q]) : 0.f; s1 += in ? bfhi(rv[tt + q]) : 0.f; }
            const float inv = __builtin_amdgcn_rcpf((float)(hi - lo)); const unsigned xv = rv[tt + 8];
            *(unsigned*)(ys + (t0 + tt) * 264 + ch) = cvt_pk_bf16(s0 * inv - bflo(xv), s1 * inv - bfhi(xv)); } }
    __syncthreads();
    { const int g = pg;
#pragma unroll
        for (int mi = 0; mi < 2; ++mi) { const int mt = (wid & 1) * 2 + mi; const int t = mt * 16 + fr;
            const bf16x8 a0 = *(const bf16x8*)(ys + t * 264 + g * 64 + fq * 8), a1 = *(const bf16x8*)(ys + t * 264 + g * 64 + 32 + fq * 8);
#pragma unroll
            for (int nt = 0; nt < 4; ++nt) {
                f32x4 acc = (f32x4){0.f, 0.f, 0.f, 0.f}; acc = MFMA16(bw[nt][0], a0, acc); acc = MFMA16(bw[nt][1], a1, acc);
                const int col = g * 64 + nt * 16 + 4 * fq; acc *= psc[nt];
                u32x2 w; w.x = cvt_pk_bf16(acc[0], acc[1]); w.y = cvt_pk_bf16(acc[2], acc[3]);
                *(u32x2*)(ycat + (size_t)(tl.row0 + t) * DM + 256 + col) = w; } } }
    __syncthreads();
}

DEVI void sgu_item(unsigned char* lds, const Params& p, int l, const Tile tl) {
    const int tid = my_tid_w(p.wave), wid = tid >> 6, lane = tid & 63, fr = lane & 15, fq = lane >> 4;
    bf16_t* vT = (bf16_t*)lds;
    const bf16_t* z = (const bf16_t*)(p.ws + OFF_Z);
    bf16_t* ycat = (bf16_t*)(p.ws + OFF_H);
    const int h = wid >> 1; const bf16_t* W = (const bf16_t*)(p.ws + OFF_SGUW) + (size_t)(l * 4 + h) * 16384;
    bf16x8 af[4][4]; float bias[4];
#pragma unroll
    for (int mi = 0; mi < 4; ++mi) { const int t = ((wid & 1) * 4 + mi) * 16 + fr; bias[mi] = p.sgu_b[(l * 4 + h) * 128 + t];
#pragma unroll
        for (int ks = 0; ks < 4; ++ks) af[mi][ks] = *(const bf16x8*)(W + t * 128 + ks * 32 + fq * 8); }
    { const f32x4 lw = *(const f32x4*)(p.sgu_ln_w + l * 256 + lane * 4), lb = *(const f32x4*)(p.sgu_ln_b + l * 256 + lane * 4);
#pragma unroll 1
        for (int hb = 0; hb < 2; ++hb) {
        u32x2 vraw[8];
#pragma unroll
        for (int i = 0; i < 8; ++i) vraw[i] = *(const u32x2*)(z + (size_t)(tl.row0 + wid * 16 + hb * 8 + i) * ZP + ZCV + lane * 4);
        f32x4 vo[8];
#pragma unroll
        for (int i = 0; i < 8; ++i) { const u32x2 raw = vraw[i];
            f32x4 v; v[0] = geluf_(bflo(raw.x)); v[1] = geluf_(bfhi(raw.x)); v[2] = geluf_(bflo(raw.y)); v[3] = geluf_(bfhi(raw.y));
            const float mean = wsum(v[0] + v[1] + v[2] + v[3], lane) * (1.0f / 256.0f); v -= mean;
            const float rstd = rsqrtf(wsum(v[0] * v[0] + v[1] * v[1] + v[2] * v[2] + v[3] * v[3], lane) * (1.0f / 256.0f) + EPS);
            vo[i] = v * rstd * lw + lb; }
#pragma unroll
        for (int j = 0; j < 4; ++j) { u32x4 w; w.x = cvt_pk_bf16(vo[0][j], vo[1][j]); w.y = cvt_pk_bf16(vo[2][j], vo[3][j]); w.z = cvt_pk_bf16(vo[4][j], vo[5][j]); w.w = cvt_pk_bf16(vo[6][j], vo[7][j]);
            *(u32x4*)(vT + (lane * 4 + j) * 136 + wid * 16 + hb * 8) = w; } } }
    __syncthreads();
    {
#pragma unroll
        for (int mi = 0; mi < 4; ++mi) { const int mt = (wid & 1) * 4 + mi; const int t = mt * 16 + fr;
            u32x2 uraw[4];
#pragma unroll
            for (int nt = 0; nt < 4; ++nt) uraw[nt] = *(const u32x2*)(z + (size_t)(tl.row0 + t) * ZP + ZCU + h * 64 + nt * 16 + 4 * fq);
#pragma unroll
            for (int nt = 0; nt < 4; ++nt) { f32x4 acc = (f32x4){0.f, 0.f, 0.f, 0.f};
#pragma unroll
                for (int ks = 0; ks < 4; ++ks) { const bf16x8 b = *(const bf16x8*)(vT + (h * 64 + nt * 16 + fr) * 136 + ks * 32 + fq * 8); acc = MFMA16(b, af[mi][ks], acc); }
                const int col = h * 64 + nt * 16 + 4 * fq; const u32x2 raw = uraw[nt]; const float bs = bias[mi];
                const float o0 = geluf_(bflo(raw.x)) * (acc[0] + bs), o1 = geluf_(bfhi(raw.x)) * (acc[1] + bs), o2 = geluf_(bflo(raw.y)) * (acc[2] + bs), o3 = geluf_(bfhi(raw.y)) * (acc[3] + bs);
                u32x2 w; w.x = cvt_pk_bf16(o0, o1); w.y = cvt_pk_bf16(o2, o3);
                *(u32x2*)(ycat + (size_t)(tl.row0 + t) * DM + 512 + col) = w; } } }
    __syncthreads();
}

DEVI void cm_item(unsigned char* lds, const Params& p, int l, const Tile tl) {
    const int tid = my_tid_w(p.wave), wid = tid >> 6, lane = tid & 63;
    float* yg = (float*)lds;
    const bf16_t* z = (const bf16_t*)(p.ws + OFF_Z);
    bf16_t* ycat = (bf16_t*)(p.ws + OFF_H);
    const int c = tid & 255, th = tid >> 8;
    float w[31];
#pragma unroll
    for (int j = 0; j < 31; ++j) w[j] = p.cm_conv_w[(l * 31 + j) * 256 + c];
    const float cb = p.cm_conv_b[l * 256 + c];
    const f32x4 lw = *(const f32x4*)(p.cm_ln_w + l * 256 + lane * 4), lb = *(const f32x4*)(p.cm_ln_b + l * 256 + lane * 4);
#pragma unroll 6
    for (int i = tid; i < 94 * 64; i += 512) { const int r = i >> 6, c4 = (i & 63) * 4; const int T = tl.T0 - 15 + r; f32x4 o = (f32x4){0.f, 0.f, 0.f, 0.f};
        if (T >= 0 && T < tl.L) { const bf16_t* zp = z + (size_t)(tl.row0 - 15 + r) * ZP; const u32x2 a = *(const u32x2*)(zp + ZDA + c4), g = *(const u32x2*)(zp + ZDG + c4);
            o[0] = bflo(a.x) * sigmoidf_(bflo(g.x)); o[1] = bfhi(a.x) * sigmoidf_(bfhi(g.x)); o[2] = bflo(a.y) * sigmoidf_(bflo(g.y)); o[3] = bfhi(a.y) * sigmoidf_(bfhi(g.y)); }
        *(f32x4*)(yg + r * 256 + c4) = o; }
    __syncthreads();
    float* yo = (float*)(lds + 94 * 256 * 4);
    {
#pragma unroll 1
        for (int bt = 0; bt < 8; ++bt) { float in[34];
#pragma unroll
            for (int i = 0; i < 34; ++i) in[i] = yg[(th * 32 + bt * 4 + i) * 256 + c];
            float s0 = cb, s1 = cb, s2 = cb, s3 = cb;
#pragma unroll
            for (int j = 0; j < 31; ++j) { s0 += in[j] * w[j]; s1 += in[j + 1] * w[j]; s2 += in[j + 2] * w[j]; s3 += in[j + 3] * w[j]; }
            float* op = yo + (th * 32 + bt * 4) * 256 + c; op[0] = s0; op[256] = s1; op[512] = s2; op[768] = s3; } }
    __syncthreads();
    {
#pragma unroll
        for (int i = 0; i < 8; ++i) { const int t = wid * 8 + i; f32x4 v = *(const f32x4*)(yo + t * 256 + lane * 4);
            const float mean = wsum(v[0] + v[1] + v[2] + v[3], lane) * (1.0f / 256.0f); v -= mean;
            const float rstd = rsqrtf(wsum(v[0] * v[0] + v[1] * v[1] + v[2] * v[2] + v[3] * v[3], lane) * (1.0f / 256.0f) + EPS);
            v = v * rstd * lw + lb;
            u32x2 w; w.x = cvt_pk_bf16(siluf_(v[0]), siluf_(v[1])); w.y = cvt_pk_bf16(siluf_(v[2]), siluf_(v[3]));
            *(u32x2*)(ycat + (size_t)(tl.row0 + t) * DM + 768 + lane * 4) = w; } }
    __syncthreads();
}

constexpr int GL_G = 0, GL_WG = 32768, GL_BG = 40960, GL_LOW = 41472, GL_VT = 49664, GL_QIN = 86528, GL_KIN = 103936, GL_STT = 121344, GL_KD = 86528, GL_WG1 = 141824, GL_BG1 = 150016;

DEVI void gla_load_common(int wave, unsigned char* lds, const bf16_t* z, const Tile tl, const float* wgate, const float* bgate) {
    const int tid = my_tid_w(wave);
    *(f32x4*)((float*)(lds + GL_WG) + tid * 4) = *(const f32x4*)(wgate + tid * 4);
    *(f32x4*)((float*)(lds + GL_WG1) + tid * 4) = *(const f32x4*)(wgate + 2048 + tid * 4);
    if (tid < 128) { ((float*)(lds + GL_BG))[tid] = bgate[tid]; ((float*)(lds + GL_BG1))[tid] = bgate[128 + tid]; }
    float* low = (float*)(lds + GL_LOW); bf16_t* vT = (bf16_t*)(lds + GL_VT);
    if (tid < 256) { const int t = tid >> 2, part = tid & 3; const u32x4 v = *(const u32x4*)(z + (size_t)(tl.row0 + t) * ZP + ZLF + part * 8);
        float* d = low + t * 32 + part * 8; d[0] = bflo(v.x); d[1] = bfhi(v.x); d[2] = bflo(v.y); d[3] = bfhi(v.y); d[4] = bflo(v.z); d[5] = bfhi(v.z); d[6] = bflo(v.w); d[7] = bfhi(v.w); }
    { const int ch = tid & 255, tb = tid >> 8;
#pragma unroll 2
        for (int tg = 0; tg < 4; ++tg) { const int t0 = (tb * 4 + tg) * 8; const bf16_t* zp = z + (size_t)(tl.row0 + t0) * ZP + ZV + ch;
            bf16_t e[8];
#pragma unroll
            for (int j = 0; j < 8; ++j) e[j] = zp[(size_t)j * ZP];
            u32x4 w; w.x = (unsigned)e[0] | ((unsigned)e[1] << 16); w.y = (unsigned)e[2] | ((unsigned)e[3] << 16); w.z = (unsigned)e[4] | ((unsigned)e[5] << 16); w.w = (unsigned)e[6] | ((unsigned)e[7] << 16);
            *(u32x4*)(vT + ch * 72 + t0) = w; } }
}
DEVI void gla_gates(unsigned char* lds, const Params& p, int l, int dir) {
    const int tid = my_tid_w(p.wave);
    float* G = (float*)(lds + GL_G); float* WG = (float*)(lds + (dir ? GL_WG1 : GL_WG)); const float* BG = (const float*)(lds + (dir ? GL_BG1 : GL_BG)); const float* low = (const float*)(lds + GL_LOW);
    __syncthreads();
    { const int t = tid >> 3, cgp = tid & 7; f32x4 lv[4];
#pragma unroll
        for (int r4 = 0; r4 < 4; ++r4) lv[r4] = *(const f32x4*)(low + t * 32 + dir * 16 + r4 * 4);
        f32x4 a[4];
#pragma unroll
        for (int j4 = 0; j4 < 4; ++j4) a[j4] = *(const f32x4*)(BG + cgp * 16 + j4 * 4);
#pragma unroll
        for (int r = 0; r < 16; ++r) { const float lr = lv[r >> 2][r & 3];
#pragma unroll
            for (int j4 = 0; j4 < 4; ++j4) a[j4] += lr * *(const f32x4*)(WG + r * 128 + cgp * 16 + j4 * 4); }
#pragma unroll
        for (int j4 = 0; j4 < 4; ++j4) { f32x4 g;
#pragma unroll
            for (int e = 0; e < 4; ++e) g[e] = fmaxf(logsigf_(a[j4][e]) * (1.0f / 16.0f), -1.0f);
            *(f32x4*)(G + t * 128 + cgp * 16 + j4 * 4) = g; } }
    __syncthreads();
    {
        const int col = tid & 127, seg = tid >> 7; float loc[16]; float run = 0.f;
#pragma unroll
        for (int i = 0; i < 16; ++i) { const int t = dir ? (seg * 16 + 15 - i) : (seg * 16 + i); run += G[t * 128 + col]; loc[i] = run; }
        WG[seg * 128 + col] = run;
        __syncthreads();
        float off = 0.f;
#pragma unroll
        for (int sg = 0; sg < 4; ++sg) { const float v = WG[sg * 128 + col]; off += (dir ? (sg > seg) : (sg < seg)) ? v : 0.f; }
#pragma unroll
        for (int i = 0; i < 16; ++i) { const int t = dir ? (seg * 16 + 15 - i) : (seg * 16 + i); G[t * 128 + col] = loc[i] + off; }
    }
    __syncthreads();
}

DEVI void gla_sum_item(unsigned char* lds, const Params& p, int l, const Tile tl) {
    const int tid = my_tid_w(p.wave), wid = tid >> 6, lane = tid & 63, fr = lane & 15, fq = lane >> 4;
    const bf16_t* z = (const bf16_t*)(p.ws + OFF_Z);
    float* ST = (float*)(p.ws + OFF_ST); float* DEC = (float*)(p.ws + OFF_DEC);
    const float* G = (const float*)(lds + GL_G); bf16_t* KD = (bf16_t*)(lds + GL_KD); const bf16_t* vT = (const bf16_t*)(lds + GL_VT);
    const int cid = tl.row0 >> 6;
    gla_load_common(p.wave, lds, z, tl, p.gla_w_gate + (size_t)l * 4096, p.gla_b_gate + l * 256);
    for (int dir = 0; dir < 2; ++dir) {
        gla_gates(lds, p, l, dir);
        { const int col = tid & 127, tq = tid >> 7; const float cl = G[(dir ? 0 : 63) * 128 + col];
            bf16_t kr[16];
#pragma unroll
            for (int tt = 0; tt < 16; ++tt) kr[tt] = z[(size_t)(tl.row0 + tq * 16 + tt) * ZP + ZK + col];
            float kd[16];
#pragma unroll
            for (int tt = 0; tt < 16; ++tt) kd[tt] = bf2f(kr[tt]) * __expf(cl - G[(tq * 16 + tt) * 128 + col]);
            u32x4 w0, w1;
            w0.x = cvt_pk_bf16(kd[0], kd[1]); w0.y = cvt_pk_bf16(kd[2], kd[3]); w0.z = cvt_pk_bf16(kd[4], kd[5]); w0.w = cvt_pk_bf16(kd[6], kd[7]);
            w1.x = cvt_pk_bf16(kd[8], kd[9]); w1.y = cvt_pk_bf16(kd[10], kd[11]); w1.z = cvt_pk_bf16(kd[12], kd[13]); w1.w = cvt_pk_bf16(kd[14], kd[15]);
            *(u32x4*)(KD + col * 72 + tq * 16) = w0; *(u32x4*)(KD + col * 72 + tq * 16 + 8) = w1;
            if (tid < 128) DEC[((size_t)(cid * 4 + (col >> 5)) * 2 + dir) * 32 + (col & 31)] = __expf(cl); }
        __syncthreads();
        { const int h = wid >> 1, mt = wid & 1;
            const bf16x8 a0 = *(const bf16x8*)(KD + (h * 32 + mt * 16 + fr) * 72 + fq * 8), a1 = *(const bf16x8*)(KD + (h * 32 + mt * 16 + fr) * 72 + 32 + fq * 8);
#pragma unroll
            for (int nt = 0; nt < 4; ++nt) { const bf16x8 b0 = *(const bf16x8*)(vT + (h * 64 + nt * 16 + fr) * 72 + fq * 8), b1 = *(const bf16x8*)(vT + (h * 64 + nt * 16 + fr) * 72 + 32 + fq * 8);
                f32x4 acc = (f32x4){0.f, 0.f, 0.f, 0.f}; acc = MFMA16(b0, a0, acc); acc = MFMA16(b1, a1, acc);
                *(f32x4*)(ST + ((size_t)(cid * 4 + h) * 2 + dir) * 2048 + (mt * 16 + fr) * 64 + nt * 16 + 4 * fq) = acc; } }
        __syncthreads();
    }
}

DEVI void gla_scan_phase(const Params& p) {
    float* ST = (float*)(p.ws + OFF_ST); const float* DEC = (const float*)(p.ws + OFF_DEC);
    for (int gt = blockIdx.x * 512 + my_tid_w(p.wave); gt < 65536; gt += gridDim.x * 512) {
        const int chain = gt >> 11, e = gt & 2047; const int dir = chain & 1, h = (chain >> 1) & 3, b = chain >> 3; const int d = e >> 6;
        float S = 0.f;
        for (int s0 = 0; s0 < 132; s0 += 12) {
            float kv[12], dc[12];
#pragma unroll
            for (int j = 0; j < 12; ++j) { const int s = s0 + j; const int cid = (s < 4) ? (512 + b * 4 + (dir ? 3 - s : s)) : (b * 128 + (dir ? 131 - s : s - 4));
                const size_t slot = (size_t)(cid * 4 + h) * 2 + dir; kv[j] = ST[slot * 2048 + e]; dc[j] = DEC[slot * 32 + d]; }
#pragma unroll
            for (int j = 0; j < 12; ++j) { const int s = s0 + j; const int cid = (s < 4) ? (512 + b * 4 + (dir ? 3 - s : s)) : (b * 128 + (dir ? 131 - s : s - 4));
                const size_t slot = (size_t)(cid * 4 + h) * 2 + dir; ST[slot * 2048 + e] = S; S = dc[j] * S + kv[j]; }
        }
    }
}

DEVI void gla_out_item(unsigned char* lds, const Params& p, int l, const Tile tl) {
    const int tid = my_tid_w(p.wave), wid = tid >> 6, lane = tid & 63, fr = lane & 15, fq = lane >> 4;
    const bf16_t* z = (const bf16_t*)(p.ws + OFF_Z);
    bf16_t* ycat = (bf16_t*)(p.ws + OFF_H);
    const float* ST = (const float*)(p.ws + OFF_ST);
    const float* G = (const float*)(lds + GL_G); bf16_t* QIN = (bf16_t*)(lds + GL_QIN); bf16_t* KIN = (bf16_t*)(lds + GL_KIN); bf16_t* STT = (bf16_t*)(lds + GL_STT);
    const bf16_t* vT = (const bf16_t*)(lds + GL_VT); bf16_t* AB = (bf16_t*)(lds + GL_G) + wid * 2304;
    const int cid = tl.row0 >> 6; const int h = wid >> 1, half = wid & 1;
    gla_load_common(p.wave, lds, z, tl, p.gla_w_gate + (size_t)l * 4096, p.gla_b_gate + l * 256);
    f32x4 o[2][4];
#pragma unroll
    for (int mi = 0; mi < 2; ++mi)
#pragma unroll
        for (int nt = 0; nt < 4; ++nt) o[mi][nt] = (f32x4){0.f, 0.f, 0.f, 0.f};
    for (int dir = 0; dir < 2; ++dir) {
        gla_gates(lds, p, l, dir);
        { const int col = tid & 127, tq = tid >> 7;
#pragma unroll 1
            for (int hb = 0; hb < 2; ++hb) {
                bf16_t qr[8], kr[8]; const bf16_t* zp = z + (size_t)(tl.row0 + tq * 16 + hb * 8) * ZP + col;
#pragma unroll
                for (int tt = 0; tt < 8; ++tt) { qr[tt] = zp[(size_t)tt * ZP + ZQ]; kr[tt] = zp[(size_t)tt * ZP + ZK]; }
#pragma unroll
                for (int tt = 0; tt < 8; ++tt) { const int t = tq * 16 + hb * 8 + tt; const float cum = G[t * 128 + col];
                    const float q = bf2f(qr[tt]) * 0.17677669529663687f * __expf(cum);
                    const float k = bf2f(kr[tt]) * __expf(-cum);
                    QIN[t * 136 + col] = f2bf(q); KIN[t * 136 + col] = f2bf(k); } }
            { const int he = tid & 255, dq = tid >> 8; const float* sp = ST + ((size_t)(cid * 4 + (he >> 6)) * 2 + dir) * 2048 + (dq * 16) * 64 + (he & 63);
                float sv[16];
#pragma unroll
                for (int j = 0; j < 16; ++j) sv[j] = sp[j * 64];
                u32x4 w0, w1;
                w0.x = cvt_pk_bf16(sv[0], sv[1]); w0.y = cvt_pk_bf16(sv[2], sv[3]); w0.z = cvt_pk_bf16(sv[4], sv[5]); w0.w = cvt_pk_bf16(sv[6], sv[7]);
                w1.x = cvt_pk_bf16(sv[8], sv[9]); w1.y = cvt_pk_bf16(sv[10], sv[11]); w1.z = cvt_pk_bf16(sv[12], sv[13]); w1.w = cvt_pk_bf16(sv[14], sv[15]);
                *(u32x4*)(STT + he * 40 + dq * 16) = w0; *(u32x4*)(STT + he * 40 + dq * 16 + 8) = w1; } }
        __syncthreads();
#pragma unroll
        for (int mi = 0; mi < 2; ++mi) { const int t = (half * 2 + mi) * 16 + fr; const bf16x8 qa = *(const bf16x8*)(QIN + t * 136 + h * 32 + fq * 8);
#pragma unroll
            for (int st = 0; st < 4; ++st) { const bf16x8 kb = *(const bf16x8*)(KIN + (st * 16 + fr) * 136 + h * 32 + fq * 8);
                f32x4 acc = (f32x4){0.f, 0.f, 0.f, 0.f}; acc = MFMA16(kb, qa, acc);
                const int s0 = st * 16 + 4 * fq;
#pragma unroll
                for (int j = 0; j < 4; ++j) { const int s = s0 + j; const bool keep = dir ? (s >= t) : (s <= t); acc[j] = keep ? acc[j] : 0.f; }
                u32x2 w; w.x = cvt_pk_bf16(acc[0], acc[1]); w.y = cvt_pk_bf16(acc[2], acc[3]);
                *(u32x2*)(AB + (mi * 16 + fr) * 72 + s0) = w; } }
        __syncthreads();
#pragma unroll
        for (int mi = 0; mi < 2; ++mi) { const int t = (half * 2 + mi) * 16 + fr;
            const bf16x8 aa0 = *(const bf16x8*)(AB + (mi * 16 + fr) * 72 + fq * 8), aa1 = *(const bf16x8*)(AB + (mi * 16 + fr) * 72 + 32 + fq * 8);
            const bf16x8 qa = *(const bf16x8*)(QIN + t * 136 + h * 32 + fq * 8);
#pragma unroll
            for (int nt = 0; nt < 4; ++nt) { const int er = h * 64 + nt * 16 + fr;
                const bf16x8 vb0 = *(const bf16x8*)(vT + er * 72 + fq * 8), vb1 = *(const bf16x8*)(vT + er * 72 + 32 + fq * 8), sb = *(const bf16x8*)(STT + er * 40 + fq * 8);
                o[mi][nt] = MFMA16(vb0, aa0, o[mi][nt]); o[mi][nt] = MFMA16(vb1, aa1, o[mi][nt]); o[mi][nt] = MFMA16(sb, qa, o[mi][nt]); } }
        __syncthreads();
    }
#pragma unroll
    for (int mi = 0; mi < 2; ++mi) { const int t = (half * 2 + mi) * 16 + fr; float ss = 0.f;
#pragma unroll
        for (int nt = 0; nt < 4; ++nt) ss += o[mi][nt][0] * o[mi][nt][0] + o[mi][nt][1] * o[mi][nt][1] + o[mi][nt][2] * o[mi][nt][2] + o[mi][nt][3] * o[mi][nt][3];
        ss += shx(ss, 16, lane); ss += shx(ss, 32, lane);
        const float rs = rsqrtf(ss * (1.0f / 64.0f) + EPS);
#pragma unroll
        for (int nt = 0; nt < 4; ++nt) { const int col = h * 64 + nt * 16 + 4 * fq; const f32x4 nw = *(const f32x4*)(p.gla_norm_w + l * 256 + col);
            const u32x2 raw = *(const u32x2*)(z + (size_t)(tl.row0 + t) * ZP + ZR + col);
            const float v0 = o[mi][nt][0] * rs * nw[0] * siluf_(bflo(raw.x)), v1 = o[mi][nt][1] * rs * nw[1] * siluf_(bfhi(raw.x)), v2 = o[mi][nt][2] * rs * nw[2] * siluf_(bflo(raw.y)), v3 = o[mi][nt][3] * rs * nw[3] * siluf_(bfhi(raw.y));
            u32x2 w; w.x = cvt_pk_bf16(v0, v1); w.y = cvt_pk_bf16(v2, v3);
            *(u32x2*)(ycat + (size_t)(tl.row0 + t) * DM + col) = w; } }
    __syncthreads();
}

DEVI void mix_phase(unsigned char* lds, const Params& p, int l) {
    const int n64 = (l == 0) ? 528 : 512, n128 = (l == 0) ? 264 : 256;
    const int nD = n64, nS = 528, nB = n64, nC = n128;
    const int total = nD + nS + nB + nC;
    for (int item = blockIdx.x; item < total; item += gridDim.x) {
        int it = item;
        if (it < nD) { cm_item(lds, p, l, tile_of(it, 64)); continue; }
        it -= nD;
        if (it < nS) { gla_sum_item(lds, p, l, tile_of(it, 64)); continue; }
        it -= nS;
        if (it < nB) { pool_item(lds, p, l, tile_of(it, 64)); continue; }
        it -= nB;
        sgu_item(lds, p, l, tile_of(it, 128));
    }
}
DEVI void gla_out_phase(unsigned char* lds, const Params& p, int l) {
    const int n64 = (l == 0) ? 528 : 512;
    for (int item = blockIdx.x; item < n64; item += gridDim.x) gla_out_item(lds, p, l, tile_of(item, 64));
}

DEVI void ffnconv_phase(unsigned char* lds, const Params& p, int l, int chunk) {
    const int lane = my_lane(); const int tg = p.wave;
    const int nu = c_cnu[chunk], u0 = c_cu0[chunk]; const int kc = FH;
    const int ntile = (l == 0) ? 528 : 512, npx = ntile >> 3;
    const bf16_t* U = (const bf16_t*)(p.ws + OFF_U); bf16_t* ACT = (bf16_t*)(p.ws + OFF_ACT);
    const int xg = blockIdx.x & 7, slot = blockIdx.x >> 3, nslot = gridDim.x >> 3;
    float wA[9][2], wG[9][2];
#pragma unroll
    for (int t = 0; t < 9; ++t) { wA[t][0] = 0.f; wA[t][1] = 0.f; wG[t][0] = 0.f; wG[t][1] = 0.f; }
    int cur_uu = -1;
    for (int j = slot; j < nu * npx; j += nslot) {
        const int uu = j / npx, rt = xg * npx + (j % npx); const Tile tl = tile_of(rt, 64);
        if (uu != cur_uu) {
#pragma unroll
            for (int t = 0; t < 9; ++t) { const float* wp = p.ffn_conv_w + ((size_t)l * 9 + t) * 5632 + (u0 + uu) * 128 + lane * 2;
                const f32x2 a = *(const f32x2*)wp, g = *(const f32x2*)(wp + FH); wA[t][0] = a[0]; wA[t][1] = a[1]; wG[t][0] = g[0]; wG[t][1] = g[1]; }
            cur_uu = uu;
        }
        const bool lat = tl.L == SEQ; const int gr = tl.T0 >> 6;
        const int c0 = tg * 8; const int seqc0 = (lat ? 0 : tl.T0) + c0, width = lat ? 64 : CTXL;
        float aA[8][2], aG[8][2];
#pragma unroll
        for (int t = 0; t < 8; ++t) { aA[t][0] = 0.f; aA[t][1] = 0.f; aG[t][0] = 0.f; aG[t][1] = 0.f; }
#pragma unroll
        for (int dr = 0; dr < 3; ++dr) {
            const bool rvalid = lat ? (gr + dr - 1 >= 0 && gr + dr - 1 < 128) : (dr == 1);
            if (rvalid) {
                const bf16_t* pb = U + ((size_t)(tl.row0 + (lat ? (dr - 1) * 64 : 0) + c0 - 1) * UPITCH + uu * 256 + lane * 2);
                unsigned va[10], vg[10];
#pragma unroll
                for (int q = 0; q < 10; ++q) { const int col = seqc0 + q - 1; va[q] = 0u; vg[q] = 0u;
                    if (col >= 0 && col < width) { va[q] = *(const unsigned*)(pb + (size_t)q * UPITCH); vg[q] = *(const unsigned*)(pb + (size_t)q * UPITCH + 128); } }
#pragma unroll
                for (int t = 0; t < 8; ++t)
#pragma unroll
                    for (int dc = 0; dc < 3; ++dc) { const int tap = dr * 3 + dc; const unsigned a = va[t + dc], g = vg[t + dc];
                        aA[t][0] += bflo(a) * wA[tap][0]; aA[t][1] += bfhi(a) * wA[tap][1]; aG[t][0] += bflo(g) * wG[tap][0]; aG[t][1] += bfhi(g) * wG[tap][1]; }
            }
        }
        bf16_t* ap = ACT + (size_t)(tl.row0 + c0) * kc + (u0 + uu) * 128 + lane * 2;
#pragma unroll
        for (int t = 0; t < 8; ++t) *(unsigned*)(ap + (size_t)t * kc) = cvt_pk_bf16(siluf_(aG[t][0]) * aA[t][0], siluf_(aG[t][1]) * aA[t][1]);
    }
}

DEVI void grid_barrier(unsigned* ctr, unsigned target) {
    asm volatile("s_waitcnt vmcnt(0)" ::: "memory");
    __syncthreads();
    if (threadIdx.x == 0) {
        __builtin_amdgcn_fence(__ATOMIC_RELEASE, "agent");
        asm volatile("s_waitcnt vmcnt(0)" ::: "memory");
        __hip_atomic_fetch_add(ctr, 1u, __ATOMIC_RELAXED, __HIP_MEMORY_SCOPE_AGENT);
        unsigned spins = 0;
        while (__hip_atomic_load(ctr, __ATOMIC_RELAXED, __HIP_MEMORY_SCOPE_AGENT) < target) { __builtin_amdgcn_s_sleep(1); if (++spins > (1u << 24)) break; }
        __builtin_amdgcn_fence(__ATOMIC_ACQUIRE, "agent");
        asm volatile("s_waitcnt vmcnt(0)" ::: "memory");
    }
    __syncthreads();
}

constexpr int PH_PER_LAYER = 19, N_PHASES = 1 + 2 * PH_PER_LAYER;

DEVI void run_phase(unsigned char* shm, const Params& p, int ph) {
    LAS unsigned char* lds3 = (LAS unsigned char*)shm;
    unsigned char* ws = p.ws;
    const float* mods = (const float*)(ws + OFF_MODS);
    float* X = (float*)(ws + OFF_X); bf16_t* H = (bf16_t*)(ws + OFF_H); bf16_t* Z = (bf16_t*)(ws + OFF_Z); bf16_t* U = (bf16_t*)(ws + OFF_U); bf16_t* ACT = (bf16_t*)(ws + OFF_ACT);
    if (ph == 0) { prep_phase(shm, p); return; }
    const int l = (ph - 1) / PH_PER_LAYER, k = (ph - 1) % PH_PER_LAYER;
    const float* ml = mods + l * 5 * 6144;
    const int Mrows = (l == 0) ? ROWS : NLAT;
    pg8::StaticOrder S;
    switch (k) {
    case 0: if (l == 0) ln_phase(p.wave, p.x, p.ctx, ROWS, nullptr, nullptr, nullptr, nullptr, ml, 0, H); break;
    case 1: { pg8::Gemm g{H, (const bf16_t*)(ws + OFF_WIN) + (size_t)l * 2304 * 1024, ROWS, ZP, 1024}; S.init(g.M, g.N, gridDim.x, blockIdx.x);
        pg8::EpiBf16 E{Z, ZP}; pg8::gemm_phase(lds3, g, S, E, p.wave); } break;
    case 2: mix_phase(shm, p, l); break;
    case 3: gla_scan_phase(p); break;
    case 4: gla_out_phase(shm, p, l); break;
    case 5: { pg8::Gemm g{H, (const bf16_t*)(ws + OFF_WOUT) + (size_t)l * 1024 * 1024, Mrows, 1024, 1024}; S.init(g.M, g.N, gridDim.x, blockIdx.x);
        pg8::EpiRes E{X, l == 0 ? p.x : X, l == 0 ? p.ctx : X + (size_t)NLAT * DM, ml, 2 * 1024, 0}; pg8::gemm_phase(lds3, g, S, E, p.wave); } break;
    case 6: ln_phase(p.wave, X, X + (size_t)NLAT * DM, Mrows, p.post_ln_w + (l * 2 + 0) * 1024, p.post_ln_b + (l * 2 + 0) * 1024, X, nullptr, ml, 3 * 1024, H); break;
    case 7: case 9: case 11: case 13: case 15: { const int ch = (k - 7) >> 1; const int u0 = c_cu0[ch], nu = c_cnu[ch];
        pg8::Gemm g{H, (const bf16_t*)(ws + OFF_WUP) + (size_t)l * 5632 * 1024 + (size_t)u0 * 256 * 1024, Mrows, nu * 256, 1024}; S.init(g.M, g.N, gridDim.x, blockIdx.x);
        pg8::EpiBf16 E{U, UPITCH}; pg8::gemm_phase(lds3, g, S, E, p.wave); } break;
    case 8: case 10: case 12: case 14: case 16: ffnconv_phase(shm, p, l, (k - 8) >> 1); break;
    case 17: { pg8::Gemm g{ACT, (const bf16_t*)(ws + OFF_WDN) + (size_t)l * 1024 * FH, Mrows, 1024, FH}; S.init(g.M, g.N, gridDim.x, blockIdx.x);
        pg8::EpiRes E{X, X, X + (size_t)NLAT * DM, ml, 5 * 1024, 0}; pg8::gemm_phase(lds3, g, S, E, p.wave); } break;
    case 18:
        if (l == 0) ln_phase(p.wave, X, X + (size_t)NLAT * DM, ROWS, p.post_ln_w + (l * 2 + 1) * 1024, p.post_ln_b + (l * 2 + 1) * 1024, X, nullptr, mods + 5 * 6144, 0, H);
        else ln_phase(p.wave, X, X + (size_t)NLAT * DM, NLAT, p.post_ln_w + (l * 2 + 1) * 1024, p.post_ln_b + (l * 2 + 1) * 1024, nullptr, p.out, nullptr, 0, nullptr);
        break;
    }
}

__global__ void __launch_bounds__(512, 2) mega(Params p, int ph_lo, int ph_hi, int coop) {
    extern __shared__ __attribute__((aligned(16))) unsigned char shm[];
    unsigned* ctr = (unsigned*)(p.ws + OFF_CTL);
    unsigned epoch = 0;
    Params q = p; q.wave = __builtin_amdgcn_readfirstlane((int)(threadIdx.x >> 6));
    for (int ph = ph_lo; ph < ph_hi; ++ph) {
        if (ph == 1 + PH_PER_LAYER) continue;
        run_phase(shm, q, ph);
#if PROBE_REP > 0
        if (ph == PROBE_PH || ph == PROBE_PH2) for (int rep = 0; rep < PROBE_REP; ++rep) { ++epoch; grid_barrier(ctr, epoch * gridDim.x); run_phase(shm, q, ph); }
#endif
        if (coop && ph + 1 < ph_hi) {
            if (ph == 0) cg::this_grid().sync();
            else { ++epoch; grid_barrier(ctr, epoch * gridDim.x); }
        }
    }
}

extern "C" void kernel_launch(void* const* d_in, const int* in_sizes, int n_in, void* d_out, int out_size, void* d_ws, size_t ws_size, hipStream_t stream) {
    static int grid = 0;
    if (grid == 0) {
        if (n_in != 26 || ws_size < WS_END) { fprintf(stderr, "kernel_launch: unexpected n_in %d / ws_size %zu (need %zu)\n", n_in, ws_size, (size_t)WS_END); grid = -1; return; }
        int dev = 0, cus = 0, per_cu = 0;
        hipGetDevice(&dev); hipDeviceGetAttribute(&cus, hipDeviceAttributeMultiprocessorCount, dev);
        if (hipFuncSetAttribute((const void*)mega, hipFuncAttributeMaxDynamicSharedMemorySize, LDS_BYTES) != hipSuccess) { fprintf(stderr, "kernel_launch: hipFuncSetAttribute failed\n"); grid = -1; return; }
        if (hipOccupancyMaxActiveBlocksPerMultiprocessor(&per_cu, (const void*)mega, 512, LDS_BYTES) != hipSuccess || per_cu < 1) { fprintf(stderr, "kernel_launch: occupancy query says %d\n", per_cu); per_cu = 1; }
        (void)hipGetLastError();
        grid = cus * 1;
    }
    if (grid < 0) return;
    Params p{};
    const float** pp = (const float**)&p;
    for (int i = 0; i < 26; ++i) pp[i] = (const float*)d_in[i];
    p.wave = 0; p.pad_ = 0;
    p.out = (float*)d_out; p.ws = (unsigned char*)d_ws;
#if MK_COOP
    hipMemsetAsync((char*)d_ws + OFF_CTL, 0, 4096, stream);
    int lo = 0, hi = N_PHASES, coop = 1;
    void* args[] = {&p, &lo, &hi, &coop};
    hipError_t e = hipLaunchCooperativeKernel((const void*)mega, dim3(grid), dim3(512), args, LDS_BYTES, stream);
    if (e != hipSuccess) fprintf(stderr, "cooperative launch failed: %s (grid %d)\n", hipGetErrorString(e), grid);
#else
    for (int ph = 0; ph < N_PHASES; ++ph) {
        if (ph == 1 + PH_PER_LAYER) continue;
        hipLaunchKernelGGL(mega, dim3(grid), dim3(512), LDS_BYTES, stream, p, ph, ph + 1, 0);
    }
#endif
}
```

```cpp
#include <hip/hip_runtime.h>
#include <hip/hip_cooperative_groups.h>
#include <cstdio>
#include <cstdint>
namespace cg = cooperative_groups;

#ifndef PROBE_REP
#define PROBE_REP 0
#define PROBE_PH -1
#define PROBE_PH2 -1
#endif
#ifndef MK_COOP
#define MK_COOP 1
#endif

#define DEVI __device__ __forceinline__
#define LAS __attribute__((address_space(3)))
typedef unsigned short bf16_t;
typedef short bf16x8 __attribute__((ext_vector_type(8)));
typedef float f32x4 __attribute__((ext_vector_type(4)));
typedef float f32x2 __attribute__((ext_vector_type(2)));
typedef unsigned u32x4 __attribute__((ext_vector_type(4)));
typedef unsigned u32x2 __attribute__((ext_vector_type(2)));

constexpr int DM = 1024, SEQ = 8192, CTXL = 256, NLAT = 32768, NCTX = 1024, ROWS = 33792;
constexpr int ZP = 2304;
constexpr int ZQ = 0, ZK = 128, ZV = 256, ZR = 512, ZLF = 768, ZB = 800, ZCU = 1056, ZCV = 1312, ZDA = 1568, ZDG = 1824;
constexpr int FH = 2816, UPITCH = 1280;
constexpr float ALPHA = 1.41421356237f, EPS = 1e-6f;
constexpr int LDS_BYTES = 160 * 1024;
constexpr int NCHUNK64 = 528;

constexpr size_t OFF_CTL = 0;
constexpr size_t OFF_MODS = 16384;
constexpr size_t OFF_SGUW = OFF_MODS + 2ull * 5 * 6144 * 4;
constexpr size_t OFF_POOLW = OFF_SGUW + 2ull * 4 * 128 * 128 * 2;
constexpr size_t OFF_WIN = OFF_POOLW + 2ull * 4 * 64 * 64 * 2;
constexpr size_t OFF_WOUT = OFF_WIN + 2ull * 2304 * 1024 * 2;
constexpr size_t OFF_WUP = OFF_WOUT + 2ull * 1024 * 1024 * 2;
constexpr size_t OFF_WDN = OFF_WUP + 2ull * 5632 * 1024 * 2;
constexpr size_t OFF_X = OFF_WDN + 2ull * 1024 * 2816 * 2;
constexpr size_t OFF_H = OFF_X + (size_t)ROWS * 1024 * 4;
constexpr size_t OFF_R1 = OFF_H + (size_t)ROWS * 1024 * 2;
constexpr size_t OFF_Z = OFF_R1;
constexpr size_t OFF_ST = OFF_Z + (size_t)ROWS * ZP * 2;
constexpr size_t OFF_DEC = OFF_ST + (size_t)NCHUNK64 * 8 * 2048 * 4;
constexpr size_t OFF_U = OFF_R1;
constexpr size_t OFF_ACT = OFF_U + (size_t)ROWS * UPITCH * 2;
constexpr size_t WS_END = OFF_ACT + (size_t)ROWS * FH * 2;
static_assert(WS_END <= 536870912ull, "workspace map exceeds the guaranteed 4 x largest-tensor size");
static_assert(OFF_DEC + (size_t)NCHUNK64 * 8 * 32 * 4 <= WS_END, "mixer scratch must fit");

struct Params {
    const float *x, *c, *ctx, *c_ctx, *w_mod, *b_mod, *w_in, *gla_w_gate, *gla_b_gate, *gla_norm_w, *pool_w, *pool_scale, *sgu_w, *sgu_b,
        *sgu_ln_w, *sgu_ln_b, *cm_conv_w, *cm_conv_b, *cm_ln_w, *cm_ln_b, *w_out, *ffn_w_up, *ffn_conv_w, *ffn_w_down, *post_ln_w, *post_ln_b;
    float* out; unsigned char* ws;
    int wave, pad_;
};

DEVI float bf2f(unsigned v) { return __uint_as_float(v << 16); }
DEVI float bflo(unsigned v) { return __uint_as_float(v << 16); }
DEVI float bfhi(unsigned v) { return __uint_as_float(v & 0xffff0000u); }
DEVI unsigned cvt_pk_bf16(float lo, float hi) { unsigned r; asm volatile("v_cvt_pk_bf16_f32 %0, %1, %2" : "=v"(r) : "v"(lo), "v"(hi)); return r; }
DEVI bf16_t f2bf(float f) { return (bf16_t)(cvt_pk_bf16(f, 0.f) & 0xffffu); }
DEVI int my_lane() { int t; asm volatile("v_mbcnt_lo_u32_b32 %0, -1, 0\n\tv_mbcnt_hi_u32_b32 %0, -1, %0" : "=v"(t)); return t; }
DEVI int my_tid_w(int wave) { return (wave << 6) | my_lane(); }
DEVI float shx(float v, int o, int lane) { return __int_as_float(__builtin_amdgcn_ds_bpermute((lane ^ o) << 2, __float_as_int(v))); }
DEVI float wsum(float v, int lane) {
#pragma unroll
    for (int o = 32; o; o >>= 1) v += shx(v, o, lane);
    return v; }
DEVI float sigmoidf_(float x) { return __builtin_amdgcn_rcpf(1.0f + __expf(-x)); }
DEVI float siluf_(float x) { return x * __builtin_amdgcn_rcpf(1.0f + __expf(-x)); }
DEVI float geluf_(float x) { const float u = 0.7978845608f * (x + 0.044715f * x * x * x); return x * __builtin_amdgcn_rcpf(1.0f + __expf(-2.0f * u)); }
DEVI float logsigf_(float x) { return fminf(x, 0.f) - log1pf(__expf(-fabsf(x))); }
#define MFMA16(a, b, c) __builtin_amdgcn_mfma_f32_16x16x32_bf16((a), (b), (c), 0, 0, 0)

namespace pg8 {
constexpr int BM = 256, BK = 64, HALF = 128, HTB = HALF * BK * 2, STAGE_BYTES = 8 * HTB, NXCD = 8, WGM = 8;
DEVI int lds_byte(int r, int c) { const int st = (r >> 4) * 2 + (c >> 5), rr = r & 15, cc = c & 31, ob = rr * 64 + cc * 2; return st * 1024 + (ob ^ (((ob >> 9) & 1) << 5)); }
DEVI void stage_rc(int b, int& R, int& C) { const int st = b / 1024, sb = b % 1024, swz = sb ^ (((sb >> 9) & 1) << 5); R = (st >> 1) * 16 + swz / 64; C = (st & 1) * 32 + (swz % 64) / 2; }
DEVI int perm32(int rho) { const int n = rho >> 4, i = rho & 15; return 8 * (i >> 2) + 4 * n + (i & 3); }
struct Unit { int pm, pn; };
struct Gemm { const bf16_t* A; const bf16_t* Bt; int M, N, K; };
struct StaticOrder {
    int nM, nN, nwg, G, c;
    DEVI void init(int M, int N, int G_, int c_) { nM = M / BM; nN = N / BM; nwg = nM * nN; G = G_; c = c_; }
    DEVI bool next(int i, Unit& u) const {
        const long L = (long)i * G + c; if (L >= nwg) return false;
        int wgid = (int)L; { const int q = nwg / NXCD, r = nwg % NXCD, xcd = wgid % NXCD, off = wgid / NXCD; wgid = (xcd < r ? xcd * (q + 1) : r * (q + 1) + (xcd - r) * q) + off; }
        const int nig = WGM * nN, gid = wgid / nig, fm = gid * WGM, gsz = (nM - fm) < WGM ? (nM - fm) : WGM;
        u.pm = fm + ((wgid % nig) % gsz); u.pn = (wgid % nig) / gsz; return true;
    }
    DEVI void a_ready(const Unit&) const {}
    DEVI void done(const Unit&) const {}
};

struct EpiBf16 {
    static constexpr bool PERM = true;
    bf16_t* O; int ldc;
    DEVI void operator()(const f32x4 (&acc)[2][2][4][2], const Unit& u, int wr, int wc, int, int) const {
        const int ln = my_lane(), fr = ln & 15, fq = ln >> 4;
        const int row0 = u.pm * BM + wr * 64 + fr; const int col0 = u.pn * BM + wc * 32 + 8 * fq;
#pragma unroll
        for (int ai = 0; ai < 2; ++ai)
#pragma unroll
            for (int m = 0; m < 4; ++m) { bf16_t* rowp = O + (size_t)(row0 + ai * HALF + m * 16) * ldc + col0;
#pragma unroll
                for (int bj = 0; bj < 2; ++bj) { const f32x4 v0 = acc[ai][bj][m][0], v1 = acc[ai][bj][m][1];
                    u32x4 w; w.x = cvt_pk_bf16(v0[0], v0[1]); w.y = cvt_pk_bf16(v0[2], v0[3]); w.z = cvt_pk_bf16(v1[0], v1[1]); w.w = cvt_pk_bf16(v1[2], v1[3]);
                    *(u32x4*)(rowp + bj * HALF) = w; } }
    }
};
struct EpiRes {
    static constexpr bool PERM = true;
    float* X; const float* srcL; const float* srcC; const float* mods; int goff; int mode;
    DEVI void operator()(const f32x4 (&acc)[2][2][4][2], const Unit& u, int wr, int wc, int, int) const {
        const int ln = my_lane(), fr = ln & 15, fq = ln >> 4;
        const int rowt = u.pm * BM; const int b = rowt < NLAT ? (rowt >> 13) : 4;
        float* dst = X + (size_t)rowt * DM;
        const float* src = (mode == 0) ? (rowt < NLAT ? srcL + (size_t)rowt * DM : srcC + (size_t)(rowt - NLAT) * DM) : dst;
        const float al = (mode == 0) ? ALPHA : 1.0f;
        const int rl = wr * 64 + fr;
        const int col0 = u.pn * BM + wc * 32 + 8 * fq;
        const float* gp = mods + b * 6144 + goff + col0;
        f32x4 gv[2][2];
#pragma unroll
        for (int bj = 0; bj < 2; ++bj)
#pragma unroll
            for (int n = 0; n < 2; ++n) gv[bj][n] = *(const f32x4*)(gp + bj * HALF + n * 4);
#pragma unroll
        for (int ai = 0; ai < 2; ++ai)
#pragma unroll
            for (int m = 0; m < 4; ++m) { const size_t ro = (size_t)(rl + ai * HALF + m * 16) * DM + col0;
#pragma unroll
                for (int bj = 0; bj < 2; ++bj) { const f32x4 x0 = *(const f32x4*)(src + ro + bj * HALF), x1 = *(const f32x4*)(src + ro + bj * HALF + 4);
                    *(f32x4*)(dst + ro + bj * HALF) = al * x0 + gv[bj][0] * acc[ai][bj][m][0];
                    *(f32x4*)(dst + ro + bj * HALF + 4) = al * x1 + gv[bj][1] * acc[ai][bj][m][1]; } }
    }
};

template <class Epi, class Sched>
DEVI void gemm_phase(LAS unsigned char* lds, const Gemm g, const Sched& S, const Epi& E, int wave) {
    const int tid = my_tid_w(wave), wid = __builtin_amdgcn_readfirstlane(tid >> 6), lane = tid & 63, wr = wid >> 2, wc = wid & 3, fr = lane & 15, fq = lane >> 4;
    const int K = g.K, nt = K / BK;
    unsigned voffA[2], voffB[2];
#pragma unroll
    for (int i = 0; i < 2; ++i) { int R, C; stage_rc(tid * 16 + i * 8192, R, C); const int Rb = Epi::PERM ? ((R & ~31) + perm32(R & 31)) : R;
        voffA[i] = (unsigned)(R * K + C) * 2u; voffB[i] = (unsigned)(Rb * K + C) * 2u; }
    const size_t kstep = (size_t)(BK * 2);
    const size_t hstep = (size_t)HALF * K * 2;
    const size_t tstep = 2 * hstep;
    const unsigned ldsw = (unsigned)wid * 1024u;
    const int aoff = lds_byte(wr * 64 + fr, fq * 8), boff = lds_byte(wc * 32 + fr, fq * 8);
#define PG8_SA(b, h) (((b) * 2 + (h)) * HTB)
#define PG8_SB(b, h) ((4 + (b) * 2 + (h)) * HTB)
#define PG8_STAGE(bufoff, gbase, voff) do { _Pragma("unroll") for (int _i = 0; _i < 2; ++_i) \
        __builtin_amdgcn_global_load_lds((const unsigned*)((const char*)(gbase) + (voff)[_i]), (LAS unsigned*)(lds + (bufoff) + ldsw + _i * 8192), 16, 0, 0); } while (0)
#define PG8_LDA(dst, b, h) do { _Pragma("unroll") for (int m = 0; m < 4; ++m) _Pragma("unroll") for (int k = 0; k < 2; ++k) dst[m][k] = *(const LAS bf16x8*)(lds + PG8_SA(b, h) + aoff + m * 2048 + k * 1024); } while (0)
#define PG8_LDB(dst, b, h) do { _Pragma("unroll") for (int n = 0; n < 2; ++n) _Pragma("unroll") for (int k = 0; k < 2; ++k) dst[n][k] = *(const LAS bf16x8*)(lds + PG8_SB(b, h) + boff + n * 2048 + k * 1024); } while (0)
#define PG8_MMA(ai, bj, At, Bt) do { __builtin_amdgcn_s_setprio(1); _Pragma("unroll") for (int m = 0; m < 4; ++m) _Pragma("unroll") for (int n = 0; n < 2; ++n) _Pragma("unroll") for (int k = 0; k < 2; ++k) \
        acc[ai][bj][m][n] = __builtin_amdgcn_mfma_f32_16x16x32_bf16(Bt[n][k], At[m][k], acc[ai][bj][m][n], 0, 0, 0); __builtin_amdgcn_s_setprio(0); } while (0)
#define PG8_WAIT_V(n) asm volatile("s_waitcnt vmcnt(" #n ")" ::: "memory")
#define PG8_WAIT_L(n) asm volatile("s_waitcnt lgkmcnt(" #n ")" ::: "memory")
#define PG8_BAR __builtin_amdgcn_s_barrier()
#define PG8_SCHED __builtin_amdgcn_sched_barrier(0)
    Unit cur, nxt; int ui = 0;
    if (!S.next(0, cur)) return;
    f32x4 acc[2][2][4][2];
#pragma unroll
    for (int a = 0; a < 2; ++a)
#pragma unroll
        for (int b = 0; b < 2; ++b)
#pragma unroll
            for (int m = 0; m < 4; ++m)
#pragma unroll
                for (int n = 0; n < 2; ++n) acc[a][b][m][n] = (f32x4){0.f, 0.f, 0.f, 0.f};
    bf16x8 At[4][2], B0[2][2], B1[2][2];
    const char* cA = (const char*)g.A + (size_t)cur.pm * tstep; const char* cB = (const char*)g.Bt + (size_t)cur.pn * tstep;
    S.a_ready(cur);
    PG8_STAGE(PG8_SB(0, 0), cB, voffB); PG8_STAGE(PG8_SA(0, 0), cA, voffA); PG8_STAGE(PG8_SB(0, 1), cB + hstep, voffB); PG8_STAGE(PG8_SA(0, 1), cA + hstep, voffA);
    if (wr == 1) PG8_BAR;
    PG8_WAIT_V(4); PG8_BAR;
    PG8_STAGE(PG8_SB(1, 0), cB + kstep, voffB); PG8_STAGE(PG8_SA(1, 0), cA + kstep, voffA); PG8_STAGE(PG8_SB(1, 1), cB + hstep + kstep, voffB);
    PG8_WAIT_V(6); PG8_BAR;
    for (;;) {
        const bool has_next = S.next(ui + 1, nxt);
        const char* nA = has_next ? (const char*)g.A + (size_t)nxt.pm * tstep : cA; const char* nB = has_next ? (const char*)g.Bt + (size_t)nxt.pn * tstep : cB;
        for (int t = 0; t < nt; t += 2) {
            const bool last = (t == nt - 2);
            const char* a1 = cA + (size_t)(t + 1) * kstep;
            const char* a2 = last ? nA : cA + (size_t)(t + 2) * kstep; const char* b2 = last ? nB : cB + (size_t)(t + 2) * kstep;
            const char* a3 = a2 + kstep; const char* b3 = b2 + kstep;
            if (last && has_next) S.a_ready(nxt);
            PG8_LDB(B0, 0, 0); PG8_SCHED; PG8_LDA(At, 0, 0); PG8_STAGE(PG8_SA(1, 1), a1 + hstep, voffA);
            PG8_WAIT_L(8); PG8_BAR; PG8_WAIT_L(0); PG8_MMA(0, 0, At, B0); PG8_BAR; PG8_SCHED;
            PG8_LDB(B1, 0, 1); PG8_STAGE(PG8_SB(0, 0), b2, voffB);
            PG8_BAR; PG8_WAIT_L(0); PG8_MMA(0, 1, At, B1); PG8_BAR;
            PG8_LDA(At, 0, 1); PG8_STAGE(PG8_SA(0, 0), a2, voffA);
            PG8_BAR; PG8_WAIT_L(0); PG8_MMA(1, 0, At, B0); PG8_BAR; PG8_SCHED;
            PG8_STAGE(PG8_SB(0, 1), b2 + hstep, voffB);
            PG8_WAIT_V(6); PG8_BAR; PG8_MMA(1, 1, At, B1); PG8_BAR;
            PG8_LDB(B0, 1, 0); PG8_SCHED; PG8_LDA(At, 1, 0); PG8_STAGE(PG8_SA(0, 1), a2 + hstep, voffA);
            PG8_WAIT_L(8); PG8_BAR; PG8_WAIT_L(0); PG8_MMA(0, 0, At, B0); PG8_BAR; PG8_SCHED;
            PG8_LDB(B1, 1, 1); PG8_STAGE(PG8_SB(1, 0), b3, voffB);
            PG8_BAR; PG8_WAIT_L(0); PG8_MMA(0, 1, At, B1); PG8_BAR;
            PG8_LDA(At, 1, 1); PG8_STAGE(PG8_SA(1, 0), a3, voffA);
            PG8_BAR; PG8_WAIT_L(0); PG8_MMA(1, 0, At, B0); PG8_BAR; PG8_SCHED;
            PG8_STAGE(PG8_SB(1, 1), b3 + hstep, voffB);
            PG8_WAIT_V(6); PG8_BAR; PG8_MMA(1, 1, At, B1); PG8_BAR;
        }
        E(acc, cur, wr, wc, fr, fq); S.done(cur);
        if (!has_next) break;
#pragma unroll
        for (int a = 0; a < 2; ++a)
#pragma unroll
            for (int b = 0; b < 2; ++b)
#pragma unroll
                for (int m = 0; m < 4; ++m)
#pragma unroll
                    for (int n = 0; n < 2; ++n) acc[a][b][m][n] = (f32x4){0.f, 0.f, 0.f, 0.f};
        cur = nxt; cA = nA; cB = nB; ++ui;
    }
    PG8_WAIT_V(0);
    if (wr == 0) PG8_BAR;
    PG8_BAR;
#undef PG8_SA
#undef PG8_SB
#undef PG8_STAGE
#undef PG8_LDA
#undef PG8_LDB
#undef PG8_MMA
#undef PG8_WAIT_V
#undef PG8_WAIT_L
#undef PG8_BAR
#undef PG8_SCHED
}
}

DEVI void transpose_tile(int wave, float* tile, const float* src, int ld_src, int k0, int n0s, int nvalid, bf16_t* dst, int ld_dst, int n0d, int k0d) {
    const int tid = my_tid_w(wave);
#pragma unroll
    for (int i = 0; i < 8; ++i) { const int kk = i * 8 + (tid >> 6), nn = tid & 63; const int col = n0s + nn;
        tile[kk * 65 + nn] = (col < nvalid) ? src[(size_t)(k0 + kk) * ld_src + col] : 0.f; }
    __syncthreads();
#pragma unroll
    for (int i = 0; i < 8; ++i) { const int nn = i * 8 + (tid >> 6), kk = tid & 63; dst[(size_t)(n0d + nn) * ld_dst + k0d + kk] = f2bf(tile[kk * 65 + nn]); }
    __syncthreads();
}

DEVI void mods_item(float* lf, const Params& p, int item) {
    const int tid = my_tid_w(p.wave); const int l = item / 96, cgp = item % 96;
    float* s = lf;
    float* red = lf + 5120;
    for (int i = tid; i < 5120; i += 512) { const int r = i >> 10, k = i & 1023; const float v = (r < 4) ? p.c[r * 1024 + k] : p.c_ctx[k]; s[i] = siluf_(v); }
    __syncthreads();
    const int cc = tid & 63, kg = tid >> 6; const int col = cgp * 64 + cc;
    const float* W = p.w_mod + (size_t)l * 1024 * 6144 + col;
    float a0 = 0.f, a1 = 0.f, a2 = 0.f, a3 = 0.f, a4 = 0.f;
#pragma unroll 8
    for (int k = kg * 128; k < kg * 128 + 128; ++k) { const float w = W[(size_t)k * 6144];
        a0 += s[k] * w; a1 += s[1024 + k] * w; a2 += s[2048 + k] * w; a3 += s[3072 + k] * w; a4 += s[4096 + k] * w; }
    red[(kg * 5 + 0) * 64 + cc] = a0; red[(kg * 5 + 1) * 64 + cc] = a1; red[(kg * 5 + 2) * 64 + cc] = a2; red[(kg * 5 + 3) * 64 + cc] = a3; red[(kg * 5 + 4) * 64 + cc] = a4;
    __syncthreads();
    if (tid < 320) { const int r = tid >> 6, c2 = tid & 63; float sum = p.b_mod[l * 6144 + cgp * 64 + c2];
#pragma unroll
        for (int q = 0; q < 8; ++q) sum += red[(q * 5 + r) * 64 + c2];
        ((float*)(p.ws + OFF_MODS))[(l * 5 + r) * 6144 + cgp * 64 + c2] = sum; }
    __syncthreads();
}

__constant__ int c_cu0[5] = {0, 5, 10, 14, 18};
__constant__ int c_cnu[5] = {5, 5, 4, 4, 4};

DEVI void prep_phase(unsigned char* lds, const Params& p) {
    float* lf = (float*)lds;
    const int T_IN = 16 * 36, T_OUT = 256, T_UP = 16 * 88, T_DN = 44 * 16, T_L = T_IN + T_OUT + T_UP + T_DN;
    const int N_MODS = 192, N_TR = 2 * T_L, N_SGU = 32, N_POOL = 8;
    const int total = N_MODS + N_TR + N_SGU + N_POOL;
    for (int item = blockIdx.x; item < total; item += gridDim.x) {
        if (item < N_MODS) { mods_item(lf, p, item); continue; }
        int it = item - N_MODS;
        if (it < N_TR) {
            const int l = it / T_L; int r = it % T_L;
            if (r < T_IN) { const int kt = r / 36, ntl = r % 36;
                transpose_tile(p.wave, lf, p.w_in + (size_t)l * 1024 * 2080, 2080, kt * 64, ntl * 64, 2080, (bf16_t*)(p.ws + OFF_WIN) + (size_t)l * 2304 * 1024, 1024, ntl * 64, kt * 64); continue; }
            r -= T_IN;
            if (r < T_OUT) { const int kt = r / 16, ntl = r % 16;
                transpose_tile(p.wave, lf, p.w_out + (size_t)l * 1024 * 1024, 1024, kt * 64, ntl * 64, 1024, (bf16_t*)(p.ws + OFF_WOUT) + (size_t)l * 1024 * 1024, 1024, ntl * 64, kt * 64); continue; }
            r -= T_OUT;
            if (r < T_UP) { const int kt = r / 88, ntl = r % 88; const int n0d = ntl * 64; const int unit = n0d >> 8, sgn = (n0d >> 7) & 1, j0 = n0d & 127;
                transpose_tile(p.wave, lf, p.ffn_w_up + (size_t)l * 1024 * 5632, 5632, kt * 64, sgn * FH + unit * 128 + j0, 5632, (bf16_t*)(p.ws + OFF_WUP) + (size_t)l * 5632 * 1024, 1024, n0d, kt * 64); continue; }
            r -= T_UP;
            { const int kt = r / 16, ntl = r % 16;
                transpose_tile(p.wave, lf, p.ffn_w_down + (size_t)l * FH * 1024, 1024, kt * 64, ntl * 64, 1024, (bf16_t*)(p.ws + OFF_WDN) + (size_t)l * 1024 * FH, FH, ntl * 64, kt * 64); continue; }
        }
        it -= N_TR;
        if (it < N_SGU) { bf16_t* d = (bf16_t*)(p.ws + OFF_SGUW); const int base = it * 4096;
#pragma unroll
            for (int i = 0; i < 8; ++i) { const int idx = base + i * 512 + my_tid_w(p.wave); d[idx] = f2bf(p.sgu_w[idx]); }
            continue; }
        it -= N_SGU;
        { transpose_tile(p.wave, lf, p.pool_w + (size_t)it * 4096, 64, 0, 0, 64, (bf16_t*)(p.ws + OFF_POOLW) + (size_t)it * 4096, 64, 0, 0); }
    }
}

DEVI void ln_phase(int wave, const float* srcL, const float* srcC, int nrows, const float* lnw, const float* lnb, float* dstX, float* dstOut, const float* mods, int soff, bf16_t* H) {
    const int lane = my_lane(); int wid = wave; asm volatile("" : "+s"(wid));
    const int rstep = gridDim.x * 8;
    int r = blockIdx.x * 8 + wid;
    f32x4 vn[4];
    if (r < nrows) { const float* src = r < NLAT ? srcL + (size_t)r * DM : srcC + (size_t)(r - NLAT) * DM;
#pragma unroll
        for (int i = 0; i < 4; ++i) vn[i] = *(const f32x4*)(src + i * 256 + lane * 4); }
    for (; r < nrows; r += rstep) {
        f32x4 v[4];
#pragma unroll
        for (int i = 0; i < 4; ++i) v[i] = vn[i];
        { const int rn = r + rstep; if (rn < nrows) { const float* src = rn < NLAT ? srcL + (size_t)rn * DM : srcC + (size_t)(rn - NLAT) * DM;
#pragma unroll
            for (int i = 0; i < 4; ++i) vn[i] = *(const f32x4*)(src + i * 256 + lane * 4); } }
        float s = 0.f;
#pragma unroll
        for (int i = 0; i < 4; ++i) s += v[i][0] + v[i][1] + v[i][2] + v[i][3];
        float mean = wsum(s, lane) * (1.0f / 1024.0f);
        float q = 0.f;
#pragma unroll
        for (int i = 0; i < 4; ++i) { v[i] -= mean; q += v[i][0] * v[i][0] + v[i][1] * v[i][1] + v[i][2] * v[i][2] + v[i][3] * v[i][3]; }
        float rstd = rsqrtf(wsum(q, lane) * (1.0f / 1024.0f) + EPS);
        if (lnw) {
#pragma unroll
            for (int i = 0; i < 4; ++i) { const f32x4 w = *(const f32x4*)(lnw + i * 256 + lane * 4), b = *(const f32x4*)(lnb + i * 256 + lane * 4); v[i] = v[i] * rstd * w + b; }
            if (dstX) {
#pragma unroll
                for (int i = 0; i < 4; ++i) *(f32x4*)(dstX + (size_t)r * DM + i * 256 + lane * 4) = v[i]; }
            if (dstOut && r < NLAT) {
#pragma unroll
                for (int i = 0; i < 4; ++i) *(f32x4*)(dstOut + (size_t)r * DM + i * 256 + lane * 4) = v[i]; }
            if (mods) {
                s = 0.f;
#pragma unroll
                for (int i = 0; i < 4; ++i) s += v[i][0] + v[i][1] + v[i][2] + v[i][3];
                mean = wsum(s, lane) * (1.0f / 1024.0f); q = 0.f;
#pragma unroll
                for (int i = 0; i < 4; ++i) { v[i] -= mean; q += v[i][0] * v[i][0] + v[i][1] * v[i][1] + v[i][2] * v[i][2] + v[i][3] * v[i][3]; }
                rstd = rsqrtf(wsum(q, lane) * (1.0f / 1024.0f) + EPS);
            }
        }
        if (mods) {
            const int b = r < NLAT ? (r >> 13) : 4; const float* mp = mods + b * 6144 + soff;
#pragma unroll
            for (int i = 0; i < 4; ++i) { const f32x4 sh = *(const f32x4*)(mp + i * 256 + lane * 4), sc = *(const f32x4*)(mp + 1024 + i * 256 + lane * 4);
                const f32x4 h = v[i] * rstd * (1.0f + sc) + sh;
                u32x2 w; w.x = cvt_pk_bf16(h[0], h[1]); w.y = cvt_pk_bf16(h[2], h[3]);
                *(u32x2*)(H + (size_t)r * DM + i * 256 + lane * 4) = w; }
        }
    }
}

struct Tile { int row0, T0, L; };
DEVI Tile tile_of(int t, int tl) {
    const int nlat = NLAT / tl; Tile r;
    if (t < nlat) { r.row0 = t * tl; r.T0 = r.row0 & (SEQ - 1); r.L = SEQ; }
    else { const int q = (t - nlat) * tl; r.row0 = NLAT + q; r.T0 = q & (CTXL - 1); r.L = CTXL; }
    return r;
}

DEVI void pool_item(unsigned char* lds, const Params& p, int l, const Tile tl) {
    const int tid = my_tid_w(p.wave), wid = tid >> 6, lane = tid & 63, fr = lane & 15, fq = lane >> 4;
    bf16_t* zs = (bf16_t*)lds;
    bf16_t* ys = (bf16_t*)(lds + 80 * 256 * 2);
    const bf16_t* z = (const bf16_t*)(p.ws + OFF_Z);
    bf16_t* ycat = (bf16_t*)(p.ws + OFF_H);
    const int pg = wid >> 1; const bf16_t* Wt = (const bf16_t*)(p.ws + OFF_POOLW) + (size_t)(l * 4 + pg) * 4096;
    bf16x8 bw[4][2]; f32x4 psc[4];
#pragma unroll
    for (int nt = 0; nt < 4; ++nt) { bw[nt][0] = *(const bf16x8*)(Wt + (nt * 16 + fr) * 64 + fq * 8); bw[nt][1] = *(const bf16x8*)(Wt + (nt * 16 + fr) * 64 + 32 + fq * 8);
        psc[nt] = *(const f32x4*)(p.pool_scale + l * 256 + pg * 64 + nt * 16 + 4 * fq); }
#pragma unroll
    for (int i = tid; i < 80 * 32; i += 512) { const int r = i >> 5, c8 = i & 31; const int T = tl.T0 - 8 + r; u32x4 v = (u32x4){0u, 0u, 0u, 0u};
        if (T >= 0 && T < tl.L) v = *(const u32x4*)(z + (size_t)(tl.row0 - 8 + r) * ZP + ZB + c8 * 8);
        *(u32x4*)(zs + r * 256 + c8 * 8) = v; }
    __syncthreads();
    {
        const int g = wid & 3, hw = 1 << g; const int ch = g * 64 + (lane & 31) * 2; const int t0 = ((wid >> 2) * 2 + (lane >> 5)) * 16;
        unsigned rv[32];
#pragma unroll
        for (int i = 0; i < 32; ++i) rv[i] = *(const unsigned*)(zs + (t0 + i) * 256 + ch);
#pragma unroll
        for (int tt = 0; tt < 16; ++tt) { const int T = tl.T0 + t0 + tt; const int lo = max(T - hw, 0), hi = min(T + hw, tl.L);
            float s0 = 0.f, s1 = 0.f;
#pragma unroll
            for (int q = 0; q < 16; ++q) { const bool in = (q >= 8 - hw) && (q < 8 + hw); s0 += in ? bflo(rv[tt + q]) : 0.f; s1 += in ? bfhi(rv[tt + q]) : 0.f; }
            const float inv = __builtin_amdgcn_rcpf((float)(hi - lo)); const unsigned xv = rv[tt + 8];
            *(unsigned*)(ys + (t0 + tt) * 264 + ch) = cvt_pk_bf16(s0 * inv - bflo(xv), s1 * inv - bfhi(xv)); } }
    __syncthreads();
    { const int g = pg;
#pragma unroll
        for (int mi = 0; mi < 2; ++mi) { const int mt = (wid & 1) * 2 + mi; const int t = mt * 16 + fr;
            const bf16x8 a0 = *(const bf16x8*)(ys + t * 264 + g * 64 + fq * 8), a1 = *(const bf16x8*)(ys + t * 264 + g * 64 + 32 + fq * 8);
#pragma unroll
            for (int nt = 0; nt < 4; ++nt) {
                f32x4 acc = (f32x4){0.f, 0.f, 0.f, 0.f}; acc = MFMA16(bw[nt][0], a0, acc); acc = MFMA16(bw[nt][1], a1, acc);
                const int col = g * 64 + nt * 16 + 4 * fq; acc *= psc[nt];
                u32x2 w; w.x = cvt_pk_bf16(acc[0], acc[1]); w.y = cvt_pk_bf16(acc[2], acc[3]);
                *(u32x2*)(ycat + (size_t)(tl.row0 + t) * DM + 256 + col) = w; } } }
    __syncthreads();
}

DEVI void sgu_item(unsigned char* lds, const Params& p, int l, const Tile tl) {
    const int tid = my_tid_w(p.wave), wid = tid >> 6, lane = tid & 63, fr = lane & 15, fq = lane >> 4;
    bf16_t* vT = (bf16_t*)lds;
    const bf16_t* z = (const bf16_t*)(p.ws + OFF_Z);
    bf16_t* ycat = (bf16_t*)(p.ws + OFF_H);
    const int h = wid >> 1; const bf16_t* W = (const bf16_t*)(p.ws + OFF_SGUW) + (size_t)(l * 4 + h) * 16384;
    bf16x8 af[4][4]; float bias[4];
#pragma unroll
    for (int mi = 0; mi < 4; ++mi) { const int t = ((wid & 1) * 4 + mi) * 16 + fr; bias[mi] = p.sgu_b[(l * 4 + h) * 128 + t];
#pragma unroll
        for (int ks = 0; ks < 4; ++ks) af[mi][ks] = *(const bf16x8*)(W + t * 128 + ks * 32 + fq * 8); }
    { const f32x4 lw = *(const f32x4*)(p.sgu_ln_w + l * 256 + lane * 4), lb = *(const f32x4*)(p.sgu_ln_b + l * 256 + lane * 4);
#pragma unroll 1
        for (int hb = 0; hb < 2; ++hb) {
        u32x2 vraw[8];
#pragma unroll
        for (int i = 0; i < 8; ++i) vraw[i] = *(const u32x2*)(z + (size_t)(tl.row0 + wid * 16 + hb * 8 + i) * ZP + ZCV + lane * 4);
        f32x4 vo[8];
#pragma unroll
        for (int i = 0; i < 8; ++i) { const u32x2 raw = vraw[i];
            f32x4 v; v[0] = geluf_(bflo(raw.x)); v[1] = geluf_(bfhi(raw.x)); v[2] = geluf_(bflo(raw.y)); v[3] = geluf_(bfhi(raw.y));
            const float mean = wsum(v[0] + v[1] + v[2] + v[3], lane) * (1.0f / 256.0f); v -= mean;
            const float rstd = rsqrtf(wsum(v[0] * v[0] + v[1] * v[1] + v[2] * v[2] + v[3] * v[3], lane) * (1.0f / 256.0f) + EPS);
            vo[i] = v * rstd * lw + lb; }
#pragma unroll
        for (int j = 0; j < 4; ++j) { u32x4 w; w.x = cvt_pk_bf16(vo[0][j], vo[1][j]); w.y = cvt_pk_bf16(vo[2][j], vo[3][j]); w.z = cvt_pk_bf16(vo[4][j], vo[5][j]); w.w = cvt_pk_bf16(vo[6][j], vo[7][j]);
            *(u32x4*)(vT + (lane * 4 + j) * 136 + wid * 16 + hb * 8) = w; } } }
    __syncthreads();
    {
#pragma unroll
        for (int mi = 0; mi < 4; ++mi) { const int mt = (wid & 1) * 4 + mi; const int t = mt * 16 + fr;
            u32x2 uraw[4];
#pragma unroll
            for (int nt = 0; nt < 4; ++nt) uraw[nt] = *(const u32x2*)(z + (size_t)(tl.row0 + t) * ZP + ZCU + h * 64 + nt * 16 + 4 * fq);
#pragma unroll
            for (int nt = 0; nt < 4; ++nt) { f32x4 acc = (f32x4){0.f, 0.f, 0.f, 0.f};
#pragma unroll
                for (int ks = 0; ks < 4; ++ks) { const bf16x8 b = *(const bf16x8*)(vT + (h * 64 + nt * 16 + fr) * 136 + ks * 32 + fq * 8); acc = MFMA16(b, af[mi][ks], acc); }
                const int col = h * 64 + nt * 16 + 4 * fq; const u32x2 raw = uraw[nt]; const float bs = bias[mi];
                const float o0 = geluf_(bflo(raw.x)) * (acc[0] + bs), o1 = geluf_(bfhi(raw.x)) * (acc[1] + bs), o2 = geluf_(bflo(raw.y)) * (acc[2] + bs), o3 = geluf_(bfhi(raw.y)) * (acc[3] + bs);
                u32x2 w; w.x = cvt_pk_bf16(o0, o1); w.y = cvt_pk_bf16(o2, o3);
                *(u32x2*)(ycat + (size_t)(tl.row0 + t) * DM + 512 + col) = w; } } }
    __syncthreads();
}

DEVI void cm_item(unsigned char* lds, const Params& p, int l, const Tile tl) {
    const int tid = my_tid_w(p.wave), wid = tid >> 6, lane = tid & 63;
    float* yg = (float*)lds;
    const bf16_t* z = (const bf16_t*)(p.ws + OFF_Z);
    bf16_t* ycat = (bf16_t*)(p.ws + OFF_H);
    const int c = tid & 255, th = tid >> 8;
    float w[31];
#pragma unroll
    for (int j = 0; j < 31; ++j) w[j] = p.cm_conv_w[(l * 31 + j) * 256 + c];
    const float cb = p.cm_conv_b[l * 256 + c];
    const f32x4 lw = *(const f32x4*)(p.cm_ln_w + l * 256 + lane * 4), lb = *(const f32x4*)(p.cm_ln_b + l * 256 + lane * 4);
#pragma unroll 6
    for (int i = tid; i < 94 * 64; i += 512) { const int r = i >> 6, c4 = (i & 63) * 4; const int T = tl.T0 - 15 + r; f32x4 o = (f32x4){0.f, 0.f, 0.f, 0.f};
        if (T >= 0 && T < tl.L) { const bf16_t* zp = z + (size_t)(tl.row0 - 15 + r) * ZP; const u32x2 a = *(const u32x2*)(zp + ZDA + c4), g = *(const u32x2*)(zp + ZDG + c4);
            o[0] = bflo(a.x) * sigmoidf_(bflo(g.x)); o[1] = bfhi(a.x) * sigmoidf_(bfhi(g.x)); o[2] = bflo(a.y) * sigmoidf_(bflo(g.y)); o[3] = bfhi(a.y) * sigmoidf_(bfhi(g.y)); }
        *(f32x4*)(yg + r * 256 + c4) = o; }
    __syncthreads();
    float* yo = (float*)(lds + 94 * 256 * 4);
    {
#pragma unroll 1
        for (int bt = 0; bt < 8; ++bt) { float in[34];
#pragma unroll
            for (int i = 0; i < 34; ++i) in[i] = yg[(th * 32 + bt * 4 + i) * 256 + c];
            float s0 = cb, s1 = cb, s2 = cb, s3 = cb;
#pragma unroll
            for (int j = 0; j < 31; ++j) { s0 += in[j] * w[j]; s1 += in[j + 1] * w[j]; s2 += in[j + 2] * w[j]; s3 += in[j + 3] * w[j]; }
            float* op = yo + (th * 32 + bt * 4) * 256 + c; op[0] = s0; op[256] = s1; op[512] = s2; op[768] = s3; } }
    __syncthreads();
    {
#pragma unroll
        for (int i = 0; i < 8; ++i) { const int t = wid * 8 + i; f32x4 v = *(const f32x4*)(yo + t * 256 + lane * 4);
            const float mean = wsum(v[0] + v[1] + v[2] + v[3], lane) * (1.0f / 256.0f); v -= mean;
            const float rstd = rsqrtf(wsum(v[0] * v[0] + v[1] * v[1] + v[2] * v[2] + v[3] * v[3], lane) * (1.0f / 256.0f) + EPS);
            v = v * rstd * lw + lb;
            u32x2 w; w.x = cvt_pk_bf16(siluf_(v[0]), siluf_(v[1])); w.y = cvt_pk_bf16(siluf_(v[2]), siluf_(v[3]));
            *(u32x2*)(ycat + (size_t)(tl.row0 + t) * DM + 768 + lane * 4) = w; } }
    __syncthreads();
}

constexpr int GL_G = 0, GL_WG = 32768, GL_BG = 40960, GL_LOW = 41472, GL_VT = 49664, GL_QIN = 86528, GL_KIN = 103936, GL_STT = 121344, GL_KD = 86528, GL_WG1 = 141824, GL_BG1 = 150016;

DEVI void gla_load_common(int wave, unsigned char* lds, const bf16_t* z, const Tile tl, const float* wgate, const float* bgate) {
    const int tid = my_tid_w(wave);
    *(f32x4*)((float*)(lds + GL_WG) + tid * 4) = *(const f32x4*)(wgate + tid * 4);
    *(f32x4*)((float*)(lds + GL_WG1) + tid * 4) = *(const f32x4*)(wgate + 2048 + tid * 4);
    if (tid < 128) { ((float*)(lds + GL_BG))[tid] = bgate[tid]; ((float*)(lds + GL_BG1))[tid] = bgate[128 + tid]; }
    float* low = (float*)(lds + GL_LOW); bf16_t* vT = (bf16_t*)(lds + GL_VT);
    if (tid < 256) { const int t = tid >> 2, part = tid & 3; const u32x4 v = *(const u32x4*)(z + (size_t)(tl.row0 + t) * ZP + ZLF + part * 8);
        float* d = low + t * 32 + part * 8; d[0] = bflo(v.x); d[1] = bfhi(v.x); d[2] = bflo(v.y); d[3] = bfhi(v.y); d[4] = bflo(v.z); d[5] = bfhi(v.z); d[6] = bflo(v.w); d[7] = bfhi(v.w); }
    { const int ch = tid & 255, tb = tid >> 8;
#pragma unroll 2
        for (int tg = 0; tg < 4; ++tg) { const int t0 = (tb * 4 + tg) * 8; const bf16_t* zp = z + (size_t)(tl.row0 + t0) * ZP + ZV + ch;
            bf16_t e[8];
#pragma unroll
            for (int j = 0; j < 8; ++j) e[j] = zp[(size_t)j * ZP];
            u32x4 w; w.x = (unsigned)e[0] | ((unsigned)e[1] << 16); w.y = (unsigned)e[2] | ((unsigned)e[3] << 16); w.z = (unsigned)e[4] | ((unsigned)e[5] << 16); w.w = (unsigned)e[6] | ((unsigned)e[7] << 16);
            *(u32x4*)(vT + ch * 72 + t0) = w; } }
}
DEVI void gla_gates(unsigned char* lds, const Params& p, int l, int dir) {
    const int tid = my_tid_w(p.wave);
    float* G = (float*)(lds + GL_G); float* WG = (float*)(lds + (dir ? GL_WG1 : GL_WG)); const float* BG = (const float*)(lds + (dir ? GL_BG1 : GL_BG)); const float* low = (const float*)(lds + GL_LOW);
    __syncthreads();
    { const int t = tid >> 3, cgp = tid & 7; f32x4 lv[4];
#pragma unroll
        for (int r4 = 0; r4 < 4; ++r4) lv[r4] = *(const f32x4*)(low + t * 32 + dir * 16 + r4 * 4);
        f32x4 a[4];
#pragma unroll
        for (int j4 = 0; j4 < 4; ++j4) a[j4] = *(const f32x4*)(BG + cgp * 16 + j4 * 4);
#pragma unroll
        for (int r = 0; r < 16; ++r) { const float lr = lv[r >> 2][r & 3];
#pragma unroll
            for (int j4 = 0; j4 < 4; ++j4) a[j4] += lr * *(const f32x4*)(WG + r * 128 + cgp * 16 + j4 * 4); }
#pragma unroll
        for (int j4 = 0; j4 < 4; ++j4) { f32x4 g;
#pragma unroll
            for (int e = 0; e < 4; ++e) g[e] = fmaxf(logsigf_(a[j4][e]) * (1.0f / 16.0f), -1.0f);
            *(f32x4*)(G + t * 128 + cgp * 16 + j4 * 4) = g; } }
    __syncthreads();
    {
        const int col = tid & 127, seg = tid >> 7; float loc[16]; float run = 0.f;
#pragma unroll
        for (int i = 0; i < 16; ++i) { const int t = dir ? (seg * 16 + 15 - i) : (seg * 16 + i); run += G[t * 128 + col]; loc[i] = run; }
        WG[seg * 128 + col] = run;
        __syncthreads();
        float off = 0.f;
#pragma unroll
        for (int sg = 0; sg < 4; ++sg) { const float v = WG[sg * 128 + col]; off += (dir ? (sg > seg) : (sg < seg)) ? v : 0.f; }
#pragma unroll
        for (int i = 0; i < 16; ++i) { const int t = dir ? (seg * 16 + 15 - i) : (seg * 16 + i); G[t * 128 + col] = loc[i] + off; }
    }
    __syncthreads();
}

DEVI void gla_sum_item(unsigned char* lds, const Params& p, int l, const Tile tl) {
    const int tid = my_tid_w(p.wave), wid = tid >> 6, lane = tid & 63, fr = lane & 15, fq = lane >> 4;
    const bf16_t* z = (const bf16_t*)(p.ws + OFF_Z);
    float* ST = (float*)(p.ws + OFF_ST); float* DEC = (float*)(p.ws + OFF_DEC);
    const float* G = (const float*)(lds + GL_G); bf16_t* KD = (bf16_t*)(lds + GL_KD); const bf16_t* vT = (const bf16_t*)(lds + GL_VT);
    const int cid = tl.row0 >> 6;
    gla_load_common(p.wave, lds, z, tl, p.gla_w_gate + (size_t)l * 4096, p.gla_b_gate + l * 256);
    for (int dir = 0; dir < 2; ++dir) {
        gla_gates(lds, p, l, dir);
        { const int col = tid & 127, tq = tid >> 7; const float cl = G[(dir ? 0 : 63) * 128 + col];
            bf16_t kr[16];
#pragma unroll
            for (int tt = 0; tt < 16; ++tt) kr[tt] = z[(size_t)(tl.row0 + tq * 16 + tt) * ZP + ZK + col];
            float kd[16];
#pragma unroll
            for (int tt = 0; tt < 16; ++tt) kd[tt] = bf2f(kr[tt]) * __expf(cl - G[(tq * 16 + tt) * 128 + col]);
            u32x4 w0, w1;
            w0.x = cvt_pk_bf16(kd[0], kd[1]); w0.y = cvt_pk_bf16(kd[2], kd[3]); w0.z = cvt_pk_bf16(kd[4], kd[5]); w0.w = cvt_pk_bf16(kd[6], kd[7]);
            w1.x = cvt_pk_bf16(kd[8], kd[9]); w1.y = cvt_pk_bf16(kd[10], kd[11]); w1.z = cvt_pk_bf16(kd[12], kd[13]); w1.w = cvt_pk_bf16(kd[14], kd[15]);
            *(u32x4*)(KD + col * 72 + tq * 16) = w0; *(u32x4*)(KD + col * 72 + tq * 16 + 8) = w1;
            if (tid < 128) DEC[((size_t)(cid * 4 + (col >> 5)) * 2 + dir) * 32 + (col & 31)] = __expf(cl); }
        __syncthreads();
        { const int h = wid >> 1, mt = wid & 1;
            const bf16x8 a0 = *(const bf16x8*)(KD + (h * 32 + mt * 16 + fr) * 72 + fq * 8), a1 = *(const bf16x8*)(KD + (h * 32 + mt * 16 + fr) * 72 + 32 + fq * 8);
#pragma unroll
            for (int nt = 0; nt < 4; ++nt) { const bf16x8 b0 = *(const bf16x8*)(vT + (h * 64 + nt * 16 + fr) * 72 + fq * 8), b1 = *(const bf16x8*)(vT + (h * 64 + nt * 16 + fr) * 72 + 32 + fq * 8);
                f32x4 acc = (f32x4){0.f, 0.f, 0.f, 0.f}; acc = MFMA16(b0, a0, acc); acc = MFMA16(b1, a1, acc);
                *(f32x4*)(ST + ((size_t)(cid * 4 + h) * 2 + dir) * 2048 + (mt * 16 + fr) * 64 + nt * 16 + 4 * fq) = acc; } }
        __syncthreads();
    }
}

DEVI void gla_scan_phase(const Params& p) {
    float* ST = (float*)(p.ws + OFF_ST); const float* DEC = (const float*)(p.ws + OFF_DEC);
    for (int gt = blockIdx.x * 512 + my_tid_w(p.wave); gt < 65536; gt += gridDim.x * 512) {
        const int chain = gt >> 11, e = gt & 2047; const int dir = chain & 1, h = (chain >> 1) & 3, b = chain >> 3; const int d = e >> 6;
        float S = 0.f;
        for (int s0 = 0; s0 < 132; s0 += 12) {
            float kv[12], dc[12];
#pragma unroll
            for (int j = 0; j < 12; ++j) { const int s = s0 + j; const int cid = (s < 4) ? (512 + b * 4 + (dir ? 3 - s : s)) : (b * 128 + (dir ? 131 - s : s - 4));
                const size_t slot = (size_t)(cid * 4 + h) * 2 + dir; kv[j] = ST[slot * 2048 + e]; dc[j] = DEC[slot * 32 + d]; }
#pragma unroll
            for (int j = 0; j < 12; ++j) { const int s = s0 + j; const int cid = (s < 4) ? (512 + b * 4 + (dir ? 3 - s : s)) : (b * 128 + (dir ? 131 - s : s - 4));
                const size_t slot = (size_t)(cid * 4 + h) * 2 + dir; ST[slot * 2048 + e] = S; S = dc[j] * S + kv[j]; }
        }
    }
}

DEVI void gla_out_item(unsigned char* lds, const Params& p, int l, const Tile tl) {
    const int tid = my_tid_w(p.wave), wid = tid >> 6, lane = tid & 63, fr = lane & 15, fq = lane >> 4;
    const bf16_t* z = (const bf16_t*)(p.ws + OFF_Z);
    bf16_t* ycat = (bf16_t*)(p.ws + OFF_H);
    const float* ST = (const float*)(p.ws + OFF_ST);
    const float* G = (const float*)(lds + GL_G); bf16_t* QIN = (bf16_t*)(lds + GL_QIN); bf16_t* KIN = (bf16_t*)(lds + GL_KIN); bf16_t* STT = (bf16_t*)(lds + GL_STT);
    const bf16_t* vT = (const bf16_t*)(lds + GL_VT); bf16_t* AB = (bf16_t*)(lds + GL_G) + wid * 2304;
    const int cid = tl.row0 >> 6; const int h = wid >> 1, half = wid & 1;
    gla_load_common(p.wave, lds, z, tl, p.gla_w_gate + (size_t)l * 4096, p.gla_b_gate + l * 256);
    f32x4 o[2][4];
#pragma unroll
    for (int mi = 0; mi < 2; ++mi)
#pragma unroll
        for (int nt = 0; nt < 4; ++nt) o[mi][nt] = (f32x4){0.f, 0.f, 0.f, 0.f};
    for (int dir = 0; dir < 2; ++dir) {
        gla_gates(lds, p, l, dir);
        { const int col = tid & 127, tq = tid >> 7;
#pragma unroll 1
            for (int hb = 0; hb < 2; ++hb) {
                bf16_t qr[8], kr[8]; const bf16_t* zp = z + (size_t)(tl.row0 + tq * 16 + hb * 8) * ZP + col;
#pragma unroll
                for (int tt = 0; tt < 8; ++tt) { qr[tt] = zp[(size_t)tt * ZP + ZQ]; kr[tt] = zp[(size_t)tt * ZP + ZK]; }
#pragma unroll
                for (int tt = 0; tt < 8; ++tt) { const int t = tq * 16 + hb * 8 + tt; const float cum = G[t * 128 + col];
                    const float q = bf2f(qr[tt]) * 0.17677669529663687f * __expf(cum);
                    const float k = bf2f(kr[tt]) * __expf(-cum);
                    QIN[t * 136 + col] = f2bf(q); KIN[t * 136 + col] = f2bf(k); } }
            { const int he = tid & 255, dq = tid >> 8; const float* sp = ST + ((size_t)(cid * 4 + (he >> 6)) * 2 + dir) * 2048 + (dq * 16) * 64 + (he & 63);
                float sv[16];
#pragma unroll
                for (int j = 0; j < 16; ++j) sv[j] = sp[j * 64];
                u32x4 w0, w1;
                w0.x = cvt_pk_bf16(sv[0], sv[1]); w0.y = cvt_pk_bf16(sv[2], sv[3]); w0.z = cvt_pk_bf16(sv[4], sv[5]); w0.w = cvt_pk_bf16(sv[6], sv[7]);
                w1.x = cvt_pk_bf16(sv[8], sv[9]); w1.y = cvt_pk_bf16(sv[10], sv[11]); w1.z = cvt_pk_bf16(sv[12], sv[13]); w1.w = cvt_pk_bf16(sv[14], sv[15]);
                *(u32x4*)(STT + he * 40 + dq * 16) = w0; *(u32x4*)(STT + he * 40 + dq * 16 + 8) = w1; } }
        __syncthreads();
#pragma unroll
        for (int mi = 0; mi < 2; ++mi) { const int t = (half * 2 + mi) * 16 + fr; const bf16x8 qa = *(const bf16x8*)(QIN + t * 136 + h * 32 + fq * 8);
#pragma unroll
            for (int st = 0; st < 4; ++st) { const bf16x8 kb = *(const bf16x8*)(KIN + (st * 16 + fr) * 136 + h * 32 + fq * 8);
                f32x4 acc = (f32x4){0.f, 0.f, 0.f, 0.f}; acc = MFMA16(kb, qa, acc);
                const int s0 = st * 16 + 4 * fq;
#pragma unroll
                for (int j = 0; j < 4; ++j) { const int s = s0 + j; const bool keep = dir ? (s >= t) : (s <= t); acc[j] = keep ? acc[j] : 0.f; }
                u32x2 w; w.x = cvt_pk_bf16(acc[0], acc[1]); w.y = cvt_pk_bf16(acc[2], acc[3]);
                *(u32x2*)(AB + (mi * 16 + fr) * 72 + s0) = w; } }
        __syncthreads();
#pragma unroll
        for (int mi = 0; mi < 2; ++mi) { const int t = (half * 2 + mi) * 16 + fr;
            const bf16x8 aa0 = *(const bf16x8*)(AB + (mi * 16 + fr) * 72 + fq * 8), aa1 = *(const bf16x8*)(AB + (mi * 16 + fr) * 72 + 32 + fq * 8);
            const bf16x8 qa = *(const bf16x8*)(QIN + t * 136 + h * 32 + fq * 8);
#pragma unroll
            for (int nt = 0; nt < 4; ++nt) { const int er = h * 64 + nt * 16 + fr;
                const bf16x8 vb0 = *(const bf16x8*)(vT + er * 72 + fq * 8), vb1 = *(const bf16x8*)(vT + er * 72 + 32 + fq * 8), sb = *(const bf16x8*)(STT + er * 40 + fq * 8);
                o[mi][nt] = MFMA16(vb0, aa0, o[mi][nt]); o[mi][nt] = MFMA16(vb1, aa1, o[mi][nt]); o[mi][nt] = MFMA16(sb, qa, o[mi][nt]); } }
        __syncthreads();
    }
#pragma unroll
    for (int mi = 0; mi < 2; ++mi) { const int t = (half * 2 + mi) * 16 + fr; float ss = 0.f;
#pragma unroll
        for (int nt = 0; nt < 4; ++nt) ss += o[mi][nt][0] * o[mi][nt][0] + o[mi][nt][1] * o[mi][nt][1] + o[mi][nt][2] * o[mi][nt][2] + o[mi][nt][3] * o[mi][nt][3];
        ss += shx(ss, 16, lane); ss += shx(ss, 32, lane);
        const float rs = rsqrtf(ss * (1.0f / 64.0f) + EPS);
#pragma unroll
        for (int nt = 0; nt < 4; ++nt) { const int col = h * 64 + nt * 16 + 4 * fq; const f32x4 nw = *(const f32x4*)(p.gla_norm_w + l * 256 + col);
            const u32x2 raw = *(const u32x2*)(z + (size_t)(tl.row0 + t) * ZP + ZR + col);
            const float v0 = o[mi][nt][0] * rs * nw[0] * siluf_(bflo(raw.x)), v1 = o[mi][nt][1] * rs * nw[1] * siluf_(bfhi(raw.x)), v2 = o[mi][nt][2] * rs * nw[2] * siluf_(bflo(raw.y)), v3 = o[mi][nt][3] * rs * nw[3] * siluf_(bfhi(raw.y));
            u32x2 w; w.x = cvt_pk_bf16(v0, v1); w.y = cvt_pk_bf16(v2, v3);
            *(u32x2*)(ycat + (size_t)(tl.row0 + t) * DM + col) = w; } }
    __syncthreads();
}

DEVI void mix_phase(unsigned char* lds, const Params& p, int l) {
    const int n64 = (l == 0) ? 528 : 512, n128 = (l == 0) ? 264 : 256;
    const int nD = n64, nS = 528, nB = n64, nC = n128;
    const int total = nD + nS + nB + nC;
    for (int item = blockIdx.x; item < total; item += gridDim.x) {
        int it = item;
        if (it < nD) { cm_item(lds, p, l, tile_of(it, 64)); continue; }
        it -= nD;
        if (it < nS) { gla_sum_item(lds, p, l, tile_of(it, 64)); continue; }
        it -= nS;
        if (it < nB) { pool_item(lds, p, l, tile_of(it, 64)); continue; }
        it -= nB;
        sgu_item(lds, p, l, tile_of(it, 128));
    }
}
DEVI void gla_out_phase(unsigned char* lds, const Params& p, int l) {
    const int n64 = (l == 0) ? 528 : 512;
    for (int item = blockIdx.x; item < n64; item += gridDim.x) gla_out_item(lds, p, l, tile_of(item, 64));
}

struct ConvItem { int uu, row0, c0, seqc0, width, gr; bool lat; };
DEVI ConvItem conv_decode(int j, int npx, int xg, int tg) {
    ConvItem it; it.uu = j / npx; const Tile tl = tile_of(xg * npx + (j % npx), 64);
    it.lat = tl.L == SEQ; it.gr = tl.T0 >> 6; it.row0 = tl.row0; it.c0 = tg * 8; it.seqc0 = (it.lat ? 0 : tl.T0) + it.c0; it.width = it.lat ? 64 : CTXL; return it;
}
DEVI void conv_issue(const ConvItem& it, const bf16_t* U, int lane, unsigned (&va)[3][10], unsigned (&vg)[3][10]) {
#pragma unroll
    for (int dr = 0; dr < 3; ++dr) {
        const bool rvalid = it.lat ? (it.gr + dr - 1 >= 0 && it.gr + dr - 1 < 128) : (dr == 1);
        const int rbase = rvalid ? (it.row0 + (it.lat ? (dr - 1) * 64 : 0)) : it.row0;
        const bf16_t* pb = U + ((size_t)(rbase + it.c0) * UPITCH + it.uu * 256 + lane * 2);
#pragma unroll
        for (int q = 0; q < 10; ++q) { const int col = it.seqc0 + q - 1; const bool cvalid = col >= 0 && col < it.width;
            const bf16_t* pq = pb + (cvalid ? (q - 1) : 0) * UPITCH;
            va[dr][q] = *(const unsigned*)pq; vg[dr][q] = *(const unsigned*)(pq + 128); }
    }
}
DEVI void ffnconv_phase(unsigned char* lds, const Params& p, int l, int chunk) {
    const int lane = my_lane(); const int tg = p.wave;
    const int nu = c_cnu[chunk], u0 = c_cu0[chunk]; const int kc = FH;
    const int ntile = (l == 0) ? 528 : 512, npx = ntile >> 3;
    const bf16_t* U = (const bf16_t*)(p.ws + OFF_U); bf16_t* ACT = (bf16_t*)(p.ws + OFF_ACT);
    const int xg = blockIdx.x & 7, slot = blockIdx.x >> 3, nslot = gridDim.x >> 3, jend = nu * npx;
    float wA[9][2], wG[9][2];
#pragma unroll
    for (int t = 0; t < 9; ++t) { wA[t][0] = 0.f; wA[t][1] = 0.f; wG[t][0] = 0.f; wG[t][1] = 0.f; }
    int cur_uu = -1;
    unsigned va[3][10], vg[3][10], na[3][10], ng[3][10];
    int j = slot;
    if (j < jend) { const ConvItem it = conv_decode(j, npx, xg, tg); conv_issue(it, U, lane, va, vg); }
    for (; j < jend; j += nslot) {
        const ConvItem it = conv_decode(j, npx, xg, tg);
        const int jn = j + nslot;
        if (jn < jend) { const ConvItem nx = conv_decode(jn, npx, xg, tg); conv_issue(nx, U, lane, na, ng); }
        if (it.uu != cur_uu) {
#pragma unroll
            for (int t = 0; t < 9; ++t) { const float* wp = p.ffn_conv_w + ((size_t)l * 9 + t) * 5632 + (u0 + it.uu) * 128 + lane * 2;
                const f32x2 a = *(const f32x2*)wp, g = *(const f32x2*)(wp + FH); wA[t][0] = a[0]; wA[t][1] = a[1]; wG[t][0] = g[0]; wG[t][1] = g[1]; }
            cur_uu = it.uu;
        }
        float aA[8][2], aG[8][2];
#pragma unroll
        for (int t = 0; t < 8; ++t) { aA[t][0] = 0.f; aA[t][1] = 0.f; aG[t][0] = 0.f; aG[t][1] = 0.f; }
#pragma unroll
        for (int dr = 0; dr < 3; ++dr) {
            const bool rvalid = it.lat ? (it.gr + dr - 1 >= 0 && it.gr + dr - 1 < 128) : (dr == 1);
#pragma unroll
            for (int q = 0; q < 10; ++q) { const int col = it.seqc0 + q - 1; const bool ok = rvalid && col >= 0 && col < it.width;
                va[dr][q] = ok ? va[dr][q] : 0u; vg[dr][q] = ok ? vg[dr][q] : 0u; }
#pragma unroll
            for (int t = 0; t < 8; ++t)
#pragma unroll
                for (int dc = 0; dc < 3; ++dc) { const int tap = dr * 3 + dc; const unsigned a = va[dr][t + dc], g = vg[dr][t + dc];
                    aA[t][0] += bflo(a) * wA[tap][0]; aA[t][1] += bfhi(a) * wA[tap][1]; aG[t][0] += bflo(g) * wG[tap][0]; aG[t][1] += bfhi(g) * wG[tap][1]; }
        }
        bf16_t* ap = ACT + (size_t)(it.row0 + it.c0) * kc + (u0 + it.uu) * 128 + lane * 2;
#pragma unroll
        for (int t = 0; t < 8; ++t) *(unsigned*)(ap + (size_t)t * kc) = cvt_pk_bf16(siluf_(aG[t][0]) * aA[t][0], siluf_(aG[t][1]) * aA[t][1]);
#pragma unroll
        for (int dr = 0; dr < 3; ++dr)
#pragma unroll
            for (int q = 0; q < 10; ++q) { va[dr][q] = na[dr][q]; vg[dr][q] = ng[dr][q]; }
    }
}

#define XB_TMO      128
#define XB_XCNT(j)  (256  + 64 * (j))
#define XB_XSUB(j)  (1280 + 64 * (j))
#define XB_XGEN(j)  (2304 + 64 * (j))
#define XB_TOP      3328
#define XB_TOPGEN   3392
#define XB_SPIN_CAP (1u << 22)
DEVI unsigned xb_ld(unsigned* p) { return __hip_atomic_load(p, __ATOMIC_RELAXED, __HIP_MEMORY_SCOPE_AGENT); }
DEVI unsigned xb_add(unsigned* p, unsigned v) { return __hip_atomic_fetch_add(p, v, __ATOMIC_RELAXED, __HIP_MEMORY_SCOPE_AGENT); }
DEVI unsigned xb_xcc_id() { return (unsigned)__builtin_amdgcn_s_getreg((3 << 11) | 20) & 0xFu; }
#define XB_SPIN(cond, bar) do { unsigned _sp = 0; while (cond) { __builtin_amdgcn_s_sleep(1); \
    if ((++_sp & 255u) == 0u) { if (xb_ld(&(bar)[XB_TMO])) break; if (_sp > XB_SPIN_CAP) { atomicAdd(&(bar)[XB_TMO], 1u); break; } } } } while (0)
struct XcdBarrier { unsigned* bar; unsigned x; volatile LAS unsigned* st; };
DEVI XcdBarrier xcd_barrier_post(unsigned* bar, volatile LAS unsigned* st) {
    XcdBarrier b; b.bar = bar; b.x = xb_xcc_id(); b.st = st;
    if (threadIdx.x == 0) (void)xb_add(&bar[XB_XCNT(b.x)], 1u);
    return b;
}
DEVI void xcd_barrier_complete(unsigned* bar, unsigned x, unsigned& nloc, unsigned& nx) {
    const unsigned G = gridDim.x * gridDim.y * gridDim.z;
    unsigned sum, cnt, mine, sp = 0u;
    for (;;) {
        sum = 0u; cnt = 0u; mine = 0u;
#pragma unroll
        for (unsigned j = 0; j < 16; ++j) { const unsigned c = xb_ld(&bar[XB_XCNT(j)]); sum += c; cnt += (c > 0u) ? 1u : 0u; mine = (j == x) ? c : mine; }
        if (sum == G) break;
        __builtin_amdgcn_s_sleep(1);
        if ((++sp & 255u) == 0u) { if (xb_ld(&bar[XB_TMO])) break; if (sp > XB_SPIN_CAP) { atomicAdd(&bar[XB_TMO], 1u); break; } }
    }
    nloc = mine > 0u ? mine : 1u; nx = cnt > 0u ? cnt : 1u;
}
DEVI void xcd_barrier(const XcdBarrier& b) {
    asm volatile("s_waitcnt vmcnt(0)" ::: "memory");
    __syncthreads();
    if (threadIdx.x == 0) {
        unsigned* bar = b.bar;
        __builtin_amdgcn_s_waitcnt(0);
        unsigned nloc = b.st[0], nx = b.st[1];
        if (nloc == 0u) { xcd_barrier_complete(bar, b.x, nloc, nx); b.st[0] = nloc; b.st[1] = nx; }
        const unsigned old = xb_add(&bar[XB_XSUB(b.x)], 1u);
        const unsigned gen = old / nloc;
        if (old + 1u == (gen + 1u) * nloc) {
            __builtin_amdgcn_fence(__ATOMIC_RELEASE, "agent");
            asm volatile("s_waitcnt vmcnt(0)" ::: "memory");
            const unsigned og = xb_add(&bar[XB_TOP], 1u);
            const unsigned tg = og / nx;
            if (og + 1u == (tg + 1u) * nx) xb_add(&bar[XB_TOPGEN], 1u);
            else XB_SPIN(xb_ld(&bar[XB_TOPGEN]) == tg, bar);
            __builtin_amdgcn_fence(__ATOMIC_ACQUIRE, "agent");
            xb_add(&bar[XB_XGEN(b.x)], 1u);
            asm volatile("s_waitcnt vmcnt(0)" ::: "memory");
        } else {
            XB_SPIN(xb_ld(&bar[XB_XGEN(b.x)]) == gen, bar);
            __builtin_amdgcn_fence(__ATOMIC_ACQUIRE, "agent");
            asm volatile("s_waitcnt vmcnt(0)" ::: "memory");
        }
    }
    __syncthreads();
}

constexpr int PH_PER_LAYER = 19, N_PHASES = 1 + 2 * PH_PER_LAYER;

DEVI void run_phase(unsigned char* shm, const Params& p, int ph) {
    LAS unsigned char* lds3 = (LAS unsigned char*)shm;
    unsigned char* ws = p.ws;
    const float* mods = (const float*)(ws + OFF_MODS);
    float* X = (float*)(ws + OFF_X); bf16_t* H = (bf16_t*)(ws + OFF_H); bf16_t* Z = (bf16_t*)(ws + OFF_Z); bf16_t* U = (bf16_t*)(ws + OFF_U); bf16_t* ACT = (bf16_t*)(ws + OFF_ACT);
    if (ph == 0) { prep_phase(shm, p); return; }
    const int l = (ph - 1) / PH_PER_LAYER, k = (ph - 1) % PH_PER_LAYER;
    const float* ml = mods + l * 5 * 6144;
    const int Mrows = (l == 0) ? ROWS : NLAT;
    pg8::StaticOrder S;
    switch (k) {
    case 0: if (l == 0) ln_phase(p.wave, p.x, p.ctx, ROWS, nullptr, nullptr, nullptr, nullptr, ml, 0, H); break;
    case 1: { pg8::Gemm g{H, (const bf16_t*)(ws + OFF_WIN) + (size_t)l * 2304 * 1024, ROWS, ZP, 1024}; S.init(g.M, g.N, gridDim.x, blockIdx.x);
        pg8::EpiBf16 E{Z, ZP}; pg8::gemm_phase(lds3, g, S, E, p.wave); } break;
    case 2: mix_phase(shm, p, l); break;
    case 3: gla_scan_phase(p); break;
    case 4: gla_out_phase(shm, p, l); break;
    case 5: { pg8::Gemm g{H, (const bf16_t*)(ws + OFF_WOUT) + (size_t)l * 1024 * 1024, Mrows, 1024, 1024}; S.init(g.M, g.N, gridDim.x, blockIdx.x);
        pg8::EpiRes E{X, l == 0 ? p.x : X, l == 0 ? p.ctx : X + (size_t)NLAT * DM, ml, 2 * 1024, 0}; pg8::gemm_phase(lds3, g, S, E, p.wave); } break;
    case 6: ln_phase(p.wave, X, X + (size_t)NLAT * DM, Mrows, p.post_ln_w + (l * 2 + 0) * 1024, p.post_ln_b + (l * 2 + 0) * 1024, X, nullptr, ml, 3 * 1024, H); break;
    case 7: case 9: case 11: case 13: case 15: { const int ch = (k - 7) >> 1; const int u0 = c_cu0[ch], nu = c_cnu[ch];
        pg8::Gemm g{H, (const bf16_t*)(ws + OFF_WUP) + (size_t)l * 5632 * 1024 + (size_t)u0 * 256 * 1024, Mrows, nu * 256, 1024}; S.init(g.M, g.N, gridDim.x, blockIdx.x);
        pg8::EpiBf16 E{U, UPITCH}; pg8::gemm_phase(lds3, g, S, E, p.wave); } break;
    case 8: case 10: case 12: case 14: case 16: ffnconv_phase(shm, p, l, (k - 8) >> 1); break;
    case 17: { pg8::Gemm g{ACT, (const bf16_t*)(ws + OFF_WDN) + (size_t)l * 1024 * FH, Mrows, 1024, FH}; S.init(g.M, g.N, gridDim.x, blockIdx.x);
        pg8::EpiRes E{X, X, X + (size_t)NLAT * DM, ml, 5 * 1024, 0}; pg8::gemm_phase(lds3, g, S, E, p.wave); } break;
    case 18:
        if (l == 0) ln_phase(p.wave, X, X + (size_t)NLAT * DM, ROWS, p.post_ln_w + (l * 2 + 1) * 1024, p.post_ln_b + (l * 2 + 1) * 1024, X, nullptr, mods + 5 * 6144, 0, H);
        else ln_phase(p.wave, X, X + (size_t)NLAT * DM, NLAT, p.post_ln_w + (l * 2 + 1) * 1024, p.post_ln_b + (l * 2 + 1) * 1024, nullptr, p.out, nullptr, 0, nullptr);
        break;
    }
}

__global__ void __launch_bounds__(512, 2) mega(Params p, int ph_lo, int ph_hi, int coop) {
    extern __shared__ __attribute__((aligned(16))) unsigned char shm[];
    unsigned* bar = (unsigned*)(p.ws + OFF_CTL);
    volatile LAS unsigned* st = (volatile LAS unsigned*)((LAS unsigned char*)shm + (LDS_BYTES - 16));
    if (threadIdx.x == 0) { st[0] = 0u; st[1] = 0u; }
    __syncthreads();
    const XcdBarrier xb = xcd_barrier_post(bar, st);
    Params q = p; q.wave = __builtin_amdgcn_readfirstlane((int)(threadIdx.x >> 6));
    for (int ph = ph_lo; ph < ph_hi; ++ph) {
        if (ph == 1 + PH_PER_LAYER) continue;
        run_phase(shm, q, ph);
#if PROBE_REP > 0
        if (ph == PROBE_PH || ph == PROBE_PH2) for (int rep = 0; rep < PROBE_REP; ++rep) { xcd_barrier(xb); run_phase(shm, q, ph); }
#endif
        if (coop && ph + 1 < ph_hi) {
            if (ph == 0) cg::this_grid().sync();
            else xcd_barrier(xb);
        }
    }
}

extern "C" void kernel_launch(void* const* d_in, const int* in_sizes, int n_in, void* d_out, int out_size, void* d_ws, size_t ws_size, hipStream_t stream) {
    static int grid = 0;
    if (grid == 0) {
        if (n_in != 26 || ws_size < WS_END) { fprintf(stderr, "kernel_launch: unexpected n_in %d / ws_size %zu (need %zu)\n", n_in, ws_size, (size_t)WS_END); grid = -1; return; }
        int dev = 0, cus = 0, per_cu = 0;
        hipGetDevice(&dev); hipDeviceGetAttribute(&cus, hipDeviceAttributeMultiprocessorCount, dev);
        if (hipFuncSetAttribute((const void*)mega, hipFuncAttributeMaxDynamicSharedMemorySize, LDS_BYTES) != hipSuccess) { fprintf(stderr, "kernel_launch: hipFuncSetAttribute failed\n"); grid = -1; return; }
        if (hipOccupancyMaxActiveBlocksPerMultiprocessor(&per_cu, (const void*)mega, 512, LDS_BYTES) != hipSuccess || per_cu < 1) { fprintf(stderr, "kernel_launch: occupancy query says %d\n", per_cu); per_cu = 1; }
        (void)hipGetLastError();
        grid = cus * 1;
    }
    if (grid < 0) return;
    Params p{};
    const float** pp = (const float**)&p;
    for (int i = 0; i < 26; ++i) pp[i] = (const float*)d_in[i];
    p.wave = 0; p.pad_ = 0;
    p.out = (float*)d_out; p.ws = (unsigned char*)d_ws;
#if MK_COOP
    hipMemsetAsync((char*)d_ws + OFF_CTL, 0, 16384, stream);
    int lo = 0, hi = N_PHASES, coop = 1;
    void* args[] = {&p, &lo, &hi, &coop};
    hipError_t e = hipLaunchCooperativeKernel((const void*)mega, dim3(grid), dim3(512), args, LDS_BYTES, stream);
    if (e != hipSuccess) fprintf(stderr, "cooperative launch failed: %s (grid %d)\n", hipGetErrorString(e), grid);
#else
    for (int ph = 0; ph < N_PHASES; ++ph) {
        if (ph == 1 + PH_PER_LAYER) continue;
        hipLaunchKernelGGL(mega, dim3(grid), dim3(512), LDS_BYTES, stream, p, ph, ph + 1, 0);
    }
#endif
}
```

```cpp
#include <hip/hip_runtime.h>
#include <hip/hip_cooperative_groups.h>
#include <cstdio>
#include <cstdint>
namespace cg = cooperative_groups;

#ifndef PROBE_REP
#define PROBE_REP 0
#define PROBE_PH -1
#define PROBE_PH2 -1
#endif
#ifndef MK_COOP
#define MK_COOP 1
#endif

#define DEVI __device__ __forceinline__
#define LAS __attribute__((address_space(3)))
typedef unsigned short bf16_t;
typedef short bf16x8 __attribute__((ext_vector_type(8)));
typedef float f32x4 __attribute__((ext_vector_type(4)));
typedef float f32x2 __attribute__((ext_vector_type(2)));
typedef unsigned u32x4 __attribute__((ext_vector_type(4)));
typedef unsigned u32x2 __attribute__((ext_vector_type(2)));

constexpr int DM = 1024, SEQ = 8192, CTXL = 256, NLAT = 32768, NCTX = 1024, ROWS = 33792;
constexpr int ZP = 2304;
constexpr int ZQ = 0, ZK = 128, ZV = 256, ZR = 512, ZLF = 768, ZB = 800, ZCU = 1056, ZCV = 1312, ZDA = 1568, ZDG = 1824;
constexpr int FH = 2816, UPITCH = 1280;
constexpr float ALPHA = 1.41421356237f, EPS = 1e-6f;
constexpr int LDS_BYTES = 160 * 1024;
constexpr int NCHUNK64 = 528;

constexpr size_t OFF_CTL = 0;
constexpr size_t OFF_MODS = 16384;
constexpr size_t OFF_SGUW = OFF_MODS + 2ull * 5 * 6144 * 4;
constexpr size_t OFF_POOLW = OFF_SGUW + 2ull * 4 * 128 * 128 * 2;
constexpr size_t OFF_WIN = OFF_POOLW + 2ull * 4 * 64 * 64 * 2;
constexpr size_t OFF_WOUT = OFF_WIN + 2ull * 2304 * 1024 * 2;
constexpr size_t OFF_WUP = OFF_WOUT + 2ull * 1024 * 1024 * 2;
constexpr size_t OFF_WDN = OFF_WUP + 2ull * 5632 * 1024 * 2;
constexpr size_t OFF_X = OFF_WDN + 2ull * 1024 * 2816 * 2;
constexpr size_t OFF_H = OFF_X + (size_t)ROWS * 1024 * 4;
constexpr size_t OFF_R1 = OFF_H + (size_t)ROWS * 1024 * 2;
constexpr size_t OFF_Z = OFF_R1;
constexpr size_t OFF_ST = OFF_Z + (size_t)ROWS * ZP * 2;
constexpr size_t OFF_DEC = OFF_ST + (size_t)NCHUNK64 * 8 * 2048 * 4;
constexpr size_t OFF_U = OFF_R1;
constexpr size_t OFF_ACT = OFF_U + (size_t)ROWS * UPITCH * 2;
constexpr size_t WS_END = OFF_ACT + (size_t)ROWS * FH * 2;
static_assert(WS_END <= 536870912ull, "workspace map exceeds the guaranteed 4 x largest-tensor size");
static_assert(OFF_DEC + (size_t)NCHUNK64 * 8 * 32 * 4 <= WS_END, "mixer scratch must fit");

struct Params {
    const float *x, *c, *ctx, *c_ctx, *w_mod, *b_mod, *w_in, *gla_w_gate, *gla_b_gate, *gla_norm_w, *pool_w, *pool_scale, *sgu_w, *sgu_b,
        *sgu_ln_w, *sgu_ln_b, *cm_conv_w, *cm_conv_b, *cm_ln_w, *cm_ln_b, *w_out, *ffn_w_up, *ffn_conv_w, *ffn_w_down, *post_ln_w, *post_ln_b;
    float* out; unsigned char* ws;
    int wave, pad_;
};

DEVI float bf2f(unsigned v) { return __uint_as_float(v << 16); }
DEVI float bflo(unsigned v) { return __uint_as_float(v << 16); }
DEVI float bfhi(unsigned v) { return __uint_as_float(v & 0xffff0000u); }
DEVI unsigned cvt_pk_bf16(float lo, float hi) { unsigned r; asm volatile("v_cvt_pk_bf16_f32 %0, %1, %2" : "=v"(r) : "v"(lo), "v"(hi)); return r; }
DEVI bf16_t f2bf(float f) { return (bf16_t)(cvt_pk_bf16(f, 0.f) & 0xffffu); }
DEVI int my_lane() { int t; asm volatile("v_mbcnt_lo_u32_b32 %0, -1, 0\n\tv_mbcnt_hi_u32_b32 %0, -1, %0" : "=v"(t)); return t; }
DEVI int my_tid_w(int wave) { return (wave << 6) | my_lane(); }
DEVI float shx(float v, int o, int lane) { return __int_as_float(__builtin_amdgcn_ds_bpermute((lane ^ o) << 2, __float_as_int(v))); }
DEVI float wsum(float v, int lane) {
#pragma unroll
    for (int o = 32; o; o >>= 1) v += shx(v, o, lane);
    return v; }
DEVI float sigmoidf_(float x) { return __builtin_amdgcn_rcpf(1.0f + __expf(-x)); }
DEVI float siluf_(float x) { return x * __builtin_amdgcn_rcpf(1.0f + __expf(-x)); }
DEVI float geluf_(float x) { const float u = 0.7978845608f * (x + 0.044715f * x * x * x); return x * __builtin_amdgcn_rcpf(1.0f + __expf(-2.0f * u)); }
DEVI float logsigf_(float x) { return fminf(x, 0.f) - __logf(1.0f + __expf(-fabsf(x))); }
#define MFMA16(a, b, c) __builtin_amdgcn_mfma_f32_16x16x32_bf16((a), (b), (c), 0, 0, 0)

namespace pg8 {
constexpr int BM = 256, BK = 64, HALF = 128, HTB = HALF * BK * 2, STAGE_BYTES = 8 * HTB, NXCD = 8, WGM = 8;
DEVI int lds_byte(int r, int c) { const int st = (r >> 4) * 2 + (c >> 5), rr = r & 15, cc = c & 31, ob = rr * 64 + cc * 2; return st * 1024 + (ob ^ (((ob >> 9) & 1) << 5)); }
DEVI void stage_rc(int b, int& R, int& C) { const int st = b / 1024, sb = b % 1024, swz = sb ^ (((sb >> 9) & 1) << 5); R = (st >> 1) * 16 + swz / 64; C = (st & 1) * 32 + (swz % 64) / 2; }
DEVI int perm32(int rho) { const int n = rho >> 4, i = rho & 15; return 8 * (i >> 2) + 4 * n + (i & 3); }
struct Unit { int pm, pn; };
struct Gemm { const bf16_t* A; const bf16_t* Bt; int M, N, K; };
struct StaticOrder {
    int nM, nN, nwg, G, c;
    DEVI void init(int M, int N, int G_, int c_) { nM = M / BM; nN = N / BM; nwg = nM * nN; G = G_; c = c_; }
    DEVI bool next(int i, Unit& u) const {
        const long L = (long)i * G + c; if (L >= nwg) return false;
        int wgid = (int)L; { const int q = nwg / NXCD, r = nwg % NXCD, xcd = wgid % NXCD, off = wgid / NXCD; wgid = (xcd < r ? xcd * (q + 1) : r * (q + 1) + (xcd - r) * q) + off; }
        const int nig = WGM * nN, gid = wgid / nig, fm = gid * WGM, gsz = (nM - fm) < WGM ? (nM - fm) : WGM;
        u.pm = fm + ((wgid % nig) % gsz); u.pn = (wgid % nig) / gsz; return true;
    }
    DEVI void a_ready(const Unit&) const {}
    DEVI void done(const Unit&) const {}
};

struct EpiBf16 {
    static constexpr bool PERM = true;
    bf16_t* O; int ldc;
    DEVI void operator()(const f32x4 (&acc)[2][2][4][2], const Unit& u, int wr, int wc, int, int) const {
        const int ln = my_lane(), fr = ln & 15, fq = ln >> 4;
        const int row0 = u.pm * BM + wr * 64 + fr; const int col0 = u.pn * BM + wc * 32 + 8 * fq;
#pragma unroll
        for (int ai = 0; ai < 2; ++ai)
#pragma unroll
            for (int m = 0; m < 4; ++m) { bf16_t* rowp = O + (size_t)(row0 + ai * HALF + m * 16) * ldc + col0;
#pragma unroll
                for (int bj = 0; bj < 2; ++bj) { const f32x4 v0 = acc[ai][bj][m][0], v1 = acc[ai][bj][m][1];
                    u32x4 w; w.x = cvt_pk_bf16(v0[0], v0[1]); w.y = cvt_pk_bf16(v0[2], v0[3]); w.z = cvt_pk_bf16(v1[0], v1[1]); w.w = cvt_pk_bf16(v1[2], v1[3]);
                    *(u32x4*)(rowp + bj * HALF) = w; } }
    }
};
struct EpiRes {
    static constexpr bool PERM = true;
    float* X; const float* srcL; const float* srcC; const float* mods; int goff; int mode;
    DEVI void operator()(const f32x4 (&acc)[2][2][4][2], const Unit& u, int wr, int wc, int, int) const {
        const int ln = my_lane(), fr = ln & 15, fq = ln >> 4;
        const int rowt = u.pm * BM; const int b = rowt < NLAT ? (rowt >> 13) : 4;
        float* dst = X + (size_t)rowt * DM;
        const float* src = (mode == 0) ? (rowt < NLAT ? srcL + (size_t)rowt * DM : srcC + (size_t)(rowt - NLAT) * DM) : dst;
        const float al = (mode == 0) ? ALPHA : 1.0f;
        const int rl = wr * 64 + fr;
        const int col0 = u.pn * BM + wc * 32 + 8 * fq;
        const float* gp = mods + b * 6144 + goff + col0;
        f32x4 gv[2][2];
#pragma unroll
        for (int bj = 0; bj < 2; ++bj)
#pragma unroll
            for (int n = 0; n < 2; ++n) gv[bj][n] = *(const f32x4*)(gp + bj * HALF + n * 4);
#pragma unroll
        for (int ai = 0; ai < 2; ++ai) {
            f32x4 xr[4][2][2];
#pragma unroll
            for (int m = 0; m < 4; ++m) { const size_t ro = (size_t)(rl + ai * HALF + m * 16) * DM + col0;
#pragma unroll
                for (int bj = 0; bj < 2; ++bj) { xr[m][bj][0] = *(const f32x4*)(src + ro + bj * HALF); xr[m][bj][1] = *(const f32x4*)(src + ro + bj * HALF + 4); } }
#pragma unroll
            for (int m = 0; m < 4; ++m) { const size_t ro = (size_t)(rl + ai * HALF + m * 16) * DM + col0;
#pragma unroll
                for (int bj = 0; bj < 2; ++bj) {
                    *(f32x4*)(dst + ro + bj * HALF) = al * xr[m][bj][0] + gv[bj][0] * acc[ai][bj][m][0];
                    *(f32x4*)(dst + ro + bj * HALF + 4) = al * xr[m][bj][1] + gv[bj][1] * acc[ai][bj][m][1]; } }
        }
    }
};

template <class Epi, class Sched>
DEVI void gemm_phase(LAS unsigned char* lds, const Gemm g, const Sched& S, const Epi& E, int wave) {
    const int tid = my_tid_w(wave), wid = __builtin_amdgcn_readfirstlane(tid >> 6), lane = tid & 63, wr = wid >> 2, wc = wid & 3, fr = lane & 15, fq = lane >> 4;
    const int K = g.K, nt = K / BK;
    unsigned voffA[2], voffB[2];
#pragma unroll
    for (int i = 0; i < 2; ++i) { int R, C; stage_rc(tid * 16 + i * 8192, R, C); const int Rb = Epi::PERM ? ((R & ~31) + perm32(R & 31)) : R;
        voffA[i] = (unsigned)(R * K + C) * 2u; voffB[i] = (unsigned)(Rb * K + C) * 2u; }
    const size_t kstep = (size_t)(BK * 2);
    const size_t hstep = (size_t)HALF * K * 2;
    const size_t tstep = 2 * hstep;
    const unsigned ldsw = (unsigned)wid * 1024u;
    const int aoff = lds_byte(wr * 64 + fr, fq * 8), boff = lds_byte(wc * 32 + fr, fq * 8);
#define PG8_SA(b, h) (((b) * 2 + (h)) * HTB)
#define PG8_SB(b, h) ((4 + (b) * 2 + (h)) * HTB)
#define PG8_STAGE(bufoff, gbase, voff) do { _Pragma("unroll") for (int _i = 0; _i < 2; ++_i) \
        __builtin_amdgcn_global_load_lds((const unsigned*)((const char*)(gbase) + (voff)[_i]), (LAS unsigned*)(lds + (bufoff) + ldsw + _i * 8192), 16, 0, 0); } while (0)
#define PG8_LDA(dst, b, h) do { _Pragma("unroll") for (int m = 0; m < 4; ++m) _Pragma("unroll") for (int k = 0; k < 2; ++k) dst[m][k] = *(const LAS bf16x8*)(lds + PG8_SA(b, h) + aoff + m * 2048 + k * 1024); } while (0)
#define PG8_LDB(dst, b, h) do { _Pragma("unroll") for (int n = 0; n < 2; ++n) _Pragma("unroll") for (int k = 0; k < 2; ++k) dst[n][k] = *(const LAS bf16x8*)(lds + PG8_SB(b, h) + boff + n * 2048 + k * 1024); } while (0)
#define PG8_MMA(ai, bj, At, Bt) do { __builtin_amdgcn_s_setprio(1); _Pragma("unroll") for (int m = 0; m < 4; ++m) _Pragma("unroll") for (int n = 0; n < 2; ++n) _Pragma("unroll") for (int k = 0; k < 2; ++k) \
        acc[ai][bj][m][n] = __builtin_amdgcn_mfma_f32_16x16x32_bf16(Bt[n][k], At[m][k], acc[ai][bj][m][n], 0, 0, 0); __builtin_amdgcn_s_setprio(0); } while (0)
#define PG8_WAIT_V(n) asm volatile("s_waitcnt vmcnt(" #n ")" ::: "memory")
#define PG8_WAIT_L(n) asm volatile("s_waitcnt lgkmcnt(" #n ")" ::: "memory")
#define PG8_BAR __builtin_amdgcn_s_barrier()
#define PG8_SCHED __builtin_amdgcn_sched_barrier(0)
    Unit cur, nxt; int ui = 0;
    if (!S.next(0, cur)) return;
    f32x4 acc[2][2][4][2];
#pragma unroll
    for (int a = 0; a < 2; ++a)
#pragma unroll
        for (int b = 0; b < 2; ++b)
#pragma unroll
            for (int m = 0; m < 4; ++m)
#pragma unroll
                for (int n = 0; n < 2; ++n) acc[a][b][m][n] = (f32x4){0.f, 0.f, 0.f, 0.f};
    bf16x8 At[4][2], B0[2][2], B1[2][2];
    const char* cA = (const char*)g.A + (size_t)cur.pm * tstep; const char* cB = (const char*)g.Bt + (size_t)cur.pn * tstep;
    S.a_ready(cur);
    PG8_STAGE(PG8_SB(0, 0), cB, voffB); PG8_STAGE(PG8_SA(0, 0), cA, voffA); PG8_STAGE(PG8_SB(0, 1), cB + hstep, voffB); PG8_STAGE(PG8_SA(0, 1), cA + hstep, voffA);
    if (wr == 1) PG8_BAR;
    PG8_WAIT_V(4); PG8_BAR;
    PG8_STAGE(PG8_SB(1, 0), cB + kstep, voffB); PG8_STAGE(PG8_SA(1, 0), cA + kstep, voffA); PG8_STAGE(PG8_SB(1, 1), cB + hstep + kstep, voffB);
    PG8_WAIT_V(6); PG8_BAR;
    for (;;) {
        const bool has_next = S.next(ui + 1, nxt);
        const char* nA = has_next ? (const char*)g.A + (size_t)nxt.pm * tstep : cA; const char* nB = has_next ? (const char*)g.Bt + (size_t)nxt.pn * tstep : cB;
        for (int t = 0; t < nt; t += 2) {
            const bool last = (t == nt - 2);
            const char* a1 = cA + (size_t)(t + 1) * kstep;
            const char* a2 = last ? nA : cA + (size_t)(t + 2) * kstep; const char* b2 = last ? nB : cB + (size_t)(t + 2) * kstep;
            const char* a3 = a2 + kstep; const char* b3 = b2 + kstep;
            if (last && has_next) S.a_ready(nxt);
            PG8_LDB(B0, 0, 0); PG8_SCHED; PG8_LDA(At, 0, 0); PG8_STAGE(PG8_SA(1, 1), a1 + hstep, voffA);
            PG8_WAIT_L(8); PG8_BAR; PG8_WAIT_L(0); PG8_MMA(0, 0, At, B0); PG8_BAR; PG8_SCHED;
            PG8_LDB(B1, 0, 1); PG8_STAGE(PG8_SB(0, 0), b2, voffB);
            PG8_BAR; PG8_WAIT_L(0); PG8_MMA(0, 1, At, B1); PG8_BAR;
            PG8_LDA(At, 0, 1); PG8_STAGE(PG8_SA(0, 0), a2, voffA);
            PG8_BAR; PG8_WAIT_L(0); PG8_MMA(1, 0, At, B0); PG8_BAR; PG8_SCHED;
            PG8_STAGE(PG8_SB(0, 1), b2 + hstep, voffB);
            PG8_WAIT_V(6); PG8_BAR; PG8_MMA(1, 1, At, B1); PG8_BAR;
            PG8_LDB(B0, 1, 0); PG8_SCHED; PG8_LDA(At, 1, 0); PG8_STAGE(PG8_SA(0, 1), a2 + hstep, voffA);
            PG8_WAIT_L(8); PG8_BAR; PG8_WAIT_L(0); PG8_MMA(0, 0, At, B0); PG8_BAR; PG8_SCHED;
            PG8_LDB(B1, 1, 1); PG8_STAGE(PG8_SB(1, 0), b3, voffB);
            PG8_BAR; PG8_WAIT_L(0); PG8_MMA(0, 1, At, B1); PG8_BAR;
            PG8_LDA(At, 1, 1); PG8_STAGE(PG8_SA(1, 0), a3, voffA);
            PG8_BAR; PG8_WAIT_L(0); PG8_MMA(1, 0, At, B0); PG8_BAR; PG8_SCHED;
            PG8_STAGE(PG8_SB(1, 1), b3 + hstep, voffB);
            PG8_WAIT_V(6); PG8_BAR; PG8_MMA(1, 1, At, B1); PG8_BAR;
        }
        E(acc, cur, wr, wc, fr, fq); S.done(cur);
        if (!has_next) break;
#pragma unroll
        for (int a = 0; a < 2; ++a)
#pragma unroll
            for (int b = 0; b < 2; ++b)
#pragma unroll
                for (int m = 0; m < 4; ++m)
#pragma unroll
                    for (int n = 0; n < 2; ++n) acc[a][b][m][n] = (f32x4){0.f, 0.f, 0.f, 0.f};
        cur = nxt; cA = nA; cB = nB; ++ui;
    }
    PG8_WAIT_V(0);
    if (wr == 0) PG8_BAR;
    PG8_BAR;
#undef PG8_SA
#undef PG8_SB
#undef PG8_STAGE
#undef PG8_LDA
#undef PG8_LDB
#undef PG8_MMA
#undef PG8_WAIT_V
#undef PG8_WAIT_L
#undef PG8_BAR
#undef PG8_SCHED
}
}

DEVI void transpose_tile(int wave, float* tile, const float* src, int ld_src, int k0, int n0s, int nvalid, bf16_t* dst, int ld_dst, int n0d, int k0d) {
    const int tid = my_tid_w(wave);
    { const int nn = tid & 63; const int col = n0s + nn; const bool ok = col < nvalid; const int colc = ok ? col : 0;
        float v[8];
#pragma unroll
        for (int i = 0; i < 8; ++i) v[i] = src[(size_t)(k0 + i * 8 + (tid >> 6)) * ld_src + colc];
#pragma unroll
        for (int i = 0; i < 8; ++i) tile[(i * 8 + (tid >> 6)) * 65 + nn] = ok ? v[i] : 0.f; }
    __syncthreads();
#pragma unroll
    for (int i = 0; i < 8; ++i) { const int nn = i * 8 + (tid >> 6), kk = tid & 63; dst[(size_t)(n0d + nn) * ld_dst + k0d + kk] = f2bf(tile[kk * 65 + nn]); }
    __syncthreads();
}

DEVI void mods_item(float* lf, const Params& p, int item) {
    const int tid = my_tid_w(p.wave); const int l = item / 96, cgp = item % 96;
    float* s = lf;
    float* red = lf + 5120;
    for (int i = tid; i < 5120; i += 512) { const int r = i >> 10, k = i & 1023; const float v = (r < 4) ? p.c[r * 1024 + k] : p.c_ctx[k]; s[i] = siluf_(v); }
    __syncthreads();
    const int cc = tid & 63, kg = tid >> 6; const int col = cgp * 64 + cc;
    const float* W = p.w_mod + (size_t)l * 1024 * 6144 + col;
    float a0 = 0.f, a1 = 0.f, a2 = 0.f, a3 = 0.f, a4 = 0.f;
#pragma unroll 8
    for (int k = kg * 128; k < kg * 128 + 128; ++k) { const float w = W[(size_t)k * 6144];
        a0 += s[k] * w; a1 += s[1024 + k] * w; a2 += s[2048 + k] * w; a3 += s[3072 + k] * w; a4 += s[4096 + k] * w; }
    red[(kg * 5 + 0) * 64 + cc] = a0; red[(kg * 5 + 1) * 64 + cc] = a1; red[(kg * 5 + 2) * 64 + cc] = a2; red[(kg * 5 + 3) * 64 + cc] = a3; red[(kg * 5 + 4) * 64 + cc] = a4;
    __syncthreads();
    if (tid < 320) { const int r = tid >> 6, c2 = tid & 63; float sum = p.b_mod[l * 6144 + cgp * 64 + c2];
#pragma unroll
        for (int q = 0; q < 8; ++q) sum += red[(q * 5 + r) * 64 + c2];
        ((float*)(p.ws + OFF_MODS))[(l * 5 + r) * 6144 + cgp * 64 + c2] = sum; }
    __syncthreads();
}

__constant__ int c_cu0[5] = {0, 5, 10, 14, 18};
__constant__ int c_cnu[5] = {5, 5, 4, 4, 4};

DEVI void prep_phase(unsigned char* lds, const Params& p) {
    float* lf = (float*)lds;
    const int T_IN = 16 * 36, T_OUT = 256, T_UP = 16 * 88, T_DN = 44 * 16, T_L = T_IN + T_OUT + T_UP + T_DN;
    const int N_MODS = 192, N_TR = 2 * T_L, N_SGU = 32, N_POOL = 8;
    const int total = N_MODS + N_TR + N_SGU + N_POOL;
    for (int item = blockIdx.x; item < total; item += gridDim.x) {
        if (item < N_MODS) { mods_item(lf, p, item); continue; }
        int it = item - N_MODS;
        if (it < N_TR) {
            const int l = it / T_L; int r = it % T_L;
            if (r < T_IN) { const int kt = r / 36, ntl = r % 36;
                transpose_tile(p.wave, lf, p.w_in + (size_t)l * 1024 * 2080, 2080, kt * 64, ntl * 64, 2080, (bf16_t*)(p.ws + OFF_WIN) + (size_t)l * 2304 * 1024, 1024, ntl * 64, kt * 64); continue; }
            r -= T_IN;
            if (r < T_OUT) { const int kt = r / 16, ntl = r % 16;
                transpose_tile(p.wave, lf, p.w_out + (size_t)l * 1024 * 1024, 1024, kt * 64, ntl * 64, 1024, (bf16_t*)(p.ws + OFF_WOUT) + (size_t)l * 1024 * 1024, 1024, ntl * 64, kt * 64); continue; }
            r -= T_OUT;
            if (r < T_UP) { const int kt = r / 88, ntl = r % 88; const int n0d = ntl * 64; const int unit = n0d >> 8, sgn = (n0d >> 7) & 1, j0 = n0d & 127;
                transpose_tile(p.wave, lf, p.ffn_w_up + (size_t)l * 1024 * 5632, 5632, kt * 64, sgn * FH + unit * 128 + j0, 5632, (bf16_t*)(p.ws + OFF_WUP) + (size_t)l * 5632 * 1024, 1024, n0d, kt * 64); continue; }
            r -= T_UP;
            { const int kt = r / 16, ntl = r % 16;
                transpose_tile(p.wave, lf, p.ffn_w_down + (size_t)l * FH * 1024, 1024, kt * 64, ntl * 64, 1024, (bf16_t*)(p.ws + OFF_WDN) + (size_t)l * 1024 * FH, FH, ntl * 64, kt * 64); continue; }
        }
        it -= N_TR;
        if (it < N_SGU) { bf16_t* d = (bf16_t*)(p.ws + OFF_SGUW); const int base = it * 4096;
            const int t0 = my_tid_w(p.wave); float v[8];
#pragma unroll
            for (int i = 0; i < 8; ++i) v[i] = p.sgu_w[base + i * 512 + t0];
#pragma unroll
            for (int i = 0; i < 8; ++i) d[base + i * 512 + t0] = f2bf(v[i]);
            continue; }
        it -= N_SGU;
        { transpose_tile(p.wave, lf, p.pool_w + (size_t)it * 4096, 64, 0, 0, 64, (bf16_t*)(p.ws + OFF_POOLW) + (size_t)it * 4096, 64, 0, 0); }
    }
}

DEVI void ln_phase(int wave, const float* srcL, const float* srcC, int nrows, const float* lnw, const float* lnb, float* dstX, float* dstOut, const float* mods, int soff, bf16_t* H) {
    const int lane = my_lane(); int wid = wave; asm volatile("" : "+s"(wid));
    const int rstep = gridDim.x * 8;
    int r = blockIdx.x * 8 + wid;
    f32x4 vn[4];
    if (r < nrows) { const float* src = r < NLAT ? srcL + (size_t)r * DM : srcC + (size_t)(r - NLAT) * DM;
#pragma unroll
        for (int i = 0; i < 4; ++i) vn[i] = *(const f32x4*)(src + i * 256 + lane * 4); }
    for (; r < nrows; r += rstep) {
        f32x4 v[4];
#pragma unroll
        for (int i = 0; i < 4; ++i) v[i] = vn[i];
        { const int rn = r + rstep; if (rn < nrows) { const float* src = rn < NLAT ? srcL + (size_t)rn * DM : srcC + (size_t)(rn - NLAT) * DM;
#pragma unroll
            for (int i = 0; i < 4; ++i) vn[i] = *(const f32x4*)(src + i * 256 + lane * 4); } }
        float s = 0.f;
#pragma unroll
        for (int i = 0; i < 4; ++i) s += v[i][0] + v[i][1] + v[i][2] + v[i][3];
        float mean = wsum(s, lane) * (1.0f / 1024.0f);
        float q = 0.f;
#pragma unroll
        for (int i = 0; i < 4; ++i) { v[i] -= mean; q += v[i][0] * v[i][0] + v[i][1] * v[i][1] + v[i][2] * v[i][2] + v[i][3] * v[i][3]; }
        float rstd = rsqrtf(wsum(q, lane) * (1.0f / 1024.0f) + EPS);
        if (lnw) {
#pragma unroll
            for (int i = 0; i < 4; ++i) { const f32x4 w = *(const f32x4*)(lnw + i * 256 + lane * 4), b = *(const f32x4*)(lnb + i * 256 + lane * 4); v[i] = v[i] * rstd * w + b; }
            if (dstX) {
#pragma unroll
                for (int i = 0; i < 4; ++i) *(f32x4*)(dstX + (size_t)r * DM + i * 256 + lane * 4) = v[i]; }
            if (dstOut && r < NLAT) {
#pragma unroll
                for (int i = 0; i < 4; ++i) *(f32x4*)(dstOut + (size_t)r * DM + i * 256 + lane * 4) = v[i]; }
            if (mods) {
                s = 0.f;
#pragma unroll
                for (int i = 0; i < 4; ++i) s += v[i][0] + v[i][1] + v[i][2] + v[i][3];
                mean = wsum(s, lane) * (1.0f / 1024.0f); q = 0.f;
#pragma unroll
                for (int i = 0; i < 4; ++i) { v[i] -= mean; q += v[i][0] * v[i][0] + v[i][1] * v[i][1] + v[i][2] * v[i][2] + v[i][3] * v[i][3]; }
                rstd = rsqrtf(wsum(q, lane) * (1.0f / 1024.0f) + EPS);
            }
        }
        if (mods) {
            const int b = r < NLAT ? (r >> 13) : 4; const float* mp = mods + b * 6144 + soff;
#pragma unroll
            for (int i = 0; i < 4; ++i) { const f32x4 sh = *(const f32x4*)(mp + i * 256 + lane * 4), sc = *(const f32x4*)(mp + 1024 + i * 256 + lane * 4);
                const f32x4 h = v[i] * rstd * (1.0f + sc) + sh;
                u32x2 w; w.x = cvt_pk_bf16(h[0], h[1]); w.y = cvt_pk_bf16(h[2], h[3]);
                *(u32x2*)(H + (size_t)r * DM + i * 256 + lane * 4) = w; }
        }
    }
}

struct Tile { int row0, T0, L; };
DEVI Tile tile_of(int t, int tl) {
    const int nlat = NLAT / tl; Tile r;
    if (t < nlat) { r.row0 = t * tl; r.T0 = r.row0 & (SEQ - 1); r.L = SEQ; }
    else { const int q = (t - nlat) * tl; r.row0 = NLAT + q; r.T0 = q & (CTXL - 1); r.L = CTXL; }
    return r;
}

DEVI void pool_item(unsigned char* lds, const Params& p, int l, const Tile tl) {
    const int tid = my_tid_w(p.wave), wid = tid >> 6, lane = tid & 63, fr = lane & 15, fq = lane >> 4;
    bf16_t* zs = (bf16_t*)lds;
    bf16_t* ys = (bf16_t*)(lds + 80 * 256 * 2);
    const bf16_t* z = (const bf16_t*)(p.ws + OFF_Z);
    bf16_t* ycat = (bf16_t*)(p.ws + OFF_H);
    const int pg = wid >> 1; const bf16_t* Wt = (const bf16_t*)(p.ws + OFF_POOLW) + (size_t)(l * 4 + pg) * 4096;
    bf16x8 bw[4][2]; f32x4 psc[4];
#pragma unroll
    for (int nt = 0; nt < 4; ++nt) { bw[nt][0] = *(const bf16x8*)(Wt + (nt * 16 + fr) * 64 + fq * 8); bw[nt][1] = *(const bf16x8*)(Wt + (nt * 16 + fr) * 64 + 32 + fq * 8);
        psc[nt] = *(const f32x4*)(p.pool_scale + l * 256 + pg * 64 + nt * 16 + 4 * fq); }
    { u32x4 zv[5];
#pragma unroll
        for (int k = 0; k < 5; ++k) { const int i = tid + k * 512; const int r = i >> 5, c8 = i & 31; const int T = tl.T0 - 8 + r; const bool ok = T >= 0 && T < tl.L;
            zv[k] = *(const u32x4*)(z + (size_t)(ok ? tl.row0 - 8 + r : tl.row0) * ZP + ZB + c8 * 8); }
#pragma unroll
        for (int k = 0; k < 5; ++k) { const int i = tid + k * 512; const int r = i >> 5, c8 = i & 31; const int T = tl.T0 - 8 + r; const bool ok = T >= 0 && T < tl.L;
            *(u32x4*)(zs + r * 256 + c8 * 8) = ok ? zv[k] : (u32x4){0u, 0u, 0u, 0u}; } }
    __syncthreads();
    {
        const int g = wid & 3, hw = 1 << g; const int ch = g * 64 + (lane & 31) * 2; const int t0 = ((wid >> 2) * 2 + (lane >> 5)) * 16;
        unsigned rv[32];
#pragma unroll
        for (int i = 0; i < 32; ++i) rv[i] = *(const unsigned*)(zs + (t0 + i) * 256 + ch);
#pragma unroll
        for (int tt = 0; tt < 16; ++tt) { const int T = tl.T0 + t0 + tt; const int lo = max(T - hw, 0), hi = min(T + hw, tl.L);
            float s0 = 0.f, s1 = 0.f;
#pragma unroll
            for (int q = 0; q < 16; ++q) { const bool in = (q >= 8 - hw) && (q < 8 + hw); s0 += in ? bflo(rv[tt + q]) : 0.f; s1 += in ? bfhi(rv[tt + q]) : 0.f; }
            const float inv = __builtin_amdgcn_rcpf((float)(hi - lo)); const unsigned xv = rv[tt + 8];
            *(unsigned*)(ys + (t0 + tt) * 264 + ch) = cvt_pk_bf16(s0 * inv - bflo(xv), s1 * inv - bfhi(xv)); } }
    __syncthreads();
    { const int g = pg;
#pragma unroll
        for (int mi = 0; mi < 2; ++mi) { const int mt = (wid & 1) * 2 + mi; const int t = mt * 16 + fr;
            const bf16x8 a0 = *(const bf16x8*)(ys + t * 264 + g * 64 + fq * 8), a1 = *(const bf16x8*)(ys + t * 264 + g * 64 + 32 + fq * 8);
#pragma unroll
            for (int nt = 0; nt < 4; ++nt) {
                f32x4 acc = (f32x4){0.f, 0.f, 0.f, 0.f}; acc = MFMA16(bw[nt][0], a0, acc); acc = MFMA16(bw[nt][1], a1, acc);
                const int col = g * 64 + nt * 16 + 4 * fq; acc *= psc[nt];
                u32x2 w; w.x = cvt_pk_bf16(acc[0], acc[1]); w.y = cvt_pk_bf16(acc[2], acc[3]);
                *(u32x2*)(ycat + (size_t)(tl.row0 + t) * DM + 256 + col) = w; } } }
    __syncthreads();
}

DEVI void sgu_item(unsigned char* lds, const Params& p, int l, const Tile tl) {
    const int tid = my_tid_w(p.wave), wid = tid >> 6, lane = tid & 63, fr = lane & 15, fq = lane >> 4;
    bf16_t* vT = (bf16_t*)lds;
    const bf16_t* z = (const bf16_t*)(p.ws + OFF_Z);
    bf16_t* ycat = (bf16_t*)(p.ws + OFF_H);
    const int h = wid >> 1; const bf16_t* W = (const bf16_t*)(p.ws + OFF_SGUW) + (size_t)(l * 4 + h) * 16384;
    bf16x8 af[4][4]; float bias[4];
#pragma unroll
    for (int mi = 0; mi < 4; ++mi) { const int t = ((wid & 1) * 4 + mi) * 16 + fr; bias[mi] = p.sgu_b[(l * 4 + h) * 128 + t];
#pragma unroll
        for (int ks = 0; ks < 4; ++ks) af[mi][ks] = *(const bf16x8*)(W + t * 128 + ks * 32 + fq * 8); }
    { const f32x4 lw = *(const f32x4*)(p.sgu_ln_w + l * 256 + lane * 4), lb = *(const f32x4*)(p.sgu_ln_b + l * 256 + lane * 4);
#pragma unroll 1
        for (int hb = 0; hb < 2; ++hb) {
        u32x2 vraw[8];
#pragma unroll
        for (int i = 0; i < 8; ++i) vraw[i] = *(const u32x2*)(z + (size_t)(tl.row0 + wid * 16 + hb * 8 + i) * ZP + ZCV + lane * 4);
        f32x4 vo[8];
#pragma unroll
        for (int i = 0; i < 8; ++i) { const u32x2 raw = vraw[i];
            f32x4 v; v[0] = geluf_(bflo(raw.x)); v[1] = geluf_(bfhi(raw.x)); v[2] = geluf_(bflo(raw.y)); v[3] = geluf_(bfhi(raw.y));
            const float mean = wsum(v[0] + v[1] + v[2] + v[3], lane) * (1.0f / 256.0f); v -= mean;
            const float rstd = rsqrtf(wsum(v[0] * v[0] + v[1] * v[1] + v[2] * v[2] + v[3] * v[3], lane) * (1.0f / 256.0f) + EPS);
            vo[i] = v * rstd * lw + lb; }
#pragma unroll
        for (int j = 0; j < 4; ++j) { u32x4 w; w.x = cvt_pk_bf16(vo[0][j], vo[1][j]); w.y = cvt_pk_bf16(vo[2][j], vo[3][j]); w.z = cvt_pk_bf16(vo[4][j], vo[5][j]); w.w = cvt_pk_bf16(vo[6][j], vo[7][j]);
            *(u32x4*)(vT + (lane * 4 + j) * 136 + wid * 16 + hb * 8) = w; } } }
    __syncthreads();
    {
#pragma unroll
        for (int mi = 0; mi < 4; ++mi) { const int mt = (wid & 1) * 4 + mi; const int t = mt * 16 + fr;
            u32x2 uraw[4];
#pragma unroll
            for (int nt = 0; nt < 4; ++nt) uraw[nt] = *(const u32x2*)(z + (size_t)(tl.row0 + t) * ZP + ZCU + h * 64 + nt * 16 + 4 * fq);
#pragma unroll
            for (int nt = 0; nt < 4; ++nt) { f32x4 acc = (f32x4){0.f, 0.f, 0.f, 0.f};
#pragma unroll
                for (int ks = 0; ks < 4; ++ks) { const bf16x8 b = *(const bf16x8*)(vT + (h * 64 + nt * 16 + fr) * 136 + ks * 32 + fq * 8); acc = MFMA16(b, af[mi][ks], acc); }
                const int col = h * 64 + nt * 16 + 4 * fq; const u32x2 raw = uraw[nt]; const float bs = bias[mi];
                const float o0 = geluf_(bflo(raw.x)) * (acc[0] + bs), o1 = geluf_(bfhi(raw.x)) * (acc[1] + bs), o2 = geluf_(bflo(raw.y)) * (acc[2] + bs), o3 = geluf_(bfhi(raw.y)) * (acc[3] + bs);
                u32x2 w; w.x = cvt_pk_bf16(o0, o1); w.y = cvt_pk_bf16(o2, o3);
                *(u32x2*)(ycat + (size_t)(tl.row0 + t) * DM + 512 + col) = w; } } }
    __syncthreads();
}

DEVI void cm_item(unsigned char* lds, const Params& p, int l, const Tile tl) {
    const int tid = my_tid_w(p.wave), wid = tid >> 6, lane = tid & 63;
    float* yg = (float*)lds;
    const bf16_t* z = (const bf16_t*)(p.ws + OFF_Z);
    bf16_t* ycat = (bf16_t*)(p.ws + OFF_H);
    const int c = tid & 255, th = tid >> 8;
    float w[31];
#pragma unroll
    for (int j = 0; j < 31; ++j) w[j] = p.cm_conv_w[(l * 31 + j) * 256 + c];
    const float cb = p.cm_conv_b[l * 256 + c];
    const f32x4 lw = *(const f32x4*)(p.cm_ln_w + l * 256 + lane * 4), lb = *(const f32x4*)(p.cm_ln_b + l * 256 + lane * 4);
    { u32x2 av[12], gv[12];
#pragma unroll
        for (int k = 0; k < 12; ++k) { const int i = tid + k * 512; const int r = min(i >> 6, 93), c4 = (i & 63) * 4; const int T = tl.T0 - 15 + r; const bool ok = T >= 0 && T < tl.L;
            const bf16_t* zp = z + (size_t)(ok ? tl.row0 - 15 + r : tl.row0) * ZP; av[k] = *(const u32x2*)(zp + ZDA + c4); gv[k] = *(const u32x2*)(zp + ZDG + c4); }
#pragma unroll
        for (int k = 0; k < 12; ++k) { const int i = tid + k * 512; const int r = i >> 6, c4 = (i & 63) * 4; const int T = tl.T0 - 15 + r; const bool ok = T >= 0 && T < tl.L;
            if (i < 94 * 64) { f32x4 o = (f32x4){0.f, 0.f, 0.f, 0.f};
                if (ok) { const u32x2 a = av[k], g = gv[k];
                    o[0] = bflo(a.x) * sigmoidf_(bflo(g.x)); o[1] = bfhi(a.x) * sigmoidf_(bfhi(g.x)); o[2] = bflo(a.y) * sigmoidf_(bflo(g.y)); o[3] = bfhi(a.y) * sigmoidf_(bfhi(g.y)); }
                *(f32x4*)(yg + r * 256 + c4) = o; } } }
    __syncthreads();
    float* yo = (float*)(lds + 94 * 256 * 4);
    {
#pragma unroll 1
        for (int bt = 0; bt < 8; ++bt) { float in[34];
#pragma unroll
            for (int i = 0; i < 34; ++i) in[i] = yg[(th * 32 + bt * 4 + i) * 256 + c];
            float s0 = cb, s1 = cb, s2 = cb, s3 = cb;
#pragma unroll
            for (int j = 0; j < 31; ++j) { s0 += in[j] * w[j]; s1 += in[j + 1] * w[j]; s2 += in[j + 2] * w[j]; s3 += in[j + 3] * w[j]; }
            float* op = yo + (th * 32 + bt * 4) * 256 + c; op[0] = s0; op[256] = s1; op[512] = s2; op[768] = s3; } }
    __syncthreads();
    {
#pragma unroll
        for (int i = 0; i < 8; ++i) { const int t = wid * 8 + i; f32x4 v = *(const f32x4*)(yo + t * 256 + lane * 4);
            const float mean = wsum(v[0] + v[1] + v[2] + v[3], lane) * (1.0f / 256.0f); v -= mean;
            const float rstd = rsqrtf(wsum(v[0] * v[0] + v[1] * v[1] + v[2] * v[2] + v[3] * v[3], lane) * (1.0f / 256.0f) + EPS);
            v = v * rstd * lw + lb;
            u32x2 w; w.x = cvt_pk_bf16(siluf_(v[0]), siluf_(v[1])); w.y = cvt_pk_bf16(siluf_(v[2]), siluf_(v[3]));
            *(u32x2*)(ycat + (size_t)(tl.row0 + t) * DM + 768 + lane * 4) = w; } }
    __syncthreads();
}

constexpr int GL_G = 0, GL_WG = 32768, GL_BG = 40960, GL_LOW = 41472, GL_VT = 49664, GL_QIN = 86528, GL_KIN = 103936, GL_STT = 121344, GL_KD = 86528, GL_WG1 = 141824, GL_BG1 = 150016;

DEVI void gla_load_common(int wave, unsigned char* lds, const bf16_t* z, const Tile tl, const float* wgate, const float* bgate) {
    const int tid = my_tid_w(wave);
    float* low = (float*)(lds + GL_LOW); bf16_t* vT = (bf16_t*)(lds + GL_VT);
    const f32x4 wg0 = *(const f32x4*)(wgate + tid * 4), wg1 = *(const f32x4*)(wgate + 2048 + tid * 4);
    const float bg0 = bgate[tid & 127], bg1 = bgate[128 + (tid & 127)];
    const u32x4 lowv = *(const u32x4*)(z + (size_t)(tl.row0 + ((tid & 255) >> 2)) * ZP + ZLF + (tid & 3) * 8);
    const int ch = tid & 255, tb = tid >> 8;
    unsigned e[4][8];
#pragma unroll
    for (int tg = 0; tg < 4; ++tg) { const bf16_t* zp = z + (size_t)(tl.row0 + (tb * 4 + tg) * 8) * ZP + ZV + ch;
#pragma unroll
        for (int j = 0; j < 8; ++j) e[tg][j] = zp[(size_t)j * ZP]; }
#pragma unroll
    for (int tg = 0; tg < 4; ++tg)
#pragma unroll
        for (int j = 0; j < 8; ++j) asm volatile("" : "+v"(e[tg][j]));
    *(f32x4*)((float*)(lds + GL_WG) + tid * 4) = wg0;
    *(f32x4*)((float*)(lds + GL_WG1) + tid * 4) = wg1;
    if (tid < 128) { ((float*)(lds + GL_BG))[tid] = bg0; ((float*)(lds + GL_BG1))[tid] = bg1; }
    if (tid < 256) { const int t = tid >> 2, part = tid & 3; float* d = low + t * 32 + part * 8;
        d[0] = bflo(lowv.x); d[1] = bfhi(lowv.x); d[2] = bflo(lowv.y); d[3] = bfhi(lowv.y); d[4] = bflo(lowv.z); d[5] = bfhi(lowv.z); d[6] = bflo(lowv.w); d[7] = bfhi(lowv.w); }
#pragma unroll
    for (int tg = 0; tg < 4; ++tg) { u32x4 w; w.x = e[tg][0] | (e[tg][1] << 16); w.y = e[tg][2] | (e[tg][3] << 16); w.z = e[tg][4] | (e[tg][5] << 16); w.w = e[tg][6] | (e[tg][7] << 16);
        *(u32x4*)(vT + ch * 72 + (tb * 4 + tg) * 8) = w; }
}
DEVI void gla_gates(unsigned char* lds, const Params& p, int l, int dir) {
    const int tid = my_tid_w(p.wave);
    float* G = (float*)(lds + GL_G); float* WG = (float*)(lds + (dir ? GL_WG1 : GL_WG)); const float* BG = (const float*)(lds + (dir ? GL_BG1 : GL_BG)); const float* low = (const float*)(lds + GL_LOW);
    __syncthreads();
    { const int t = tid >> 3, cgp = tid & 7; f32x4 lv[4];
#pragma unroll
        for (int r4 = 0; r4 < 4; ++r4) lv[r4] = *(const f32x4*)(low + t * 32 + dir * 16 + r4 * 4);
        f32x4 a[4];
#pragma unroll
        for (int j4 = 0; j4 < 4; ++j4) a[j4] = *(const f32x4*)(BG + cgp * 16 + j4 * 4);
#pragma unroll
        for (int r = 0; r < 16; ++r) { const float lr = lv[r >> 2][r & 3];
#pragma unroll
            for (int j4 = 0; j4 < 4; ++j4) a[j4] += lr * *(const f32x4*)(WG + r * 128 + cgp * 16 + j4 * 4); }
#pragma unroll
        for (int j4 = 0; j4 < 4; ++j4) { f32x4 g;
#pragma unroll
            for (int e = 0; e < 4; ++e) g[e] = fmaxf(logsigf_(a[j4][e]) * (1.0f / 16.0f), -1.0f);
            *(f32x4*)(G + t * 128 + cgp * 16 + j4 * 4) = g; } }
    __syncthreads();
    {
        const int col = tid & 127, seg = tid >> 7; float loc[16]; float run = 0.f;
#pragma unroll
        for (int i = 0; i < 16; ++i) { const int t = dir ? (seg * 16 + 15 - i) : (seg * 16 + i); run += G[t * 128 + col]; loc[i] = run; }
        WG[seg * 128 + col] = run;
        __syncthreads();
        float off = 0.f;
#pragma unroll
        for (int sg = 0; sg < 4; ++sg) { const float v = WG[sg * 128 + col]; off += (dir ? (sg > seg) : (sg < seg)) ? v : 0.f; }
#pragma unroll
        for (int i = 0; i < 16; ++i) { const int t = dir ? (seg * 16 + 15 - i) : (seg * 16 + i); G[t * 128 + col] = loc[i] + off; }
    }
    __syncthreads();
}

DEVI void gla_sum_item(unsigned char* lds, const Params& p, int l, const Tile tl) {
    const int tid = my_tid_w(p.wave), wid = tid >> 6, lane = tid & 63, fr = lane & 15, fq = lane >> 4;
    const bf16_t* z = (const bf16_t*)(p.ws + OFF_Z);
    float* ST = (float*)(p.ws + OFF_ST); float* DEC = (float*)(p.ws + OFF_DEC);
    const float* G = (const float*)(lds + GL_G); bf16_t* KD = (bf16_t*)(lds + GL_KD); const bf16_t* vT = (const bf16_t*)(lds + GL_VT);
    const int cid = tl.row0 >> 6;
    gla_load_common(p.wave, lds, z, tl, p.gla_w_gate + (size_t)l * 4096, p.gla_b_gate + l * 256);
    for (int dir = 0; dir < 2; ++dir) {
        gla_gates(lds, p, l, dir);
        { const int col = tid & 127, tq = tid >> 7; const float cl = G[(dir ? 0 : 63) * 128 + col];
            bf16_t kr[16];
#pragma unroll
            for (int tt = 0; tt < 16; ++tt) kr[tt] = z[(size_t)(tl.row0 + tq * 16 + tt) * ZP + ZK + col];
            float kd[16];
#pragma unroll
            for (int tt = 0; tt < 16; ++tt) kd[tt] = bf2f(kr[tt]) * __expf(cl - G[(tq * 16 + tt) * 128 + col]);
            u32x4 w0, w1;
            w0.x = cvt_pk_bf16(kd[0], kd[1]); w0.y = cvt_pk_bf16(kd[2], kd[3]); w0.z = cvt_pk_bf16(kd[4], kd[5]); w0.w = cvt_pk_bf16(kd[6], kd[7]);
            w1.x = cvt_pk_bf16(kd[8], kd[9]); w1.y = cvt_pk_bf16(kd[10], kd[11]); w1.z = cvt_pk_bf16(kd[12], kd[13]); w1.w = cvt_pk_bf16(kd[14], kd[15]);
            *(u32x4*)(KD + col * 72 + tq * 16) = w0; *(u32x4*)(KD + col * 72 + tq * 16 + 8) = w1;
            if (tid < 128) DEC[((size_t)(cid * 4 + (col >> 5)) * 2 + dir) * 32 + (col & 31)] = __expf(cl); }
        __syncthreads();
        { const int h = wid >> 1, mt = wid & 1;
            const bf16x8 a0 = *(const bf16x8*)(KD + (h * 32 + mt * 16 + fr) * 72 + fq * 8), a1 = *(const bf16x8*)(KD + (h * 32 + mt * 16 + fr) * 72 + 32 + fq * 8);
#pragma unroll
            for (int nt = 0; nt < 4; ++nt) { const bf16x8 b0 = *(const bf16x8*)(vT + (h * 64 + nt * 16 + fr) * 72 + fq * 8), b1 = *(const bf16x8*)(vT + (h * 64 + nt * 16 + fr) * 72 + 32 + fq * 8);
                f32x4 acc = (f32x4){0.f, 0.f, 0.f, 0.f}; acc = MFMA16(b0, a0, acc); acc = MFMA16(b1, a1, acc);
                *(f32x4*)(ST + ((size_t)(cid * 4 + h) * 2 + dir) * 2048 + (mt * 16 + fr) * 64 + nt * 16 + 4 * fq) = acc; } }
        __syncthreads();
    }
}

DEVI void gla_scan_phase(const Params& p) {
    float* ST = (float*)(p.ws + OFF_ST); const float* DEC = (const float*)(p.ws + OFF_DEC);
    for (int gt = blockIdx.x * 512 + my_tid_w(p.wave); gt < 65536; gt += gridDim.x * 512) {
        const int chain = gt >> 11, e = gt & 2047; const int dir = chain & 1, h = (chain >> 1) & 3, b = chain >> 3; const int d = e >> 6;
        float S = 0.f;
        for (int s0 = 0; s0 < 132; s0 += 12) {
            float kv[12], dc[12];
#pragma unroll
            for (int j = 0; j < 12; ++j) { const int s = s0 + j; const int cid = (s < 4) ? (512 + b * 4 + (dir ? 3 - s : s)) : (b * 128 + (dir ? 131 - s : s - 4));
                const size_t slot = (size_t)(cid * 4 + h) * 2 + dir; kv[j] = ST[slot * 2048 + e]; dc[j] = DEC[slot * 32 + d]; }
#pragma unroll
            for (int j = 0; j < 12; ++j) { const int s = s0 + j; const int cid = (s < 4) ? (512 + b * 4 + (dir ? 3 - s : s)) : (b * 128 + (dir ? 131 - s : s - 4));
                const size_t slot = (size_t)(cid * 4 + h) * 2 + dir; ST[slot * 2048 + e] = S; S = dc[j] * S + kv[j]; }
        }
    }
}

DEVI void gla_out_item(unsigned char* lds, const Params& p, int l, const Tile tl) {
    const int tid = my_tid_w(p.wave), wid = tid >> 6, lane = tid & 63, fr = lane & 15, fq = lane >> 4;
    const bf16_t* z = (const bf16_t*)(p.ws + OFF_Z);
    bf16_t* ycat = (bf16_t*)(p.ws + OFF_H);
    const float* ST = (const float*)(p.ws + OFF_ST);
    const float* G = (const float*)(lds + GL_G); bf16_t* QIN = (bf16_t*)(lds + GL_QIN); bf16_t* KIN = (bf16_t*)(lds + GL_KIN); bf16_t* STT = (bf16_t*)(lds + GL_STT);
    const bf16_t* vT = (const bf16_t*)(lds + GL_VT); bf16_t* AB = (bf16_t*)(lds + GL_G) + wid * 2304;
    const int cid = tl.row0 >> 6; const int h = wid >> 1, half = wid & 1;
    gla_load_common(p.wave, lds, z, tl, p.gla_w_gate + (size_t)l * 4096, p.gla_b_gate + l * 256);
    f32x4 o[2][4];
#pragma unroll
    for (int mi = 0; mi < 2; ++mi)
#pragma unroll
        for (int nt = 0; nt < 4; ++nt) o[mi][nt] = (f32x4){0.f, 0.f, 0.f, 0.f};
    for (int dir = 0; dir < 2; ++dir) {
        gla_gates(lds, p, l, dir);
        { const int col = tid & 127, tq = tid >> 7;
#pragma unroll 1
            for (int hb = 0; hb < 2; ++hb) {
                bf16_t qr[8], kr[8]; const bf16_t* zp = z + (size_t)(tl.row0 + tq * 16 + hb * 8) * ZP + col;
#pragma unroll
                for (int tt = 0; tt < 8; ++tt) { qr[tt] = zp[(size_t)tt * ZP + ZQ]; kr[tt] = zp[(size_t)tt * ZP + ZK]; }
#pragma unroll
                for (int tt = 0; tt < 8; ++tt) { const int t = tq * 16 + hb * 8 + tt; const float cum = G[t * 128 + col];
                    const float q = bf2f(qr[tt]) * 0.17677669529663687f * __expf(cum);
                    const float k = bf2f(kr[tt]) * __expf(-cum);
                    QIN[t * 136 + col] = f2bf(q); KIN[t * 136 + col] = f2bf(k); } }
            { const int he = tid & 255, dq = tid >> 8; const float* sp = ST + ((size_t)(cid * 4 + (he >> 6)) * 2 + dir) * 2048 + (dq * 16) * 64 + (he & 63);
                float sv[16];
#pragma unroll
                for (int j = 0; j < 16; ++j) sv[j] = sp[j * 64];
                u32x4 w0, w1;
                w0.x = cvt_pk_bf16(sv[0], sv[1]); w0.y = cvt_pk_bf16(sv[2], sv[3]); w0.z = cvt_pk_bf16(sv[4], sv[5]); w0.w = cvt_pk_bf16(sv[6], sv[7]);
                w1.x = cvt_pk_bf16(sv[8], sv[9]); w1.y = cvt_pk_bf16(sv[10], sv[11]); w1.z = cvt_pk_bf16(sv[12], sv[13]); w1.w = cvt_pk_bf16(sv[14], sv[15]);
                *(u32x4*)(STT + he * 40 + dq * 16) = w0; *(u32x4*)(STT + he * 40 + dq * 16 + 8) = w1; } }
        __syncthreads();
#pragma unroll
        for (int mi = 0; mi < 2; ++mi) { const int t = (half * 2 + mi) * 16 + fr; const bf16x8 qa = *(const bf16x8*)(QIN + t * 136 + h * 32 + fq * 8);
#pragma unroll
            for (int st = 0; st < 4; ++st) { const bf16x8 kb = *(const bf16x8*)(KIN + (st * 16 + fr) * 136 + h * 32 + fq * 8);
                f32x4 acc = (f32x4){0.f, 0.f, 0.f, 0.f}; acc = MFMA16(kb, qa, acc);
                const int s0 = st * 16 + 4 * fq;
#pragma unroll
                for (int j = 0; j < 4; ++j) { const int s = s0 + j; const bool keep = dir ? (s >= t) : (s <= t); acc[j] = keep ? acc[j] : 0.f; }
                u32x2 w; w.x = cvt_pk_bf16(acc[0], acc[1]); w.y = cvt_pk_bf16(acc[2], acc[3]);
                *(u32x2*)(AB + (mi * 16 + fr) * 72 + s0) = w; } }
        __syncthreads();
#pragma unroll
        for (int mi = 0; mi < 2; ++mi) { const int t = (half * 2 + mi) * 16 + fr;
            const bf16x8 aa0 = *(const bf16x8*)(AB + (mi * 16 + fr) * 72 + fq * 8), aa1 = *(const bf16x8*)(AB + (mi * 16 + fr) * 72 + 32 + fq * 8);
            const bf16x8 qa = *(const bf16x8*)(QIN + t * 136 + h * 32 + fq * 8);
#pragma unroll
            for (int nt = 0; nt < 4; ++nt) { const int er = h * 64 + nt * 16 + fr;
                const bf16x8 vb0 = *(const bf16x8*)(vT + er * 72 + fq * 8), vb1 = *(const bf16x8*)(vT + er * 72 + 32 + fq * 8), sb = *(const bf16x8*)(STT + er * 40 + fq * 8);
                o[mi][nt] = MFMA16(vb0, aa0, o[mi][nt]); o[mi][nt] = MFMA16(vb1, aa1, o[mi][nt]); o[mi][nt] = MFMA16(sb, qa, o[mi][nt]); } }
        __syncthreads();
    }
#pragma unroll
    for (int mi = 0; mi < 2; ++mi) { const int t = (half * 2 + mi) * 16 + fr; float ss = 0.f;
#pragma unroll
        for (int nt = 0; nt < 4; ++nt) ss += o[mi][nt][0] * o[mi][nt][0] + o[mi][nt][1] * o[mi][nt][1] + o[mi][nt][2] * o[mi][nt][2] + o[mi][nt][3] * o[mi][nt][3];
        ss += shx(ss, 16, lane); ss += shx(ss, 32, lane);
        const float rs = rsqrtf(ss * (1.0f / 64.0f) + EPS);
#pragma unroll
        for (int nt = 0; nt < 4; ++nt) { const int col = h * 64 + nt * 16 + 4 * fq; const f32x4 nw = *(const f32x4*)(p.gla_norm_w + l * 256 + col);
            const u32x2 raw = *(const u32x2*)(z + (size_t)(tl.row0 + t) * ZP + ZR + col);
            const float v0 = o[mi][nt][0] * rs * nw[0] * siluf_(bflo(raw.x)), v1 = o[mi][nt][1] * rs * nw[1] * siluf_(bfhi(raw.x)), v2 = o[mi][nt][2] * rs * nw[2] * siluf_(bflo(raw.y)), v3 = o[mi][nt][3] * rs * nw[3] * siluf_(bfhi(raw.y));
            u32x2 w; w.x = cvt_pk_bf16(v0, v1); w.y = cvt_pk_bf16(v2, v3);
            *(u32x2*)(ycat + (size_t)(tl.row0 + t) * DM + col) = w; } }
    __syncthreads();
}

DEVI void mix_phase(unsigned char* lds, const Params& p, int l) {
    const int n64 = (l == 0) ? 528 : 512, n128 = (l == 0) ? 264 : 256;
    const int nD = n64, nS = 528, nB = n64, nC = n128;
    const int total = nD + nS + nB + nC;
    for (int item = blockIdx.x; item < total; item += gridDim.x) {
        int it = item;
        if (it < nD) { cm_item(lds, p, l, tile_of(it, 64)); continue; }
        it -= nD;
        if (it < nS) { gla_sum_item(lds, p, l, tile_of(it, 64)); continue; }
        it -= nS;
        if (it < nB) { pool_item(lds, p, l, tile_of(it, 64)); continue; }
        it -= nB;
        sgu_item(lds, p, l, tile_of(it, 128));
    }
}
DEVI void gla_out_phase(unsigned char* lds, const Params& p, int l) {
    const int n64 = (l == 0) ? 528 : 512;
    for (int item = blockIdx.x; item < n64; item += gridDim.x) gla_out_item(lds, p, l, tile_of(item, 64));
}

struct ConvItem { int uu, row0, c0, seqc0, width, gr; bool lat; };
DEVI ConvItem conv_decode(int j, int npx, int xg, int tg) {
    ConvItem it; it.uu = j / npx; const Tile tl = tile_of(xg * npx + (j % npx), 64);
    it.lat = tl.L == SEQ; it.gr = tl.T0 >> 6; it.row0 = tl.row0; it.c0 = tg * 8; it.seqc0 = (it.lat ? 0 : tl.T0) + it.c0; it.width = it.lat ? 64 : CTXL; return it;
}
DEVI void conv_issue(const ConvItem& it, const bf16_t* U, int lane, unsigned (&va)[3][10], unsigned (&vg)[3][10]) {
#pragma unroll
    for (int dr = 0; dr < 3; ++dr) {
        const bool rvalid = it.lat ? (it.gr + dr - 1 >= 0 && it.gr + dr - 1 < 128) : (dr == 1);
        const int rbase = rvalid ? (it.row0 + (it.lat ? (dr - 1) * 64 : 0)) : it.row0;
        const bf16_t* pb = U + ((size_t)(rbase + it.c0) * UPITCH + it.uu * 256 + lane * 2);
#pragma unroll
        for (int q = 0; q < 10; ++q) { const int col = it.seqc0 + q - 1; const bool cvalid = col >= 0 && col < it.width;
            const bf16_t* pq = pb + (cvalid ? (q - 1) : 0) * UPITCH;
            va[dr][q] = *(const unsigned*)pq; vg[dr][q] = *(const unsigned*)(pq + 128); }
    }
}
DEVI void ffnconv_phase(unsigned char* lds, const Params& p, int l, int chunk) {
    const int lane = my_lane(); const int tg = p.wave;
    const int nu = c_cnu[chunk], u0 = c_cu0[chunk]; const int kc = FH;
    const int ntile = (l == 0) ? 528 : 512, npx = ntile >> 3;
    const bf16_t* U = (const bf16_t*)(p.ws + OFF_U); bf16_t* ACT = (bf16_t*)(p.ws + OFF_ACT);
    const int xg = blockIdx.x & 7, slot = blockIdx.x >> 3, nslot = gridDim.x >> 3, jend = nu * npx;
    float wA[9][2], wG[9][2];
#pragma unroll
    for (int t = 0; t < 9; ++t) { wA[t][0] = 0.f; wA[t][1] = 0.f; wG[t][0] = 0.f; wG[t][1] = 0.f; }
    int cur_uu = -1;
    unsigned va[3][10], vg[3][10], na[3][10], ng[3][10];
    int j = slot;
    if (j < jend) { const ConvItem it = conv_decode(j, npx, xg, tg); conv_issue(it, U, lane, va, vg); }
    for (; j < jend; j += nslot) {
        const ConvItem it = conv_decode(j, npx, xg, tg);
        const int jn = j + nslot;
        if (jn < jend) { const ConvItem nx = conv_decode(jn, npx, xg, tg); conv_issue(nx, U, lane, na, ng); }
        if (it.uu != cur_uu) {
#pragma unroll
            for (int t = 0; t < 9; ++t) { const float* wp = p.ffn_conv_w + ((size_t)l * 9 + t) * 5632 + (u0 + it.uu) * 128 + lane * 2;
                const f32x2 a = *(const f32x2*)wp, g = *(const f32x2*)(wp + FH); wA[t][0] = a[0]; wA[t][1] = a[1]; wG[t][0] = g[0]; wG[t][1] = g[1]; }
            cur_uu = it.uu;
        }
        float aA[8][2], aG[8][2];
#pragma unroll
        for (int t = 0; t < 8; ++t) { aA[t][0] = 0.f; aA[t][1] = 0.f; aG[t][0] = 0.f; aG[t][1] = 0.f; }
#pragma unroll
        for (int dr = 0; dr < 3; ++dr) {
            const bool rvalid = it.lat ? (it.gr + dr - 1 >= 0 && it.gr + dr - 1 < 128) : (dr == 1);
#pragma unroll
            for (int q = 0; q < 10; ++q) { const int col = it.seqc0 + q - 1; const bool ok = rvalid && col >= 0 && col < it.width;
                va[dr][q] = ok ? va[dr][q] : 0u; vg[dr][q] = ok ? vg[dr][q] : 0u; }
#pragma unroll
            for (int t = 0; t < 8; ++t)
#pragma unroll
                for (int dc = 0; dc < 3; ++dc) { const int tap = dr * 3 + dc; const unsigned a = va[dr][t + dc], g = vg[dr][t + dc];
                    aA[t][0] += bflo(a) * wA[tap][0]; aA[t][1] += bfhi(a) * wA[tap][1]; aG[t][0] += bflo(g) * wG[tap][0]; aG[t][1] += bfhi(g) * wG[tap][1]; }
        }
        bf16_t* ap = ACT + (size_t)(it.row0 + it.c0) * kc + (u0 + it.uu) * 128 + lane * 2;
#pragma unroll
        for (int t = 0; t < 8; ++t) *(unsigned*)(ap + (size_t)t * kc) = cvt_pk_bf16(siluf_(aG[t][0]) * aA[t][0], siluf_(aG[t][1]) * aA[t][1]);
#pragma unroll
        for (int dr = 0; dr < 3; ++dr)
#pragma unroll
            for (int q = 0; q < 10; ++q) { va[dr][q] = na[dr][q]; vg[dr][q] = ng[dr][q]; }
    }
}

#define XB_TMO      128
#define XB_XCNT(j)  (256  + 64 * (j))
#define XB_XSUB(j)  (1280 + 64 * (j))
#define XB_XGEN(j)  (2304 + 64 * (j))
#define XB_TOP      3328
#define XB_TOPGEN   3392
#define XB_SPIN_CAP (1u << 22)
DEVI unsigned xb_ld(unsigned* p) { return __hip_atomic_load(p, __ATOMIC_RELAXED, __HIP_MEMORY_SCOPE_AGENT); }
DEVI unsigned xb_add(unsigned* p, unsigned v) { return __hip_atomic_fetch_add(p, v, __ATOMIC_RELAXED, __HIP_MEMORY_SCOPE_AGENT); }
DEVI unsigned xb_xcc_id() { return (unsigned)__builtin_amdgcn_s_getreg((3 << 11) | 20) & 0xFu; }
#define XB_SPIN(cond, bar) do { unsigned _sp = 0; while (cond) { __builtin_amdgcn_s_sleep(1); \
    if ((++_sp & 255u) == 0u) { if (xb_ld(&(bar)[XB_TMO])) break; if (_sp > XB_SPIN_CAP) { atomicAdd(&(bar)[XB_TMO], 1u); break; } } } } while (0)
struct XcdBarrier { unsigned* bar; unsigned x; volatile LAS unsigned* st; };
DEVI XcdBarrier xcd_barrier_post(unsigned* bar, volatile LAS unsigned* st) {
    XcdBarrier b; b.bar = bar; b.x = xb_xcc_id(); b.st = st;
    if (threadIdx.x == 0) (void)xb_add(&bar[XB_XCNT(b.x)], 1u);
    return b;
}
DEVI void xcd_barrier_complete(unsigned* bar, unsigned x, unsigned& nloc, unsigned& nx) {
    const unsigned G = gridDim.x * gridDim.y * gridDim.z;
    unsigned sum, cnt, mine, sp = 0u;
    for (;;) {
        sum = 0u; cnt = 0u; mine = 0u;
#pragma unroll
        for (unsigned j = 0; j < 16; ++j) { const unsigned c = xb_ld(&bar[XB_XCNT(j)]); sum += c; cnt += (c > 0u) ? 1u : 0u; mine = (j == x) ? c : mine; }
        if (sum == G) break;
        __builtin_amdgcn_s_sleep(1);
        if ((++sp & 255u) == 0u) { if (xb_ld(&bar[XB_TMO])) break; if (sp > XB_SPIN_CAP) { atomicAdd(&bar[XB_TMO], 1u); break; } }
    }
    nloc = mine > 0u ? mine : 1u; nx = cnt > 0u ? cnt : 1u;
}
DEVI void xcd_barrier(const XcdBarrier& b) {
    asm volatile("s_waitcnt vmcnt(0)" ::: "memory");
    __syncthreads();
    if (threadIdx.x == 0) {
        unsigned* bar = b.bar;
        __builtin_amdgcn_s_waitcnt(0);
        unsigned nloc = b.st[0], nx = b.st[1];
        if (nloc == 0u) { xcd_barrier_complete(bar, b.x, nloc, nx); b.st[0] = nloc; b.st[1] = nx; }
        const unsigned old = xb_add(&bar[XB_XSUB(b.x)], 1u);
        const unsigned gen = old / nloc;
        if (old + 1u == (gen + 1u) * nloc) {
            __builtin_amdgcn_fence(__ATOMIC_RELEASE, "agent");
            asm volatile("s_waitcnt vmcnt(0)" ::: "memory");
            const unsigned og = xb_add(&bar[XB_TOP], 1u);
            const unsigned tg = og / nx;
            if (og + 1u == (tg + 1u) * nx) xb_add(&bar[XB_TOPGEN], 1u);
            else XB_SPIN(xb_ld(&bar[XB_TOPGEN]) == tg, bar);
            __builtin_amdgcn_fence(__ATOMIC_ACQUIRE, "agent");
            xb_add(&bar[XB_XGEN(b.x)], 1u);
            asm volatile("s_waitcnt vmcnt(0)" ::: "memory");
        } else {
            XB_SPIN(xb_ld(&bar[XB_XGEN(b.x)]) == gen, bar);
            __builtin_amdgcn_fence(__ATOMIC_ACQUIRE, "agent");
            asm volatile("s_waitcnt vmcnt(0)" ::: "memory");
        }
    }
    __syncthreads();
}

constexpr int PH_PER_LAYER = 19, N_PHASES = 1 + 2 * PH_PER_LAYER;

DEVI void run_phase(unsigned char* shm, const Params& p, int ph) {
    LAS unsigned char* lds3 = (LAS unsigned char*)shm;
    unsigned char* ws = p.ws;
    const float* mods = (const float*)(ws + OFF_MODS);
    float* X = (float*)(ws + OFF_X); bf16_t* H = (bf16_t*)(ws + OFF_H); bf16_t* Z = (bf16_t*)(ws + OFF_Z); bf16_t* U = (bf16_t*)(ws + OFF_U); bf16_t* ACT = (bf16_t*)(ws + OFF_ACT);
    if (ph == 0) { prep_phase(shm, p); return; }
    const int l = (ph - 1) / PH_PER_LAYER, k = (ph - 1) % PH_PER_LAYER;
    const float* ml = mods + l * 5 * 6144;
    const int Mrows = (l == 0) ? ROWS : NLAT;
    pg8::StaticOrder S;
    switch (k) {
    case 0: if (l == 0) ln_phase(p.wave, p.x, p.ctx, ROWS, nullptr, nullptr, nullptr, nullptr, ml, 0, H); break;
    case 1: { pg8::Gemm g{H, (const bf16_t*)(ws + OFF_WIN) + (size_t)l * 2304 * 1024, ROWS, ZP, 1024}; S.init(g.M, g.N, gridDim.x, blockIdx.x);
        pg8::EpiBf16 E{Z, ZP}; pg8::gemm_phase(lds3, g, S, E, p.wave); } break;
    case 2: mix_phase(shm, p, l); break;
    case 3: gla_scan_phase(p); break;
    case 4: gla_out_phase(shm, p, l); break;
    case 5: { pg8::Gemm g{H, (const bf16_t*)(ws + OFF_WOUT) + (size_t)l * 1024 * 1024, Mrows, 1024, 1024}; S.init(g.M, g.N, gridDim.x, blockIdx.x);
        pg8::EpiRes E{X, l == 0 ? p.x : X, l == 0 ? p.ctx : X + (size_t)NLAT * DM, ml, 2 * 1024, 0}; pg8::gemm_phase(lds3, g, S, E, p.wave); } break;
    case 6: ln_phase(p.wave, X, X + (size_t)NLAT * DM, Mrows, p.post_ln_w + (l * 2 + 0) * 1024, p.post_ln_b + (l * 2 + 0) * 1024, X, nullptr, ml, 3 * 1024, H); break;
    case 7: case 9: case 11: case 13: case 15: { const int ch = (k - 7) >> 1; const int u0 = c_cu0[ch], nu = c_cnu[ch];
        pg8::Gemm g{H, (const bf16_t*)(ws + OFF_WUP) + (size_t)l * 5632 * 1024 + (size_t)u0 * 256 * 1024, Mrows, nu * 256, 1024}; S.init(g.M, g.N, gridDim.x, blockIdx.x);
        pg8::EpiBf16 E{U, UPITCH}; pg8::gemm_phase(lds3, g, S, E, p.wave); } break;
    case 8: case 10: case 12: case 14: case 16: ffnconv_phase(shm, p, l, (k - 8) >> 1); break;
    case 17: { pg8::Gemm g{ACT, (const bf16_t*)(ws + OFF_WDN) + (size_t)l * 1024 * FH, Mrows, 1024, FH}; S.init(g.M, g.N, gridDim.x, blockIdx.x);
        pg8::EpiRes E{X, X, X + (size_t)NLAT * DM, ml, 5 * 1024, 0}; pg8::gemm_phase(lds3, g, S, E, p.wave); } break;
    case 18:
        if (l == 0) ln_phase(p.wave, X, X + (size_t)NLAT * DM, ROWS, p.post_ln_w + (l * 2 + 1) * 1024, p.post_ln_b + (l * 2 + 1) * 1024, X, nullptr, mods + 5 * 6144, 0, H);
        else ln_phase(p.wave, X, X + (size_t)NLAT * DM, NLAT, p.post_ln_w + (l * 2 + 1) * 1024, p.post_ln_b + (l * 2 + 1) * 1024, nullptr, p.out, nullptr, 0, nullptr);
        break;
    }
}

__global__ void __launch_bounds__(512, 2) mega(Params p, int ph_lo, int ph_hi, int coop) {
    extern __shared__ __attribute__((aligned(16))) unsigned char shm[];
    unsigned* bar = (unsigned*)(p.ws + OFF_CTL);
    volatile LAS unsigned* st = (volatile LAS unsigned*)((LAS unsigned char*)shm + (LDS_BYTES - 16));
    if (threadIdx.x == 0) { st[0] = 0u; st[1] = 0u; }
    __syncthreads();
    const XcdBarrier xb = xcd_barrier_post(bar, st);
    Params q = p; q.wave = __builtin_amdgcn_readfirstlane((int)(threadIdx.x >> 6));
    for (int ph = ph_lo; ph < ph_hi; ++ph) {
        if (ph == 1 + PH_PER_LAYER) continue;
        run_phase(shm, q, ph);
#if PROBE_REP > 0
        if (ph == PROBE_PH || ph == PROBE_PH2) for (int rep = 0; rep < PROBE_REP; ++rep) { xcd_barrier(xb); run_phase(shm, q, ph); }
#endif
        if (coop && ph + 1 < ph_hi) {
            if (ph == 0) cg::this_grid().sync();
            else xcd_barrier(xb);
        }
    }
}

extern "C" void kernel_launch(void* const* d_in, const int* in_sizes, int n_in, void* d_out, int out_size, void* d_ws, size_t ws_size, hipStream_t stream) {
    static int grid = 0;
    if (grid == 0) {
        if (n_in != 26 || ws_size < WS_END) { fprintf(stderr, "kernel_launch: unexpected n_in %d / ws_size %zu (need %zu)\n", n_in, ws_size, (size_t)WS_END); grid = -1; return; }
        int dev = 0, cus = 0, per_cu = 0;
        hipGetDevice(&dev); hipDeviceGetAttribute(&cus, hipDeviceAttributeMultiprocessorCount, dev);
        if (hipFuncSetAttribute((const void*)mega, hipFuncAttributeMaxDynamicSharedMemorySize, LDS_BYTES) != hipSuccess) { fprintf(stderr, "kernel_launch: hipFuncSetAttribute failed\n"); grid = -1; return; }
        if (hipOccupancyMaxActiveBlocksPerMultiprocessor(&per_cu, (const void*)mega, 512, LDS_BYTES) != hipSuccess || per_cu < 1) { fprintf(stderr, "kernel_launch: occupancy query says %d\n", per_cu); per_cu = 1; }
        (void)hipGetLastError();
        grid = cus * 1;
    }
    if (grid < 0) return;
    Params p{};
    const float** pp = (const float**)&p;
    for (int i = 0; i < 26; ++i) pp[i] = (const float*)d_in[i];
    p.wave = 0; p.pad_ = 0;
    p.out = (float*)d_out; p.ws = (unsigned char*)d_ws;
#if MK_COOP
    hipMemsetAsync((char*)d_ws + OFF_CTL, 0, 16384, stream);
    int lo = 0, hi = N_PHASES, coop = 1;
    void* args[] = {&p, &lo, &hi, &coop};
    hipError_t e = hipLaunchCooperativeKernel((const void*)mega, dim3(grid), dim3(512), args, LDS_BYTES, stream);
    if (e != hipSuccess) fprintf(stderr, "cooperative launch failed: %s (grid %d)\n", hipGetErrorString(e), grid);
#else
    for (int ph = 0; ph < N_PHASES; ++ph) {
        if (ph == 1 + PH_PER_LAYER) continue;
        hipLaunchKernelGGL(mega, dim3(grid), dim3(512), LDS_BYTES, stream, p, ph, ph + 1, 0);
    }
#endif
}
```

```cpp
#include <hip/hip_runtime.h>
#include <hip/hip_cooperative_groups.h>
#include <cstdio>
#include <cstdint>
namespace cg = cooperative_groups;

#ifndef PROBE_REP
#define PROBE_REP 0
#define PROBE_PH -1
#define PROBE_PH2 -1
#endif
#ifndef MK_COOP
#define MK_COOP 1
#endif

#define DEVI __device__ __forceinline__
#define LAS __attribute__((address_space(3)))
typedef unsigned short bf16_t;
typedef short bf16x8 __attribute__((ext_vector_type(8)));
typedef float f32x4 __attribute__((ext_vector_type(4)));
typedef float f32x2 __attribute__((ext_vector_type(2)));
typedef unsigned u32x4 __attribute__((ext_vector_type(4)));
typedef unsigned u32x2 __attribute__((ext_vector_type(2)));

constexpr int DM = 1024, SEQ = 8192, CTXL = 256, NLAT = 32768, NCTX = 1024, ROWS = 33792;
constexpr int ZP = 2304;
constexpr int ZQ = 0, ZK = 128, ZV = 256, ZR = 512, ZLF = 768, ZB = 800, ZCU = 1056, ZCV = 1312, ZDA = 1568, ZDG = 1824;
constexpr int FH = 2816, UPITCH = 1280;
constexpr float ALPHA = 1.41421356237f, EPS = 1e-6f;
constexpr int LDS_BYTES = 160 * 1024;
constexpr int NCHUNK64 = 528;

constexpr size_t OFF_CTL = 0;
constexpr size_t OFF_MODS = 16384;
constexpr size_t OFF_SGUW = OFF_MODS + 2ull * 5 * 6144 * 4;
constexpr size_t OFF_POOLW = OFF_SGUW + 2ull * 4 * 128 * 128 * 2;
constexpr size_t OFF_WIN = OFF_POOLW + 2ull * 4 * 64 * 64 * 2;
constexpr size_t OFF_WOUT = OFF_WIN + 2ull * 2304 * 1024 * 2;
constexpr size_t OFF_WUP = OFF_WOUT + 2ull * 1024 * 1024 * 2;
constexpr size_t OFF_WDN = OFF_WUP + 2ull * 5632 * 1024 * 2;
constexpr size_t OFF_X = OFF_WDN + 2ull * 1024 * 2816 * 2;
constexpr size_t OFF_H = OFF_X + (size_t)ROWS * 1024 * 4;
constexpr size_t OFF_R1 = OFF_H + (size_t)ROWS * 1024 * 2;
constexpr size_t OFF_Z = OFF_R1;
constexpr size_t OFF_ST = OFF_Z + (size_t)ROWS * ZP * 2;
constexpr size_t OFF_DEC = OFF_ST + (size_t)NCHUNK64 * 8 * 2048 * 4;
constexpr size_t OFF_U = OFF_R1;
constexpr size_t OFF_ACT = OFF_U + (size_t)ROWS * UPITCH * 2;
constexpr size_t WS_END = OFF_ACT + (size_t)ROWS * FH * 2;
static_assert(WS_END <= 536870912ull, "workspace map exceeds the guaranteed 4 x largest-tensor size");
static_assert(OFF_DEC + (size_t)NCHUNK64 * 8 * 32 * 4 <= WS_END, "mixer scratch must fit");

struct Params {
    const float *x, *c, *ctx, *c_ctx, *w_mod, *b_mod, *w_in, *gla_w_gate, *gla_b_gate, *gla_norm_w, *pool_w, *pool_scale, *sgu_w, *sgu_b,
        *sgu_ln_w, *sgu_ln_b, *cm_conv_w, *cm_conv_b, *cm_ln_w, *cm_ln_b, *w_out, *ffn_w_up, *ffn_conv_w, *ffn_w_down, *post_ln_w, *post_ln_b;
    float* out; unsigned char* ws;
    int wave, pad_;
};

DEVI float bf2f(unsigned v) { return __uint_as_float(v << 16); }
DEVI float bflo(unsigned v) { return __uint_as_float(v << 16); }
DEVI float bfhi(unsigned v) { return __uint_as_float(v & 0xffff0000u); }
DEVI unsigned cvt_pk_bf16(float lo, float hi) { unsigned r; asm volatile("v_cvt_pk_bf16_f32 %0, %1, %2" : "=v"(r) : "v"(lo), "v"(hi)); return r; }
DEVI bf16_t f2bf(float f) { return (bf16_t)(cvt_pk_bf16(f, 0.f) & 0xffffu); }
DEVI int my_lane() { int t; asm volatile("v_mbcnt_lo_u32_b32 %0, -1, 0\n\tv_mbcnt_hi_u32_b32 %0, -1, %0" : "=v"(t)); return t; }
DEVI int my_tid_w(int wave) { return (wave << 6) | my_lane(); }
DEVI float shx(float v, int o, int lane) { return __int_as_float(__builtin_amdgcn_ds_bpermute((lane ^ o) << 2, __float_as_int(v))); }
DEVI float wsum(float v, int lane) {
#pragma unroll
    for (int o = 32; o; o >>= 1) v += shx(v, o, lane);
    return v; }
DEVI float sigmoidf_(float x) { return __builtin_amdgcn_rcpf(1.0f + __expf(-x)); }
DEVI float siluf_(float x) { return x * __builtin_amdgcn_rcpf(1.0f + __expf(-x)); }
DEVI float geluf_(float x) { const float u = 0.7978845608f * (x + 0.044715f * x * x * x); return x * __builtin_amdgcn_rcpf(1.0f + __expf(-2.0f * u)); }
DEVI float logsigf_(float x) { return fminf(x, 0.f) - __logf(1.0f + __expf(-fabsf(x))); }
#define MFMA16(a, b, c) __builtin_amdgcn_mfma_f32_16x16x32_bf16((a), (b), (c), 0, 0, 0)

namespace pg8 {
constexpr int BM = 256, BK = 64, HALF = 128, HTB = HALF * BK * 2, STAGE_BYTES = 8 * HTB, NXCD = 8, WGM = 8;
DEVI int lds_byte(int r, int c) { const int st = (r >> 4) * 2 + (c >> 5), rr = r & 15, cc = c & 31, ob = rr * 64 + cc * 2; return st * 1024 + (ob ^ (((ob >> 9) & 1) << 5)); }
DEVI void stage_rc(int b, int& R, int& C) { const int st = b / 1024, sb = b % 1024, swz = sb ^ (((sb >> 9) & 1) << 5); R = (st >> 1) * 16 + swz / 64; C = (st & 1) * 32 + (swz % 64) / 2; }
DEVI int perm32(int rho) { const int n = rho >> 4, i = rho & 15; return 8 * (i >> 2) + 4 * n + (i & 3); }
struct Unit { int pm, pn; };
struct Gemm { const bf16_t* A; const bf16_t* Bt; int M, N, K; };
struct StaticOrder {
    int nM, nN, nwg, G, c;
    DEVI void init(int M, int N, int G_, int c_) { nM = M / BM; nN = N / BM; nwg = nM * nN; G = G_; c = c_; }
    DEVI bool next(int i, Unit& u) const {
        const long L = (long)i * G + c; if (L >= nwg) return false;
        int wgid = (int)L; { const int q = nwg / NXCD, r = nwg % NXCD, xcd = wgid % NXCD, off = wgid / NXCD; wgid = (xcd < r ? xcd * (q + 1) : r * (q + 1) + (xcd - r) * q) + off; }
        const int nig = WGM * nN, gid = wgid / nig, fm = gid * WGM, gsz = (nM - fm) < WGM ? (nM - fm) : WGM;
        u.pm = fm + ((wgid % nig) % gsz); u.pn = (wgid % nig) / gsz; return true;
    }
    DEVI void a_ready(const Unit&) const {}
    DEVI void done(const Unit&) const {}
};

struct EpiBf16 {
    static constexpr bool PERM = true;
    bf16_t* O; int ldc;
    DEVI void operator()(const f32x4 (&acc)[2][2][4][2], const Unit& u, int wr, int wc, int, int) const {
        const int ln = my_lane(), fr = ln & 15, fq = ln >> 4;
        const int row0 = u.pm * BM + wr * 64 + fr; const int col0 = u.pn * BM + wc * 32 + 8 * fq;
#pragma unroll
        for (int ai = 0; ai < 2; ++ai)
#pragma unroll
            for (int m = 0; m < 4; ++m) { bf16_t* rowp = O + (size_t)(row0 + ai * HALF + m * 16) * ldc + col0;
#pragma unroll
                for (int bj = 0; bj < 2; ++bj) { const f32x4 v0 = acc[ai][bj][m][0], v1 = acc[ai][bj][m][1];
                    u32x4 w; w.x = cvt_pk_bf16(v0[0], v0[1]); w.y = cvt_pk_bf16(v0[2], v0[3]); w.z = cvt_pk_bf16(v1[0], v1[1]); w.w = cvt_pk_bf16(v1[2], v1[3]);
                    *(u32x4*)(rowp + bj * HALF) = w; } }
    }
};
struct EpiRes {
    static constexpr bool PERM = true;
    float* X; const float* srcL; const float* srcC; const float* mods; int goff; int mode;
    DEVI void operator()(const f32x4 (&acc)[2][2][4][2], const Unit& u, int wr, int wc, int, int) const {
        const int ln = my_lane(), fr = ln & 15, fq = ln >> 4;
        const int rowt = u.pm * BM; const int b = rowt < NLAT ? (rowt >> 13) : 4;
        float* dst = X + (size_t)rowt * DM;
        const float* src = (mode == 0) ? (rowt < NLAT ? srcL + (size_t)rowt * DM : srcC + (size_t)(rowt - NLAT) * DM) : dst;
        const float al = (mode == 0) ? ALPHA : 1.0f;
        const int rl = wr * 64 + fr;
        const int col0 = u.pn * BM + wc * 32 + 8 * fq;
        const float* gp = mods + b * 6144 + goff + col0;
        f32x4 gv[2][2];
#pragma unroll
        for (int bj = 0; bj < 2; ++bj)
#pragma unroll
            for (int n = 0; n < 2; ++n) gv[bj][n] = *(const f32x4*)(gp + bj * HALF + n * 4);
#pragma unroll
        for (int ai = 0; ai < 2; ++ai) {
            f32x4 xr[4][2][2];
#pragma unroll
            for (int m = 0; m < 4; ++m) { const size_t ro = (size_t)(rl + ai * HALF + m * 16) * DM + col0;
#pragma unroll
                for (int bj = 0; bj < 2; ++bj) { xr[m][bj][0] = *(const f32x4*)(src + ro + bj * HALF); xr[m][bj][1] = *(const f32x4*)(src + ro + bj * HALF + 4); } }
#pragma unroll
            for (int m = 0; m < 4; ++m) { const size_t ro = (size_t)(rl + ai * HALF + m * 16) * DM + col0;
#pragma unroll
                for (int bj = 0; bj < 2; ++bj) {
                    *(f32x4*)(dst + ro + bj * HALF) = al * xr[m][bj][0] + gv[bj][0] * acc[ai][bj][m][0];
                    *(f32x4*)(dst + ro + bj * HALF + 4) = al * xr[m][bj][1] + gv[bj][1] * acc[ai][bj][m][1]; } }
        }
    }
};

template <class Epi, class Sched>
DEVI void gemm_phase(LAS unsigned char* lds, const Gemm g, const Sched& S, const Epi& E, int wave) {
    const int tid = my_tid_w(wave), wid = __builtin_amdgcn_readfirstlane(tid >> 6), lane = tid & 63, wr = wid >> 2, wc = wid & 3, fr = lane & 15, fq = lane >> 4;
    const int K = g.K, nt = K / BK;
    unsigned voffA[2], voffB[2];
#pragma unroll
    for (int i = 0; i < 2; ++i) { int R, C; stage_rc(tid * 16 + i * 8192, R, C); const int Rb = Epi::PERM ? ((R & ~31) + perm32(R & 31)) : R;
        voffA[i] = (unsigned)(R * K + C) * 2u; voffB[i] = (unsigned)(Rb * K + C) * 2u; }
    const size_t kstep = (size_t)(BK * 2);
    const size_t hstep = (size_t)HALF * K * 2;
    const size_t tstep = 2 * hstep;
    const unsigned ldsw = (unsigned)wid * 1024u;
    const int aoff = lds_byte(wr * 64 + fr, fq * 8), boff = lds_byte(wc * 32 + fr, fq * 8);
#define PG8_SA(b, h) (((b) * 2 + (h)) * HTB)
#define PG8_SB(b, h) ((4 + (b) * 2 + (h)) * HTB)
#define PG8_STAGE(bufoff, gbase, voff) do { _Pragma("unroll") for (int _i = 0; _i < 2; ++_i) \
        __builtin_amdgcn_global_load_lds((const unsigned*)((const char*)(gbase) + (voff)[_i]), (LAS unsigned*)(lds + (bufoff) + ldsw + _i * 8192), 16, 0, 0); } while (0)
#define PG8_LDA(dst, b, h) do { _Pragma("unroll") for (int m = 0; m < 4; ++m) _Pragma("unroll") for (int k = 0; k < 2; ++k) dst[m][k] = *(const LAS bf16x8*)(lds + PG8_SA(b, h) + aoff + m * 2048 + k * 1024); } while (0)
#define PG8_LDB(dst, b, h) do { _Pragma("unroll") for (int n = 0; n < 2; ++n) _Pragma("unroll") for (int k = 0; k < 2; ++k) dst[n][k] = *(const LAS bf16x8*)(lds + PG8_SB(b, h) + boff + n * 2048 + k * 1024); } while (0)
#define PG8_MMA(ai, bj, At, Bt) do { __builtin_amdgcn_s_setprio(1); _Pragma("unroll") for (int m = 0; m < 4; ++m) _Pragma("unroll") for (int n = 0; n < 2; ++n) _Pragma("unroll") for (int k = 0; k < 2; ++k) \
        acc[ai][bj][m][n] = __builtin_amdgcn_mfma_f32_16x16x32_bf16(Bt[n][k], At[m][k], acc[ai][bj][m][n], 0, 0, 0); __builtin_amdgcn_s_setprio(0); } while (0)
#define PG8_WAIT_V(n) asm volatile("s_waitcnt vmcnt(" #n ")" ::: "memory")
#define PG8_WAIT_L(n) asm volatile("s_waitcnt lgkmcnt(" #n ")" ::: "memory")
#define PG8_BAR __builtin_amdgcn_s_barrier()
#define PG8_SCHED __builtin_amdgcn_sched_barrier(0)
    Unit cur, nxt; int ui = 0;
    if (!S.next(0, cur)) return;
    f32x4 acc[2][2][4][2];
#pragma unroll
    for (int a = 0; a < 2; ++a)
#pragma unroll
        for (int b = 0; b < 2; ++b)
#pragma unroll
            for (int m = 0; m < 4; ++m)
#pragma unroll
                for (int n = 0; n < 2; ++n) acc[a][b][m][n] = (f32x4){0.f, 0.f, 0.f, 0.f};
    bf16x8 At[4][2], B0[2][2], B1[2][2];
    const char* cA = (const char*)g.A + (size_t)cur.pm * tstep; const char* cB = (const char*)g.Bt + (size_t)cur.pn * tstep;
    S.a_ready(cur);
    PG8_STAGE(PG8_SB(0, 0), cB, voffB); PG8_STAGE(PG8_SA(0, 0), cA, voffA); PG8_STAGE(PG8_SB(0, 1), cB + hstep, voffB); PG8_STAGE(PG8_SA(0, 1), cA + hstep, voffA);
    if (wr == 1) PG8_BAR;
    PG8_WAIT_V(4); PG8_BAR;
    PG8_STAGE(PG8_SB(1, 0), cB + kstep, voffB); PG8_STAGE(PG8_SA(1, 0), cA + kstep, voffA); PG8_STAGE(PG8_SB(1, 1), cB + hstep + kstep, voffB);
    PG8_WAIT_V(6); PG8_BAR;
    for (;;) {
        const bool has_next = S.next(ui + 1, nxt);
        const char* nA = has_next ? (const char*)g.A + (size_t)nxt.pm * tstep : cA; const char* nB = has_next ? (const char*)g.Bt + (size_t)nxt.pn * tstep : cB;
        for (int t = 0; t < nt; t += 2) {
            const bool last = (t == nt - 2);
            const char* a1 = cA + (size_t)(t + 1) * kstep;
            const char* a2 = last ? nA : cA + (size_t)(t + 2) * kstep; const char* b2 = last ? nB : cB + (size_t)(t + 2) * kstep;
            const char* a3 = a2 + kstep; const char* b3 = b2 + kstep;
            if (last && has_next) S.a_ready(nxt);
            PG8_LDB(B0, 0, 0); PG8_SCHED; PG8_LDA(At, 0, 0); PG8_STAGE(PG8_SA(1, 1), a1 + hstep, voffA);
            PG8_WAIT_L(8); PG8_BAR; PG8_WAIT_L(0); PG8_MMA(0, 0, At, B0); PG8_BAR; PG8_SCHED;
            PG8_LDB(B1, 0, 1); PG8_STAGE(PG8_SB(0, 0), b2, voffB);
            PG8_BAR; PG8_WAIT_L(0); PG8_MMA(0, 1, At, B1); PG8_BAR;
            PG8_LDA(At, 0, 1); PG8_STAGE(PG8_SA(0, 0), a2, voffA);
            PG8_BAR; PG8_WAIT_L(0); PG8_MMA(1, 0, At, B0); PG8_BAR; PG8_SCHED;
            PG8_STAGE(PG8_SB(0, 1), b2 + hstep, voffB);
            PG8_WAIT_V(6); PG8_BAR; PG8_MMA(1, 1, At, B1); PG8_BAR;
            PG8_LDB(B0, 1, 0); PG8_SCHED; PG8_LDA(At, 1, 0); PG8_STAGE(PG8_SA(0, 1), a2 + hstep, voffA);
            PG8_WAIT_L(8); PG8_BAR; PG8_WAIT_L(0); PG8_MMA(0, 0, At, B0); PG8_BAR; PG8_SCHED;
            PG8_LDB(B1, 1, 1); PG8_STAGE(PG8_SB(1, 0), b3, voffB);
            PG8_BAR; PG8_WAIT_L(0); PG8_MMA(0, 1, At, B1); PG8_BAR;
            PG8_LDA(At, 1, 1); PG8_STAGE(PG8_SA(1, 0), a3, voffA);
            PG8_BAR; PG8_WAIT_L(0); PG8_MMA(1, 0, At, B0); PG8_BAR; PG8_SCHED;
            PG8_STAGE(PG8_SB(1, 1), b3 + hstep, voffB);
            PG8_WAIT_V(6); PG8_BAR; PG8_MMA(1, 1, At, B1); PG8_BAR;
        }
        E(acc, cur, wr, wc, fr, fq); S.done(cur);
        if (!has_next) break;
#pragma unroll
        for (int a = 0; a < 2; ++a)
#pragma unroll
            for (int b = 0; b < 2; ++b)
#pragma unroll
                for (int m = 0; m < 4; ++m)
#pragma unroll
                    for (int n = 0; n < 2; ++n) acc[a][b][m][n] = (f32x4){0.f, 0.f, 0.f, 0.f};
        cur = nxt; cA = nA; cB = nB; ++ui;
    }
    PG8_WAIT_V(0);
    if (wr == 0) PG8_BAR;
    PG8_BAR;
#undef PG8_SA
#undef PG8_SB
#undef PG8_STAGE
#undef PG8_LDA
#undef PG8_LDB
#undef PG8_MMA
#undef PG8_WAIT_V
#undef PG8_WAIT_L
#undef PG8_BAR
#undef PG8_SCHED
}
}

DEVI void transpose_tile(int wave, float* tile, const float* src, int ld_src, int k0, int n0s, int nvalid, bf16_t* dst, int ld_dst, int n0d, int k0d) {
    const int tid = my_tid_w(wave);
    { const int nn = tid & 63; const int col = n0s + nn; const bool ok = col < nvalid; const int colc = ok ? col : 0;
        float v[8];
#pragma unroll
        for (int i = 0; i < 8; ++i) v[i] = src[(size_t)(k0 + i * 8 + (tid >> 6)) * ld_src + colc];
#pragma unroll
        for (int i = 0; i < 8; ++i) tile[(i * 8 + (tid >> 6)) * 65 + nn] = ok ? v[i] : 0.f; }
    __syncthreads();
#pragma unroll
    for (int i = 0; i < 8; ++i) { const int nn = i * 8 + (tid >> 6), kk = tid & 63; dst[(size_t)(n0d + nn) * ld_dst + k0d + kk] = f2bf(tile[kk * 65 + nn]); }
    __syncthreads();
}

DEVI void mods_item(float* lf, const Params& p, int item) {
    const int tid = my_tid_w(p.wave); const int l = item / 96, cgp = item % 96;
    float* s = lf;
    float* red = lf + 5120;
    for (int i = tid; i < 5120; i += 512) { const int r = i >> 10, k = i & 1023; const float v = (r < 4) ? p.c[r * 1024 + k] : p.c_ctx[k]; s[i] = siluf_(v); }
    __syncthreads();
    const int cc = tid & 63, kg = tid >> 6; const int col = cgp * 64 + cc;
    const float* W = p.w_mod + (size_t)l * 1024 * 6144 + col;
    float a0 = 0.f, a1 = 0.f, a2 = 0.f, a3 = 0.f, a4 = 0.f;
#pragma unroll 8
    for (int k = kg * 128; k < kg * 128 + 128; ++k) { const float w = W[(size_t)k * 6144];
        a0 += s[k] * w; a1 += s[1024 + k] * w; a2 += s[2048 + k] * w; a3 += s[3072 + k] * w; a4 += s[4096 + k] * w; }
    red[(kg * 5 + 0) * 64 + cc] = a0; red[(kg * 5 + 1) * 64 + cc] = a1; red[(kg * 5 + 2) * 64 + cc] = a2; red[(kg * 5 + 3) * 64 + cc] = a3; red[(kg * 5 + 4) * 64 + cc] = a4;
    __syncthreads();
    if (tid < 320) { const int r = tid >> 6, c2 = tid & 63; float sum = p.b_mod[l * 6144 + cgp * 64 + c2];
#pragma unroll
        for (int q = 0; q < 8; ++q) sum += red[(q * 5 + r) * 64 + c2];
        ((float*)(p.ws + OFF_MODS))[(l * 5 + r) * 6144 + cgp * 64 + c2] = sum; }
    __syncthreads();
}

__constant__ int c_cu0[2][5] = {{0, 5, 10, 15, 20}, {0, 5, 10, 14, 18}};
__constant__ int c_cnu[2][5] = {{5, 5, 5, 5, 2}, {5, 5, 4, 4, 4}};

DEVI void prep_phase(unsigned char* lds, const Params& p) {
    float* lf = (float*)lds;
    const int T_IN = 16 * 36, T_OUT = 256, T_UP = 16 * 88, T_DN = 44 * 16, T_L = T_IN + T_OUT + T_UP + T_DN;
    const int N_MODS = 192, N_TR = 2 * T_L, N_SGU = 32, N_POOL = 8;
    const int total = N_MODS + N_TR + N_SGU + N_POOL;
    for (int item = blockIdx.x; item < total; item += gridDim.x) {
        if (item < N_MODS) { mods_item(lf, p, item); continue; }
        int it = item - N_MODS;
        if (it < N_TR) {
            const int l = it / T_L; int r = it % T_L;
            if (r < T_IN) { const int kt = r / 36, ntl = r % 36;
                transpose_tile(p.wave, lf, p.w_in + (size_t)l * 1024 * 2080, 2080, kt * 64, ntl * 64, 2080, (bf16_t*)(p.ws + OFF_WIN) + (size_t)l * 2304 * 1024, 1024, ntl * 64, kt * 64); continue; }
            r -= T_IN;
            if (r < T_OUT) { const int kt = r / 16, ntl = r % 16;
                transpose_tile(p.wave, lf, p.w_out + (size_t)l * 1024 * 1024, 1024, kt * 64, ntl * 64, 1024, (bf16_t*)(p.ws + OFF_WOUT) + (size_t)l * 1024 * 1024, 1024, ntl * 64, kt * 64); continue; }
            r -= T_OUT;
            if (r < T_UP) { const int kt = r / 88, ntl = r % 88; const int n0d = ntl * 64; const int unit = n0d >> 8, sgn = (n0d >> 7) & 1, j0 = n0d & 127;
                transpose_tile(p.wave, lf, p.ffn_w_up + (size_t)l * 1024 * 5632, 5632, kt * 64, sgn * FH + unit * 128 + j0, 5632, (bf16_t*)(p.ws + OFF_WUP) + (size_t)l * 5632 * 1024, 1024, n0d, kt * 64); continue; }
            r -= T_UP;
            { const int kt = r / 16, ntl = r % 16;
                transpose_tile(p.wave, lf, p.ffn_w_down + (size_t)l * FH * 1024, 1024, kt * 64, ntl * 64, 1024, (bf16_t*)(p.ws + OFF_WDN) + (size_t)l * 1024 * FH, FH, ntl * 64, kt * 64); continue; }
        }
        it -= N_TR;
        if (it < N_SGU) { bf16_t* d = (bf16_t*)(p.ws + OFF_SGUW); const int base = it * 4096;
            const int t0 = my_tid_w(p.wave); float v[8];
#pragma unroll
            for (int i = 0; i < 8; ++i) v[i] = p.sgu_w[base + i * 512 + t0];
#pragma unroll
            for (int i = 0; i < 8; ++i) d[base + i * 512 + t0] = f2bf(v[i]);
            continue; }
        it -= N_SGU;
        { transpose_tile(p.wave, lf, p.pool_w + (size_t)it * 4096, 64, 0, 0, 64, (bf16_t*)(p.ws + OFF_POOLW) + (size_t)it * 4096, 64, 0, 0); }
    }
}

DEVI void ln_phase(int wave, const float* srcL, const float* srcC, int nrows, const float* lnw, const float* lnb, float* dstX, float* dstOut, const float* mods, int soff, bf16_t* H) {
    const int lane = my_lane(); int wid = wave; asm volatile("" : "+s"(wid));
    const int rstep = gridDim.x * 8;
    int r = blockIdx.x * 8 + wid;
    f32x4 vn[4];
    if (r < nrows) { const float* src = r < NLAT ? srcL + (size_t)r * DM : srcC + (size_t)(r - NLAT) * DM;
#pragma unroll
        for (int i = 0; i < 4; ++i) vn[i] = *(const f32x4*)(src + i * 256 + lane * 4); }
    for (; r < nrows; r += rstep) {
        f32x4 v[4];
#pragma unroll
        for (int i = 0; i < 4; ++i) v[i] = vn[i];
        { const int rn = r + rstep; if (rn < nrows) { const float* src = rn < NLAT ? srcL + (size_t)rn * DM : srcC + (size_t)(rn - NLAT) * DM;
#pragma unroll
            for (int i = 0; i < 4; ++i) vn[i] = *(const f32x4*)(src + i * 256 + lane * 4); } }
        float s = 0.f;
#pragma unroll
        for (int i = 0; i < 4; ++i) s += v[i][0] + v[i][1] + v[i][2] + v[i][3];
        float mean = wsum(s, lane) * (1.0f / 1024.0f);
        float q = 0.f;
#pragma unroll
        for (int i = 0; i < 4; ++i) { v[i] -= mean; q += v[i][0] * v[i][0] + v[i][1] * v[i][1] + v[i][2] * v[i][2] + v[i][3] * v[i][3]; }
        float rstd = rsqrtf(wsum(q, lane) * (1.0f / 1024.0f) + EPS);
        if (lnw) {
#pragma unroll
            for (int i = 0; i < 4; ++i) { const f32x4 w = *(const f32x4*)(lnw + i * 256 + lane * 4), b = *(const f32x4*)(lnb + i * 256 + lane * 4); v[i] = v[i] * rstd * w + b; }
            if (dstX) {
#pragma unroll
                for (int i = 0; i < 4; ++i) *(f32x4*)(dstX + (size_t)r * DM + i * 256 + lane * 4) = v[i]; }
            if (dstOut && r < NLAT) {
#pragma unroll
                for (int i = 0; i < 4; ++i) *(f32x4*)(dstOut + (size_t)r * DM + i * 256 + lane * 4) = v[i]; }
            if (mods) {
                s = 0.f;
#pragma unroll
                for (int i = 0; i < 4; ++i) s += v[i][0] + v[i][1] + v[i][2] + v[i][3];
                mean = wsum(s, lane) * (1.0f / 1024.0f); q = 0.f;
#pragma unroll
                for (int i = 0; i < 4; ++i) { v[i] -= mean; q += v[i][0] * v[i][0] + v[i][1] * v[i][1] + v[i][2] * v[i][2] + v[i][3] * v[i][3]; }
                rstd = rsqrtf(wsum(q, lane) * (1.0f / 1024.0f) + EPS);
            }
        }
        if (mods) {
            const int b = r < NLAT ? (r >> 13) : 4; const float* mp = mods + b * 6144 + soff;
#pragma unroll
            for (int i = 0; i < 4; ++i) { const f32x4 sh = *(const f32x4*)(mp + i * 256 + lane * 4), sc = *(const f32x4*)(mp + 1024 + i * 256 + lane * 4);
                const f32x4 h = v[i] * rstd * (1.0f + sc) + sh;
                u32x2 w; w.x = cvt_pk_bf16(h[0], h[1]); w.y = cvt_pk_bf16(h[2], h[3]);
                *(u32x2*)(H + (size_t)r * DM + i * 256 + lane * 4) = w; }
        }
    }
}

struct Tile { int row0, T0, L; };
DEVI Tile tile_of(int t, int tl) {
    const int nlat = NLAT / tl; Tile r;
    if (t < nlat) { r.row0 = t * tl; r.T0 = r.row0 & (SEQ - 1); r.L = SEQ; }
    else { const int q = (t - nlat) * tl; r.row0 = NLAT + q; r.T0 = q & (CTXL - 1); r.L = CTXL; }
    return r;
}

DEVI void pool_item(unsigned char* lds, const Params& p, int l, const Tile tl) {
    const int tid = my_tid_w(p.wave), wid = tid >> 6, lane = tid & 63, fr = lane & 15, fq = lane >> 4;
    bf16_t* zs = (bf16_t*)lds;
    bf16_t* ys = (bf16_t*)(lds + 80 * 256 * 2);
    const bf16_t* z = (const bf16_t*)(p.ws + OFF_Z);
    bf16_t* ycat = (bf16_t*)(p.ws + OFF_H);
    const int pg = wid >> 1; const bf16_t* Wt = (const bf16_t*)(p.ws + OFF_POOLW) + (size_t)(l * 4 + pg) * 4096;
    bf16x8 bw[4][2]; f32x4 psc[4];
#pragma unroll
    for (int nt = 0; nt < 4; ++nt) { bw[nt][0] = *(const bf16x8*)(Wt + (nt * 16 + fr) * 64 + fq * 8); bw[nt][1] = *(const bf16x8*)(Wt + (nt * 16 + fr) * 64 + 32 + fq * 8);
        psc[nt] = *(const f32x4*)(p.pool_scale + l * 256 + pg * 64 + nt * 16 + 4 * fq); }
    { u32x4 zv[5];
#pragma unroll
        for (int k = 0; k < 5; ++k) { const int i = tid + k * 512; const int r = i >> 5, c8 = i & 31; const int T = tl.T0 - 8 + r; const bool ok = T >= 0 && T < tl.L;
            zv[k] = *(const u32x4*)(z + (size_t)(ok ? tl.row0 - 8 + r : tl.row0) * ZP + ZB + c8 * 8); }
#pragma unroll
        for (int k = 0; k < 5; ++k) { const int i = tid + k * 512; const int r = i >> 5, c8 = i & 31; const int T = tl.T0 - 8 + r; const bool ok = T >= 0 && T < tl.L;
            *(u32x4*)(zs + r * 256 + c8 * 8) = ok ? zv[k] : (u32x4){0u, 0u, 0u, 0u}; } }
    __syncthreads();
    {
        const int g = wid & 3, hw = 1 << g; const int ch = g * 64 + (lane & 31) * 2; const int t0 = ((wid >> 2) * 2 + (lane >> 5)) * 16;
        unsigned rv[32];
#pragma unroll
        for (int i = 0; i < 32; ++i) rv[i] = *(const unsigned*)(zs + (t0 + i) * 256 + ch);
#pragma unroll
        for (int tt = 0; tt < 16; ++tt) { const int T = tl.T0 + t0 + tt; const int lo = max(T - hw, 0), hi = min(T + hw, tl.L);
            float s0 = 0.f, s1 = 0.f;
#pragma unroll
            for (int q = 0; q < 16; ++q) { const bool in = (q >= 8 - hw) && (q < 8 + hw); s0 += in ? bflo(rv[tt + q]) : 0.f; s1 += in ? bfhi(rv[tt + q]) : 0.f; }
            const float inv = __builtin_amdgcn_rcpf((float)(hi - lo)); const unsigned xv = rv[tt + 8];
            *(unsigned*)(ys + (t0 + tt) * 264 + ch) = cvt_pk_bf16(s0 * inv - bflo(xv), s1 * inv - bfhi(xv)); } }
    __syncthreads();
    { const int g = pg;
#pragma unroll
        for (int mi = 0; mi < 2; ++mi) { const int mt = (wid & 1) * 2 + mi; const int t = mt * 16 + fr;
            const bf16x8 a0 = *(const bf16x8*)(ys + t * 264 + g * 64 + fq * 8), a1 = *(const bf16x8*)(ys + t * 264 + g * 64 + 32 + fq * 8);
#pragma unroll
            for (int nt = 0; nt < 4; ++nt) {
                f32x4 acc = (f32x4){0.f, 0.f, 0.f, 0.f}; acc = MFMA16(bw[nt][0], a0, acc); acc = MFMA16(bw[nt][1], a1, acc);
                const int col = g * 64 + nt * 16 + 4 * fq; acc *= psc[nt];
                u32x2 w; w.x = cvt_pk_bf16(acc[0], acc[1]); w.y = cvt_pk_bf16(acc[2], acc[3]);
                *(u32x2*)(ycat + (size_t)(tl.row0 + t) * DM + 256 + col) = w; } } }
    __syncthreads();
}

DEVI void sgu_item(unsigned char* lds, const Params& p, int l, const Tile tl) {
    const int tid = my_tid_w(p.wave), wid = tid >> 6, lane = tid & 63, fr = lane & 15, fq = lane >> 4;
    bf16_t* vT = (bf16_t*)lds;
    const bf16_t* z = (const bf16_t*)(p.ws + OFF_Z);
    bf16_t* ycat = (bf16_t*)(p.ws + OFF_H);
    const int h = wid >> 1; const bf16_t* W = (const bf16_t*)(p.ws + OFF_SGUW) + (size_t)(l * 4 + h) * 16384;
    bf16x8 af[4][4]; float bias[4];
#pragma unroll
    for (int mi = 0; mi < 4; ++mi) { const int t = ((wid & 1) * 4 + mi) * 16 + fr; bias[mi] = p.sgu_b[(l * 4 + h) * 128 + t];
#pragma unroll
        for (int ks = 0; ks < 4; ++ks) af[mi][ks] = *(const bf16x8*)(W + t * 128 + ks * 32 + fq * 8); }
    { const f32x4 lw = *(const f32x4*)(p.sgu_ln_w + l * 256 + lane * 4), lb = *(const f32x4*)(p.sgu_ln_b + l * 256 + lane * 4);
#pragma unroll 1
        for (int hb = 0; hb < 2; ++hb) {
        u32x2 vraw[8];
#pragma unroll
        for (int i = 0; i < 8; ++i) vraw[i] = *(const u32x2*)(z + (size_t)(tl.row0 + wid * 16 + hb * 8 + i) * ZP + ZCV + lane * 4);
        f32x4 vo[8];
#pragma unroll
        for (int i = 0; i < 8; ++i) { const u32x2 raw = vraw[i];
            f32x4 v; v[0] = geluf_(bflo(raw.x)); v[1] = geluf_(bfhi(raw.x)); v[2] = geluf_(bflo(raw.y)); v[3] = geluf_(bfhi(raw.y));
            const float mean = wsum(v[0] + v[1] + v[2] + v[3], lane) * (1.0f / 256.0f); v -= mean;
            const float rstd = rsqrtf(wsum(v[0] * v[0] + v[1] * v[1] + v[2] * v[2] + v[3] * v[3], lane) * (1.0f / 256.0f) + EPS);
            vo[i] = v * rstd * lw + lb; }
#pragma unroll
        for (int j = 0; j < 4; ++j) { u32x4 w; w.x = cvt_pk_bf16(vo[0][j], vo[1][j]); w.y = cvt_pk_bf16(vo[2][j], vo[3][j]); w.z = cvt_pk_bf16(vo[4][j], vo[5][j]); w.w = cvt_pk_bf16(vo[6][j], vo[7][j]);
            *(u32x4*)(vT + (lane * 4 + j) * 136 + wid * 16 + hb * 8) = w; } } }
    __syncthreads();
    {
        u32x2 uraw4[4][4];
#pragma unroll
        for (int mi = 0; mi < 4; ++mi)
#pragma unroll
            for (int nt = 0; nt < 4; ++nt) uraw4[mi][nt] = *(const u32x2*)(z + (size_t)(tl.row0 + ((wid & 1) * 4 + mi) * 16 + fr) * ZP + ZCU + h * 64 + nt * 16 + 4 * fq);
#pragma unroll
        for (int mi = 0; mi < 4; ++mi) { const int mt = (wid & 1) * 4 + mi; const int t = mt * 16 + fr;
#pragma unroll
            for (int nt = 0; nt < 4; ++nt) { f32x4 acc = (f32x4){0.f, 0.f, 0.f, 0.f};
#pragma unroll
                for (int ks = 0; ks < 4; ++ks) { const bf16x8 b = *(const bf16x8*)(vT + (h * 64 + nt * 16 + fr) * 136 + ks * 32 + fq * 8); acc = MFMA16(b, af[mi][ks], acc); }
                const int col = h * 64 + nt * 16 + 4 * fq; const u32x2 raw = uraw4[mi][nt]; const float bs = bias[mi];
                const float o0 = geluf_(bflo(raw.x)) * (acc[0] + bs), o1 = geluf_(bfhi(raw.x)) * (acc[1] + bs), o2 = geluf_(bflo(raw.y)) * (acc[2] + bs), o3 = geluf_(bfhi(raw.y)) * (acc[3] + bs);
                u32x2 w; w.x = cvt_pk_bf16(o0, o1); w.y = cvt_pk_bf16(o2, o3);
                *(u32x2*)(ycat + (size_t)(tl.row0 + t) * DM + 512 + col) = w; } } }
    __syncthreads();
}

DEVI void cm_item(unsigned char* lds, const Params& p, int l, const Tile tl) {
    const int tid = my_tid_w(p.wave), wid = tid >> 6, lane = tid & 63;
    float* yg = (float*)lds;
    const bf16_t* z = (const bf16_t*)(p.ws + OFF_Z);
    bf16_t* ycat = (bf16_t*)(p.ws + OFF_H);
    const int c = tid & 255, th = tid >> 8;
    float w[31];
#pragma unroll
    for (int j = 0; j < 31; ++j) w[j] = p.cm_conv_w[(l * 31 + j) * 256 + c];
    const float cb = p.cm_conv_b[l * 256 + c];
    const f32x4 lw = *(const f32x4*)(p.cm_ln_w + l * 256 + lane * 4), lb = *(const f32x4*)(p.cm_ln_b + l * 256 + lane * 4);
    { u32x2 av[12], gv[12];
#pragma unroll
        for (int k = 0; k < 12; ++k) { const int i = tid + k * 512; const int r = min(i >> 6, 93), c4 = (i & 63) * 4; const int T = tl.T0 - 15 + r; const bool ok = T >= 0 && T < tl.L;
            const bf16_t* zp = z + (size_t)(ok ? tl.row0 - 15 + r : tl.row0) * ZP; av[k] = *(const u32x2*)(zp + ZDA + c4); gv[k] = *(const u32x2*)(zp + ZDG + c4); }
#pragma unroll
        for (int k = 0; k < 12; ++k) { const int i = tid + k * 512; const int r = i >> 6, c4 = (i & 63) * 4; const int T = tl.T0 - 15 + r; const bool ok = T >= 0 && T < tl.L;
            if (i < 94 * 64) { f32x4 o = (f32x4){0.f, 0.f, 0.f, 0.f};
                if (ok) { const u32x2 a = av[k], g = gv[k];
                    o[0] = bflo(a.x) * sigmoidf_(bflo(g.x)); o[1] = bfhi(a.x) * sigmoidf_(bfhi(g.x)); o[2] = bflo(a.y) * sigmoidf_(bflo(g.y)); o[3] = bfhi(a.y) * sigmoidf_(bfhi(g.y)); }
                *(f32x4*)(yg + r * 256 + c4) = o; } } }
    __syncthreads();
    float* yo = (float*)(lds + 94 * 256 * 4);
    {
#pragma unroll 1
        for (int bt = 0; bt < 8; ++bt) { float in[34];
#pragma unroll
            for (int i = 0; i < 34; ++i) in[i] = yg[(th * 32 + bt * 4 + i) * 256 + c];
            float s0 = cb, s1 = cb, s2 = cb, s3 = cb;
#pragma unroll
            for (int j = 0; j < 31; ++j) { s0 += in[j] * w[j]; s1 += in[j + 1] * w[j]; s2 += in[j + 2] * w[j]; s3 += in[j + 3] * w[j]; }
            float* op = yo + (th * 32 + bt * 4) * 256 + c; op[0] = s0; op[256] = s1; op[512] = s2; op[768] = s3; } }
    __syncthreads();
    {
#pragma unroll
        for (int i = 0; i < 8; ++i) { const int t = wid * 8 + i; f32x4 v = *(const f32x4*)(yo + t * 256 + lane * 4);
            const float mean = wsum(v[0] + v[1] + v[2] + v[3], lane) * (1.0f / 256.0f); v -= mean;
            const float rstd = rsqrtf(wsum(v[0] * v[0] + v[1] * v[1] + v[2] * v[2] + v[3] * v[3], lane) * (1.0f / 256.0f) + EPS);
            v = v * rstd * lw + lb;
            u32x2 w; w.x = cvt_pk_bf16(siluf_(v[0]), siluf_(v[1])); w.y = cvt_pk_bf16(siluf_(v[2]), siluf_(v[3]));
            *(u32x2*)(ycat + (size_t)(tl.row0 + t) * DM + 768 + lane * 4) = w; } }
    __syncthreads();
}

constexpr int GL_G = 0, GL_WG = 32768, GL_BG = 40960, GL_LOW = 41472, GL_VT = 49664, GL_QIN = 86528, GL_KIN = 103936, GL_STT = 121344, GL_KD = 86528, GL_WG1 = 141824, GL_BG1 = 150016;

DEVI void gla_load_common(int wave, unsigned char* lds, const bf16_t* z, const Tile tl, const float* wgate, const float* bgate) {
    const int tid = my_tid_w(wave);
    float* low = (float*)(lds + GL_LOW); bf16_t* vT = (bf16_t*)(lds + GL_VT);
    const f32x4 wg0 = *(const f32x4*)(wgate + tid * 4), wg1 = *(const f32x4*)(wgate + 2048 + tid * 4);
    const float bg0 = bgate[tid & 127], bg1 = bgate[128 + (tid & 127)];
    const u32x4 lowv = *(const u32x4*)(z + (size_t)(tl.row0 + ((tid & 255) >> 2)) * ZP + ZLF + (tid & 3) * 8);
    const int ch = tid & 255, tb = tid >> 8;
    unsigned e[4][8];
#pragma unroll
    for (int tg = 0; tg < 4; ++tg) { const bf16_t* zp = z + (size_t)(tl.row0 + (tb * 4 + tg) * 8) * ZP + ZV + ch;
#pragma unroll
        for (int j = 0; j < 8; ++j) e[tg][j] = zp[(size_t)j * ZP]; }
#pragma unroll
    for (int tg = 0; tg < 4; ++tg)
#pragma unroll
        for (int j = 0; j < 8; ++j) asm volatile("" : "+v"(e[tg][j]));
    *(f32x4*)((float*)(lds + GL_WG) + tid * 4) = wg0;
    *(f32x4*)((float*)(lds + GL_WG1) + tid * 4) = wg1;
    if (tid < 128) { ((float*)(lds + GL_BG))[tid] = bg0; ((float*)(lds + GL_BG1))[tid] = bg1; }
    if (tid < 256) { const int t = tid >> 2, part = tid & 3; float* d = low + t * 32 + part * 8;
        d[0] = bflo(lowv.x); d[1] = bfhi(lowv.x); d[2] = bflo(lowv.y); d[3] = bfhi(lowv.y); d[4] = bflo(lowv.z); d[5] = bfhi(lowv.z); d[6] = bflo(lowv.w); d[7] = bfhi(lowv.w); }
#pragma unroll
    for (int tg = 0; tg < 4; ++tg) { u32x4 w; w.x = e[tg][0] | (e[tg][1] << 16); w.y = e[tg][2] | (e[tg][3] << 16); w.z = e[tg][4] | (e[tg][5] << 16); w.w = e[tg][6] | (e[tg][7] << 16);
        *(u32x4*)(vT + ch * 72 + (tb * 4 + tg) * 8) = w; }
}
DEVI void gla_gates(unsigned char* lds, const Params& p, int l, int dir) {
    const int tid = my_tid_w(p.wave);
    float* G = (float*)(lds + GL_G); float* WG = (float*)(lds + (dir ? GL_WG1 : GL_WG)); const float* BG = (const float*)(lds + (dir ? GL_BG1 : GL_BG)); const float* low = (const float*)(lds + GL_LOW);
    __syncthreads();
    { const int t = tid >> 3, cgp = tid & 7; f32x4 lv[4];
#pragma unroll
        for (int r4 = 0; r4 < 4; ++r4) lv[r4] = *(const f32x4*)(low + t * 32 + dir * 16 + r4 * 4);
        f32x4 a[4];
#pragma unroll
        for (int j4 = 0; j4 < 4; ++j4) a[j4] = *(const f32x4*)(BG + cgp * 16 + j4 * 4);
#pragma unroll
        for (int r = 0; r < 16; ++r) { const float lr = lv[r >> 2][r & 3];
#pragma unroll
            for (int j4 = 0; j4 < 4; ++j4) a[j4] += lr * *(const f32x4*)(WG + r * 128 + cgp * 16 + j4 * 4); }
#pragma unroll
        for (int j4 = 0; j4 < 4; ++j4) { f32x4 g;
#pragma unroll
            for (int e = 0; e < 4; ++e) g[e] = fmaxf(logsigf_(a[j4][e]) * (1.0f / 16.0f), -1.0f);
            *(f32x4*)(G + t * 128 + cgp * 16 + j4 * 4) = g; } }
    __syncthreads();
    {
        const int col = tid & 127, seg = tid >> 7; float loc[16]; float run = 0.f;
#pragma unroll
        for (int i = 0; i < 16; ++i) { const int t = dir ? (seg * 16 + 15 - i) : (seg * 16 + i); run += G[t * 128 + col]; loc[i] = run; }
        WG[seg * 128 + col] = run;
        __syncthreads();
        float off = 0.f;
#pragma unroll
        for (int sg = 0; sg < 4; ++sg) { const float v = WG[sg * 128 + col]; off += (dir ? (sg > seg) : (sg < seg)) ? v : 0.f; }
#pragma unroll
        for (int i = 0; i < 16; ++i) { const int t = dir ? (seg * 16 + 15 - i) : (seg * 16 + i); G[t * 128 + col] = loc[i] + off; }
    }
    __syncthreads();
}

DEVI void gla_sum_item(unsigned char* lds, const Params& p, int l, const Tile tl) {
    const int tid = my_tid_w(p.wave), wid = tid >> 6, lane = tid & 63, fr = lane & 15, fq = lane >> 4;
    const bf16_t* z = (const bf16_t*)(p.ws + OFF_Z);
    float* ST = (float*)(p.ws + OFF_ST); float* DEC = (float*)(p.ws + OFF_DEC);
    const float* G = (const float*)(lds + GL_G); bf16_t* KD = (bf16_t*)(lds + GL_KD); const bf16_t* vT = (const bf16_t*)(lds + GL_VT);
    const int cid = tl.row0 >> 6;
    gla_load_common(p.wave, lds, z, tl, p.gla_w_gate + (size_t)l * 4096, p.gla_b_gate + l * 256);
    for (int dir = 0; dir < 2; ++dir) {
        unsigned kr[16];
        { const int col = tid & 127, tq = tid >> 7;
#pragma unroll
            for (int tt = 0; tt < 16; ++tt) kr[tt] = z[(size_t)(tl.row0 + tq * 16 + tt) * ZP + ZK + col]; }
        gla_gates(lds, p, l, dir);
        { const int col = tid & 127, tq = tid >> 7; const float cl = G[(dir ? 0 : 63) * 128 + col];
            float kd[16];
#pragma unroll
            for (int tt = 0; tt < 16; ++tt) kd[tt] = bf2f(kr[tt]) * __expf(cl - G[(tq * 16 + tt) * 128 + col]);
            u32x4 w0, w1;
            w0.x = cvt_pk_bf16(kd[0], kd[1]); w0.y = cvt_pk_bf16(kd[2], kd[3]); w0.z = cvt_pk_bf16(kd[4], kd[5]); w0.w = cvt_pk_bf16(kd[6], kd[7]);
            w1.x = cvt_pk_bf16(kd[8], kd[9]); w1.y = cvt_pk_bf16(kd[10], kd[11]); w1.z = cvt_pk_bf16(kd[12], kd[13]); w1.w = cvt_pk_bf16(kd[14], kd[15]);
            *(u32x4*)(KD + col * 72 + tq * 16) = w0; *(u32x4*)(KD + col * 72 + tq * 16 + 8) = w1;
            if (tid < 128) DEC[((size_t)(cid * 4 + (col >> 5)) * 2 + dir) * 32 + (col & 31)] = __expf(cl); }
        __syncthreads();
        { const int h = wid >> 1, mt = wid & 1;
            const bf16x8 a0 = *(const bf16x8*)(KD + (h * 32 + mt * 16 + fr) * 72 + fq * 8), a1 = *(const bf16x8*)(KD + (h * 32 + mt * 16 + fr) * 72 + 32 + fq * 8);
#pragma unroll
            for (int nt = 0; nt < 4; ++nt) { const bf16x8 b0 = *(const bf16x8*)(vT + (h * 64 + nt * 16 + fr) * 72 + fq * 8), b1 = *(const bf16x8*)(vT + (h * 64 + nt * 16 + fr) * 72 + 32 + fq * 8);
                f32x4 acc = (f32x4){0.f, 0.f, 0.f, 0.f}; acc = MFMA16(b0, a0, acc); acc = MFMA16(b1, a1, acc);
                *(f32x4*)(ST + ((size_t)(cid * 4 + h) * 2 + dir) * 2048 + (mt * 16 + fr) * 64 + nt * 16 + 4 * fq) = acc; } }
        __syncthreads();
    }
}

DEVI void gla_scan_phase(const Params& p) {
    float* ST = (float*)(p.ws + OFF_ST); const float* DEC = (const float*)(p.ws + OFF_DEC);
    for (int gt = blockIdx.x * 512 + my_tid_w(p.wave); gt < 65536; gt += gridDim.x * 512) {
        const int chain = gt >> 11, e = gt & 2047; const int dir = chain & 1, h = (chain >> 1) & 3, b = chain >> 3; const int d = e >> 6;
        float S = 0.f;
        for (int s0 = 0; s0 < 132; s0 += 12) {
            float kv[12], dc[12];
#pragma unroll
            for (int j = 0; j < 12; ++j) { const int s = s0 + j; const int cid = (s < 4) ? (512 + b * 4 + (dir ? 3 - s : s)) : (b * 128 + (dir ? 131 - s : s - 4));
                const size_t slot = (size_t)(cid * 4 + h) * 2 + dir; kv[j] = ST[slot * 2048 + e]; dc[j] = DEC[slot * 32 + d]; }
#pragma unroll
            for (int j = 0; j < 12; ++j) { const int s = s0 + j; const int cid = (s < 4) ? (512 + b * 4 + (dir ? 3 - s : s)) : (b * 128 + (dir ? 131 - s : s - 4));
                const size_t slot = (size_t)(cid * 4 + h) * 2 + dir; ST[slot * 2048 + e] = S; S = dc[j] * S + kv[j]; }
        }
    }
}

DEVI void gla_out_item(unsigned char* lds, const Params& p, int l, const Tile tl) {
    const int tid = my_tid_w(p.wave), wid = tid >> 6, lane = tid & 63, fr = lane & 15, fq = lane >> 4;
    const bf16_t* z = (const bf16_t*)(p.ws + OFF_Z);
    bf16_t* ycat = (bf16_t*)(p.ws + OFF_H);
    const float* ST = (const float*)(p.ws + OFF_ST);
    const float* G = (const float*)(lds + GL_G); bf16_t* QIN = (bf16_t*)(lds + GL_QIN); bf16_t* KIN = (bf16_t*)(lds + GL_KIN); bf16_t* STT = (bf16_t*)(lds + GL_STT);
    const bf16_t* vT = (const bf16_t*)(lds + GL_VT); bf16_t* AB = (bf16_t*)(lds + GL_G) + wid * 2304;
    const int cid = tl.row0 >> 6; const int h = wid >> 1, half = wid & 1;
    gla_load_common(p.wave, lds, z, tl, p.gla_w_gate + (size_t)l * 4096, p.gla_b_gate + l * 256);
    f32x4 o[2][4];
#pragma unroll
    for (int mi = 0; mi < 2; ++mi)
#pragma unroll
        for (int nt = 0; nt < 4; ++nt) o[mi][nt] = (f32x4){0.f, 0.f, 0.f, 0.f};
    for (int dir = 0; dir < 2; ++dir) {
        unsigned qr[8], kr[8]; float sv[16];
        { const int cp = tid & 63, tq8 = tid >> 6; const bf16_t* zp = z + (size_t)(tl.row0 + tq8 * 8) * ZP + 2 * cp;
#pragma unroll
            for (int tt = 0; tt < 8; ++tt) { qr[tt] = *(const unsigned*)(zp + (size_t)tt * ZP + ZQ); kr[tt] = *(const unsigned*)(zp + (size_t)tt * ZP + ZK); }
        }
        gla_gates(lds, p, l, dir);
        { const int cp = tid & 63, tq8 = tid >> 6;
            { const int he = tid & 255, dq = tid >> 8; const float* sp = ST + ((size_t)(cid * 4 + (he >> 6)) * 2 + dir) * 2048 + (dq * 16) * 64 + (he & 63);
#pragma unroll
                for (int j = 0; j < 16; ++j) sv[j] = sp[j * 64]; }
#pragma unroll
            for (int tt = 0; tt < 8; ++tt) { const int t = tq8 * 8 + tt; const f32x2 cum = *(const f32x2*)(G + t * 128 + 2 * cp);
                const float e0 = __expf(cum[0]), e1 = __expf(cum[1]);
                *(unsigned*)(QIN + t * 136 + 2 * cp) = cvt_pk_bf16(bflo(qr[tt]) * 0.17677669529663687f * e0, bfhi(qr[tt]) * 0.17677669529663687f * e1);
                *(unsigned*)(KIN + t * 136 + 2 * cp) = cvt_pk_bf16(bflo(kr[tt]) * __builtin_amdgcn_rcpf(e0), bfhi(kr[tt]) * __builtin_amdgcn_rcpf(e1)); }
            { const int he = tid & 255, dq = tid >> 8;
                u32x4 w0, w1;
                w0.x = cvt_pk_bf16(sv[0], sv[1]); w0.y = cvt_pk_bf16(sv[2], sv[3]); w0.z = cvt_pk_bf16(sv[4], sv[5]); w0.w = cvt_pk_bf16(sv[6], sv[7]);
                w1.x = cvt_pk_bf16(sv[8], sv[9]); w1.y = cvt_pk_bf16(sv[10], sv[11]); w1.z = cvt_pk_bf16(sv[12], sv[13]); w1.w = cvt_pk_bf16(sv[14], sv[15]);
                *(u32x4*)(STT + he * 40 + dq * 16) = w0; *(u32x4*)(STT + he * 40 + dq * 16 + 8) = w1; } }
        __syncthreads();
#pragma unroll
        for (int mi = 0; mi < 2; ++mi) { const int t = (half * 2 + mi) * 16 + fr; const bf16x8 qa = *(const bf16x8*)(QIN + t * 136 + h * 32 + fq * 8);
#pragma unroll
            for (int st = 0; st < 4; ++st) { const bf16x8 kb = *(const bf16x8*)(KIN + (st * 16 + fr) * 136 + h * 32 + fq * 8);
                f32x4 acc = (f32x4){0.f, 0.f, 0.f, 0.f}; acc = MFMA16(kb, qa, acc);
                const int s0 = st * 16 + 4 * fq;
#pragma unroll
                for (int j = 0; j < 4; ++j) { const int s = s0 + j; const bool keep = dir ? (s >= t) : (s <= t); acc[j] = keep ? acc[j] : 0.f; }
                u32x2 w; w.x = cvt_pk_bf16(acc[0], acc[1]); w.y = cvt_pk_bf16(acc[2], acc[3]);
                *(u32x2*)(AB + (mi * 16 + fr) * 72 + s0) = w; } }
        __syncthreads();
#pragma unroll
        for (int mi = 0; mi < 2; ++mi) { const int t = (half * 2 + mi) * 16 + fr;
            const bf16x8 aa0 = *(const bf16x8*)(AB + (mi * 16 + fr) * 72 + fq * 8), aa1 = *(const bf16x8*)(AB + (mi * 16 + fr) * 72 + 32 + fq * 8);
            const bf16x8 qa = *(const bf16x8*)(QIN + t * 136 + h * 32 + fq * 8);
#pragma unroll
            for (int nt = 0; nt < 4; ++nt) { const int er = h * 64 + nt * 16 + fr;
                const bf16x8 vb0 = *(const bf16x8*)(vT + er * 72 + fq * 8), vb1 = *(const bf16x8*)(vT + er * 72 + 32 + fq * 8), sb = *(const bf16x8*)(STT + er * 40 + fq * 8);
                o[mi][nt] = MFMA16(vb0, aa0, o[mi][nt]); o[mi][nt] = MFMA16(vb1, aa1, o[mi][nt]); o[mi][nt] = MFMA16(sb, qa, o[mi][nt]); } }
        __syncthreads();
    }
#pragma unroll
    for (int mi = 0; mi < 2; ++mi) { const int t = (half * 2 + mi) * 16 + fr; float ss = 0.f;
#pragma unroll
        for (int nt = 0; nt < 4; ++nt) ss += o[mi][nt][0] * o[mi][nt][0] + o[mi][nt][1] * o[mi][nt][1] + o[mi][nt][2] * o[mi][nt][2] + o[mi][nt][3] * o[mi][nt][3];
        ss += shx(ss, 16, lane); ss += shx(ss, 32, lane);
        const float rs = rsqrtf(ss * (1.0f / 64.0f) + EPS);
#pragma unroll
        for (int nt = 0; nt < 4; ++nt) { const int col = h * 64 + nt * 16 + 4 * fq; const f32x4 nw = *(const f32x4*)(p.gla_norm_w + l * 256 + col);
            const u32x2 raw = *(const u32x2*)(z + (size_t)(tl.row0 + t) * ZP + ZR + col);
            const float v0 = o[mi][nt][0] * rs * nw[0] * siluf_(bflo(raw.x)), v1 = o[mi][nt][1] * rs * nw[1] * siluf_(bfhi(raw.x)), v2 = o[mi][nt][2] * rs * nw[2] * siluf_(bflo(raw.y)), v3 = o[mi][nt][3] * rs * nw[3] * siluf_(bfhi(raw.y));
            u32x2 w; w.x = cvt_pk_bf16(v0, v1); w.y = cvt_pk_bf16(v2, v3);
            *(u32x2*)(ycat + (size_t)(tl.row0 + t) * DM + col) = w; } }
    __syncthreads();
}

DEVI void mix_phase(unsigned char* lds, const Params& p, int l) {
    const int n64 = (l == 0) ? 528 : 512, n128 = (l == 0) ? 264 : 256;
    const int nD = n64, nS = 528, nB = n64, nC = n128;
    const int total = nD + nS + nB + nC;
    for (int item = blockIdx.x; item < total; item += gridDim.x) {
        int it = item;
        if (it < nD) { cm_item(lds, p, l, tile_of(it, 64)); continue; }
        it -= nD;
        if (it < nS) { gla_sum_item(lds, p, l, tile_of(it, 64)); continue; }
        it -= nS;
        if (it < nB) { pool_item(lds, p, l, tile_of(it, 64)); continue; }
        it -= nB;
        sgu_item(lds, p, l, tile_of(it, 128));
    }
}
DEVI void gla_out_phase(unsigned char* lds, const Params& p, int l) {
    const int n64 = (l == 0) ? 528 : 512;
    for (int item = blockIdx.x; item < n64; item += gridDim.x) gla_out_item(lds, p, l, tile_of(item, 64));
}

struct ConvItem { int uu, row0, c0, seqc0, width, gr; bool lat; };
DEVI ConvItem conv_decode(int j, int npx, int xg, int tg) {
    ConvItem it; it.uu = j / npx; const Tile tl = tile_of(xg * npx + (j % npx), 64);
    it.lat = tl.L == SEQ; it.gr = tl.T0 >> 6; it.row0 = tl.row0; it.c0 = tg * 8; it.seqc0 = (it.lat ? 0 : tl.T0) + it.c0; it.width = it.lat ? 64 : CTXL; return it;
}
DEVI void conv_issue(const ConvItem& it, const bf16_t* U, int lane, unsigned (&va)[3][10], unsigned (&vg)[3][10]) {
#pragma unroll
    for (int dr = 0; dr < 3; ++dr) {
        const bool rvalid = it.lat ? (it.gr + dr - 1 >= 0 && it.gr + dr - 1 < 128) : (dr == 1);
        const int rbase = rvalid ? (it.row0 + (it.lat ? (dr - 1) * 64 : 0)) : it.row0;
        const bf16_t* pb = U + ((size_t)(rbase + it.c0) * UPITCH + it.uu * 256 + lane * 2);
#pragma unroll
        for (int q = 0; q < 10; ++q) { const int col = it.seqc0 + q - 1; const bool cvalid = col >= 0 && col < it.width;
            const bf16_t* pq = pb + (cvalid ? (q - 1) : 0) * UPITCH;
            va[dr][q] = *(const unsigned*)pq; vg[dr][q] = *(const unsigned*)(pq + 128); }
    }
}
DEVI void ffnconv_phase(unsigned char* lds, const Params& p, int l, int chunk) {
    const int lane = my_lane(); const int tg = p.wave;
    const int nu = c_cnu[l][chunk], u0 = c_cu0[l][chunk]; const int kc = FH;
    const int ntile = (l == 0) ? 528 : 512, npx = ntile >> 3;
    const bf16_t* U = (const bf16_t*)(p.ws + OFF_U); bf16_t* ACT = (bf16_t*)(p.ws + OFF_ACT);
    const int xg = blockIdx.x & 7, slot = blockIdx.x >> 3, nslot = gridDim.x >> 3, jend = nu * npx;
    float wA[9][2], wG[9][2];
#pragma unroll
    for (int t = 0; t < 9; ++t) { wA[t][0] = 0.f; wA[t][1] = 0.f; wG[t][0] = 0.f; wG[t][1] = 0.f; }
    int cur_uu = -1;
    unsigned va[3][10], vg[3][10], na[3][10], ng[3][10];
    int j = slot;
    if (j < jend) { const ConvItem it = conv_decode(j, npx, xg, tg); conv_issue(it, U, lane, va, vg); }
    for (; j < jend; j += nslot) {
        const ConvItem it = conv_decode(j, npx, xg, tg);
        const int jn = j + nslot;
        if (jn < jend) { const ConvItem nx = conv_decode(jn, npx, xg, tg); conv_issue(nx, U, lane, na, ng); }
        if (it.uu != cur_uu) {
#pragma unroll
            for (int t = 0; t < 9; ++t) { const float* wp = p.ffn_conv_w + ((size_t)l * 9 + t) * 5632 + (u0 + it.uu) * 128 + lane * 2;
                const f32x2 a = *(const f32x2*)wp, g = *(const f32x2*)(wp + FH); wA[t][0] = a[0]; wA[t][1] = a[1]; wG[t][0] = g[0]; wG[t][1] = g[1]; }
            cur_uu = it.uu;
        }
        float aA[8][2], aG[8][2];
#pragma unroll
        for (int t = 0; t < 8; ++t) { aA[t][0] = 0.f; aA[t][1] = 0.f; aG[t][0] = 0.f; aG[t][1] = 0.f; }
#pragma unroll
        for (int dr = 0; dr < 3; ++dr) {
            const bool rvalid = it.lat ? (it.gr + dr - 1 >= 0 && it.gr + dr - 1 < 128) : (dr == 1);
#pragma unroll
            for (int q = 0; q < 10; ++q) { const int col = it.seqc0 + q - 1; const bool ok = rvalid && col >= 0 && col < it.width;
                va[dr][q] = ok ? va[dr][q] : 0u; vg[dr][q] = ok ? vg[dr][q] : 0u; }
#pragma unroll
            for (int t = 0; t < 8; ++t)
#pragma unroll
                for (int dc = 0; dc < 3; ++dc) { const int tap = dr * 3 + dc; const unsigned a = va[dr][t + dc], g = vg[dr][t + dc];
                    aA[t][0] += bflo(a) * wA[tap][0]; aA[t][1] += bfhi(a) * wA[tap][1]; aG[t][0] += bflo(g) * wG[tap][0]; aG[t][1] += bfhi(g) * wG[tap][1]; }
        }
        bf16_t* ap = ACT + (size_t)(it.row0 + it.c0) * kc + (u0 + it.uu) * 128 + lane * 2;
#pragma unroll
        for (int t = 0; t < 8; ++t) *(unsigned*)(ap + (size_t)t * kc) = cvt_pk_bf16(siluf_(aG[t][0]) * aA[t][0], siluf_(aG[t][1]) * aA[t][1]);
#pragma unroll
        for (int dr = 0; dr < 3; ++dr)
#pragma unroll
            for (int q = 0; q < 10; ++q) { va[dr][q] = na[dr][q]; vg[dr][q] = ng[dr][q]; }
    }
}

#define XB_TMO      128
#define XB_XCNT(j)  (256  + 64 * (j))
#define XB_XSUB(j)  (1280 + 64 * (j))
#define XB_XGEN(j)  (2304 + 64 * (j))
#define XB_TOP      3328
#define XB_TOPGEN   3392
#define XB_SPIN_CAP (1u << 22)
DEVI unsigned xb_ld(unsigned* p) { return __hip_atomic_load(p, __ATOMIC_RELAXED, __HIP_MEMORY_SCOPE_AGENT); }
DEVI unsigned xb_add(unsigned* p, unsigned v) { return __hip_atomic_fetch_add(p, v, __ATOMIC_RELAXED, __HIP_MEMORY_SCOPE_AGENT); }
DEVI unsigned xb_xcc_id() { return (unsigned)__builtin_amdgcn_s_getreg((3 << 11) | 20) & 0xFu; }
#define XB_SPIN(cond, bar) do { unsigned _sp = 0; while (cond) { __builtin_amdgcn_s_sleep(1); \
    if ((++_sp & 255u) == 0u) { if (xb_ld(&(bar)[XB_TMO])) break; if (_sp > XB_SPIN_CAP) { atomicAdd(&(bar)[XB_TMO], 1u); break; } } } } while (0)
struct XcdBarrier { unsigned* bar; unsigned x; volatile LAS unsigned* st; };
DEVI XcdBarrier xcd_barrier_post(unsigned* bar, volatile LAS unsigned* st) {
    XcdBarrier b; b.bar = bar; b.x = xb_xcc_id(); b.st = st;
    if (threadIdx.x == 0) (void)xb_add(&bar[XB_XCNT(b.x)], 1u);
    return b;
}
DEVI void xcd_barrier_complete(unsigned* bar, unsigned x, unsigned& nloc, unsigned& nx) {
    const unsigned G = gridDim.x * gridDim.y * gridDim.z;
    unsigned sum, cnt, mine, sp = 0u;
    for (;;) {
        sum = 0u; cnt = 0u; mine = 0u;
#pragma unroll
        for (unsigned j = 0; j < 16; ++j) { const unsigned c = xb_ld(&bar[XB_XCNT(j)]); sum += c; cnt += (c > 0u) ? 1u : 0u; mine = (j == x) ? c : mine; }
        if (sum == G) break;
        __builtin_amdgcn_s_sleep(1);
        if ((++sp & 255u) == 0u) { if (xb_ld(&bar[XB_TMO])) break; if (sp > XB_SPIN_CAP) { atomicAdd(&bar[XB_TMO], 1u); break; } }
    }
    nloc = mine > 0u ? mine : 1u; nx = cnt > 0u ? cnt : 1u;
}
DEVI void xcd_barrier(const XcdBarrier& b) {
    asm volatile("s_waitcnt vmcnt(0)" ::: "memory");
    __syncthreads();
    if (threadIdx.x == 0) {
        unsigned* bar = b.bar;
        __builtin_amdgcn_s_waitcnt(0);
        unsigned nloc = b.st[0], nx = b.st[1];
        if (nloc == 0u) { xcd_barrier_complete(bar, b.x, nloc, nx); b.st[0] = nloc; b.st[1] = nx; }
        const unsigned old = xb_add(&bar[XB_XSUB(b.x)], 1u);
        const unsigned gen = old / nloc;
        if (old + 1u == (gen + 1u) * nloc) {
            __builtin_amdgcn_fence(__ATOMIC_RELEASE, "agent");
            asm volatile("s_waitcnt vmcnt(0)" ::: "memory");
            const unsigned og = xb_add(&bar[XB_TOP], 1u);
            const unsigned tg = og / nx;
            if (og + 1u == (tg + 1u) * nx) xb_add(&bar[XB_TOPGEN], 1u);
            else XB_SPIN(xb_ld(&bar[XB_TOPGEN]) == tg, bar);
            __builtin_amdgcn_fence(__ATOMIC_ACQUIRE, "agent");
            xb_add(&bar[XB_XGEN(b.x)], 1u);
            asm volatile("s_waitcnt vmcnt(0)" ::: "memory");
        } else {
            XB_SPIN(xb_ld(&bar[XB_XGEN(b.x)]) == gen, bar);
            __builtin_amdgcn_fence(__ATOMIC_ACQUIRE, "agent");
            asm volatile("s_waitcnt vmcnt(0)" ::: "memory");
        }
    }
    __syncthreads();
}

constexpr int PH_PER_LAYER = 19, N_PHASES = 1 + 2 * PH_PER_LAYER;

DEVI void run_phase(unsigned char* shm, const Params& p, int ph) {
    LAS unsigned char* lds3 = (LAS unsigned char*)shm;
    unsigned char* ws = p.ws;
    const float* mods = (const float*)(ws + OFF_MODS);
    float* X = (float*)(ws + OFF_X); bf16_t* H = (bf16_t*)(ws + OFF_H); bf16_t* Z = (bf16_t*)(ws + OFF_Z); bf16_t* U = (bf16_t*)(ws + OFF_U); bf16_t* ACT = (bf16_t*)(ws + OFF_ACT);
    if (ph == 0) { prep_phase(shm, p); return; }
    const int l = (ph - 1) / PH_PER_LAYER, k = (ph - 1) % PH_PER_LAYER;
    const float* ml = mods + l * 5 * 6144;
    const int Mrows = (l == 0) ? ROWS : NLAT;
    pg8::StaticOrder S;
    switch (k) {
    case 0: if (l == 0) ln_phase(p.wave, p.x, p.ctx, ROWS, nullptr, nullptr, nullptr, nullptr, ml, 0, H); break;
    case 1: { pg8::Gemm g{H, (const bf16_t*)(ws + OFF_WIN) + (size_t)l * 2304 * 1024, ROWS, ZP, 1024}; S.init(g.M, g.N, gridDim.x, blockIdx.x);
        pg8::EpiBf16 E{Z, ZP}; pg8::gemm_phase(lds3, g, S, E, p.wave); } break;
    case 2: mix_phase(shm, p, l); break;
    case 3: gla_scan_phase(p); break;
    case 4: gla_out_phase(shm, p, l); break;
    case 5: { pg8::Gemm g{H, (const bf16_t*)(ws + OFF_WOUT) + (size_t)l * 1024 * 1024, Mrows, 1024, 1024}; S.init(g.M, g.N, gridDim.x, blockIdx.x);
        pg8::EpiRes E{X, l == 0 ? p.x : X, l == 0 ? p.ctx : X + (size_t)NLAT * DM, ml, 2 * 1024, 0}; pg8::gemm_phase(lds3, g, S, E, p.wave); } break;
    case 6: ln_phase(p.wave, X, X + (size_t)NLAT * DM, Mrows, p.post_ln_w + (l * 2 + 0) * 1024, p.post_ln_b + (l * 2 + 0) * 1024, X, nullptr, ml, 3 * 1024, H); break;
    case 7: case 9: case 11: case 13: case 15: { const int ch = (k - 7) >> 1; const int u0 = c_cu0[l][ch], nu = c_cnu[l][ch];
        pg8::Gemm g{H, (const bf16_t*)(ws + OFF_WUP) + (size_t)l * 5632 * 1024 + (size_t)u0 * 256 * 1024, Mrows, nu * 256, 1024}; S.init(g.M, g.N, gridDim.x, blockIdx.x);
        pg8::EpiBf16 E{U, UPITCH}; pg8::gemm_phase(lds3, g, S, E, p.wave); } break;
    case 8: case 10: case 12: case 14: case 16: ffnconv_phase(shm, p, l, (k - 8) >> 1); break;
    case 17: { pg8::Gemm g{ACT, (const bf16_t*)(ws + OFF_WDN) + (size_t)l * 1024 * FH, Mrows, 1024, FH}; S.init(g.M, g.N, gridDim.x, blockIdx.x);
        pg8::EpiRes E{X, X, X + (size_t)NLAT * DM, ml, 5 * 1024, 0}; pg8::gemm_phase(lds3, g, S, E, p.wave); } break;
    case 18:
        if (l == 0) ln_phase(p.wave, X, X + (size_t)NLAT * DM, ROWS, p.post_ln_w + (l * 2 + 1) * 1024, p.post_ln_b + (l * 2 + 1) * 1024, X, nullptr, mods + 5 * 6144, 0, H);
        else ln_phase(p.wave, X, X + (size_t)NLAT * DM, NLAT, p.post_ln_w + (l * 2 + 1) * 1024, p.post_ln_b + (l * 2 + 1) * 1024, nullptr, p.out, nullptr, 0, nullptr);
        break;
    }
}

__global__ void __launch_bounds__(512, 2) mega(Params p, int ph_lo, int ph_hi, int coop) {
    extern __shared__ __attribute__((aligned(16))) unsigned char shm[];
    unsigned* bar = (unsigned*)(p.ws + OFF_CTL);
    volatile LAS unsigned* st = (volatile LAS unsigned*)((LAS unsigned char*)shm + (LDS_BYTES - 16));
    if (threadIdx.x == 0) { st[0] = 0u; st[1] = 0u; }
    __syncthreads();
    const XcdBarrier xb = xcd_barrier_post(bar, st);
    Params q = p; q.wave = __builtin_amdgcn_readfirstlane((int)(threadIdx.x >> 6));
    for (int ph = ph_lo; ph < ph_hi; ++ph) {
        if (ph == 1 + PH_PER_LAYER) continue;
        run_phase(shm, q, ph);
#if PROBE_REP > 0
        if (ph == PROBE_PH || ph == PROBE_PH2) for (int rep = 0; rep < PROBE_REP; ++rep) { xcd_barrier(xb); run_phase(shm, q, ph); }
#endif
        if (coop && ph + 1 < ph_hi) {
            if (coop == 2) cg::this_grid().sync();
            xcd_barrier(xb);
        }
    }
}

extern "C" void kernel_launch(void* const* d_in, const int* in_sizes, int n_in, void* d_out, int out_size, void* d_ws, size_t ws_size, hipStream_t stream) {
    static int grid = 0;
    if (grid == 0) {
        if (n_in != 26 || ws_size < WS_END) { fprintf(stderr, "kernel_launch: unexpected n_in %d / ws_size %zu (need %zu)\n", n_in, ws_size, (size_t)WS_END); grid = -1; return; }
        int dev = 0, cus = 0, per_cu = 0;
        hipGetDevice(&dev); hipDeviceGetAttribute(&cus, hipDeviceAttributeMultiprocessorCount, dev);
        if (hipFuncSetAttribute((const void*)mega, hipFuncAttributeMaxDynamicSharedMemorySize, LDS_BYTES) != hipSuccess) { fprintf(stderr, "kernel_launch: hipFuncSetAttribute failed\n"); grid = -1; return; }
        if (hipOccupancyMaxActiveBlocksPerMultiprocessor(&per_cu, (const void*)mega, 512, LDS_BYTES) != hipSuccess || per_cu < 1) { fprintf(stderr, "kernel_launch: occupancy query says %d\n", per_cu); per_cu = 1; }
        (void)hipGetLastError();
        grid = cus * 1;
    }
    if (grid < 0) return;
    Params p{};
    const float** pp = (const float**)&p;
    for (int i = 0; i < 26; ++i) pp[i] = (const float*)d_in[i];
    p.wave = 0; p.pad_ = 0;
    p.out = (float*)d_out; p.ws = (unsigned char*)d_ws;
#if MK_COOP
    hipMemsetAsync((char*)d_ws + OFF_CTL, 0, 16384, stream);
    int lo = 0, hi = N_PHASES, coop = 1;
    void* args[] = {&p, &lo, &hi, &coop};
    hipError_t e = hipLaunchCooperativeKernel((const void*)mega, dim3(grid), dim3(512), args, LDS_BYTES, stream);
    if (e != hipSuccess) fprintf(stderr, "cooperative launch failed: %s (grid %d)\n", hipGetErrorString(e), grid);
#else
    for (int ph = 0; ph < N_PHASES; ++ph) {
        if (ph == 1 + PH_PER_LAYER) continue;
        hipLaunchKernelGGL(mega, dim3(grid), dim3(512), LDS_BYTES, stream, p, ph, ph + 1, 0);
    }
#endif
}
```
